# Optimizing an MI355X kernel written in HIP

```python
import math
import jax, jax.numpy as jnp
from jax import lax
import numpy as np

D_MODEL = 2048
BATCH = 2
SEQ = 16384
DEPTH = 4

GRID_W = 64
CTX_LEN = 256
N_MIXERS = 2
N_CONV_LAYERS = (DEPTH + 1) // 2
N_MLA_LAYERS = DEPTH // 2
N_HEADS = 16
QK_NOPE_DIM = 128
QK_ROPE_DIM = 64
QK_HEAD_DIM = QK_NOPE_DIM + QK_ROPE_DIM
V_HEAD_DIM = 128
Q_LORA_RANK = 512
KV_LORA_RANK = 512
ROPE_THETA = 10000.0
Q_BLOCK = 128
CONV_WIDTH = 3
D_FF = 5632
DN_ALPHA = (2.0 * DEPTH) ** 0.25
DN_BETA = (8.0 * DEPTH) ** -0.25
LN_EPS = 1e-5
RMS_EPS = 1e-6

kernel_name = "hybrid_shortconv_mla_convffn_deepnorm_prefix"


def _layer_norm(x, g, b):
    xf = x.astype(jnp.float32)
    mu = jnp.mean(xf, -1, keepdims=True)
    var = jnp.mean(jnp.square(xf - mu), -1, keepdims=True)
    return ((xf - mu) * lax.rsqrt(var + LN_EPS) * g.astype(jnp.float32) + b.astype(jnp.float32)).astype(x.dtype)


def _rms_norm(x, g):
    xf = x.astype(jnp.float32)
    ms = jnp.mean(jnp.square(xf), -1, keepdims=True)
    return (xf * lax.rsqrt(ms + RMS_EPS) * g.astype(jnp.float32)).astype(x.dtype)


def _dwconv3(h, w, b=None):
    hp = jnp.pad(h, ((0, 0), (1, 1), (0, 0)))
    y = hp[:, :-2] * w[0] + hp[:, 1:-1] * w[1] + hp[:, 2:] * w[2]
    return y if b is None else y + b


def _axial_rope_tables(rows):
    n_freq = QK_ROPE_DIM // 4
    inv_freq = 1.0 / (ROPE_THETA ** (jnp.arange(n_freq, dtype=jnp.float32) / n_freq))
    row = jnp.broadcast_to(jnp.arange(rows, dtype=jnp.float32)[:, None], (rows, GRID_W)).reshape(-1)
    col = jnp.broadcast_to(jnp.arange(GRID_W, dtype=jnp.float32)[None, :], (rows, GRID_W)).reshape(-1)
    ang_r = row[:, None] * inv_freq[None, :]
    ang_c = col[:, None] * inv_freq[None, :]
    ang = jnp.concatenate([ang_r, ang_r, ang_c, ang_c], -1)
    return jnp.cos(ang), jnp.sin(ang)


def _apply_axial_rope(t, cos, sin):
    r1, r2, c1, c2 = jnp.split(t, 4, axis=-1)
    rot = jnp.concatenate([-r2, r1, -c2, c1], -1)
    return (t * cos + rot * sin).astype(t.dtype)


def _short_conv_mix(h, w_in, conv_w, w_out):
    b_gate, c_gate, v = jnp.split(h @ w_in, 3, axis=-1)
    return (b_gate * _dwconv3(c_gate * v, conv_w)) @ w_out


def _mla_queries(h, w_dq, q_norm, w_uq):
    bsz, n, _ = h.shape
    q = (_rms_norm(h @ w_dq, q_norm) @ w_uq).reshape(bsz, n, N_HEADS, QK_HEAD_DIM)
    return q[..., :QK_NOPE_DIM], q[..., QK_NOPE_DIM:]


def _mla_keys_values(h, w_dkv, kv_norm, w_uk, w_uv):
    bsz, n, _ = h.shape
    ckv = h @ w_dkv
    c_kv = _rms_norm(ckv[..., :KV_LORA_RANK], kv_norm)
    k_rope = ckv[..., KV_LORA_RANK:]
    k_nope = (c_kv @ w_uk).reshape(bsz, n, N_HEADS, QK_NOPE_DIM)
    v = (c_kv @ w_uv).reshape(bsz, n, N_HEADS, V_HEAD_DIM)
    return k_nope, k_rope, v


def _block_attention(q_nope, q_rope, k_nope, k_rope, v):
    bsz, lq = q_nope.shape[0], q_nope.shape[1]
    nb = lq // Q_BLOCK
    scale = 1.0 / math.sqrt(QK_HEAD_DIM)
    qn = q_nope.reshape(bsz, nb, Q_BLOCK, N_HEADS, QK_NOPE_DIM).transpose(1, 0, 2, 3, 4)
    qr = q_rope.reshape(bsz, nb, Q_BLOCK, N_HEADS, QK_ROPE_DIM).transpose(1, 0, 2, 3, 4)

    def one_block(args):
        qn_b, qr_b = args
        s = jnp.einsum('bqhd,bkhd->bhqk', qn_b, k_nope) + jnp.einsum('bqhr,bkr->bhqk', qr_b, k_rope)
        p = jax.nn.softmax(s.astype(jnp.float32) * scale, axis=-1).astype(v.dtype)
        return jnp.einsum('bhqk,bkhd->bqhd', p, v)

    o = lax.map(one_block, (qn, qr))
    return o.transpose(1, 0, 2, 3, 4).reshape(bsz, lq, N_HEADS * V_HEAD_DIM)


def _mla_mix(hx, hc, cos, sin, w_dq, q_norm, w_uq, w_dkv, kv_norm, w_uk, w_uv, w_o, need_ctx_out):
    qn_x, qr_x = _mla_queries(hx, w_dq, q_norm, w_uq)
    kn_x, kr_x, v_x = _mla_keys_values(hx, w_dkv, kv_norm, w_uk, w_uv)
    qr_x = _apply_axial_rope(qr_x, cos[:, None, :], sin[:, None, :])
    kr_x = _apply_axial_rope(kr_x, cos, sin)
    kn_c, kr_c, v_c = _mla_keys_values(hc, w_dkv, kv_norm, w_uk, w_uv)
    kn_all = jnp.concatenate([kn_c, kn_x], axis=1)
    kr_all = jnp.concatenate([kr_c, kr_x], axis=1)
    v_all = jnp.concatenate([v_c, v_x], axis=1)
    y_x = _block_attention(qn_x, qr_x, kn_all, kr_all, v_all) @ w_o
    y_c = None
    if need_ctx_out:
        qn_c, qr_c = _mla_queries(hc, w_dq, q_norm, w_uq)
        y_c = _block_attention(qn_c, qr_c, kn_c, kr_c, v_c) @ w_o
    return y_x, y_c


def _conv_ffn(h, w_up, conv_w, conv_b, w_down):
    gu = _dwconv3(h @ w_up, conv_w, conv_b)
    g, u = jnp.split(gu, 2, axis=-1)
    return (jax.nn.silu(g) * u) @ w_down


def setup_inputs(seed: int = 0) -> dict:
    key = jax.random.key(seed)
    ks = jax.random.split(key, 26)
    f32 = jnp.float32
    D, F = D_MODEL, D_FF
    nrm = lambda k, shape, s: jax.random.normal(k, shape, f32) * s
    return {
        "x": nrm(ks[0], (BATCH, SEQ, D), 1.0),
        "c": nrm(ks[1], (BATCH, D), 1.0),
        "ctx": nrm(ks[2], (BATCH, CTX_LEN, D), 1.0),
        "c_ctx": nrm(ks[3], (D,), 1.0),
        "ada_w": nrm(ks[4], (DEPTH, D, 6 * D), 0.5 * D ** -0.5),
        "ada_b": nrm(ks[5], (DEPTH, 6 * D), 0.01),
        "ln1_g": 1.0 + nrm(ks[6], (DEPTH, D), 0.02),
        "ln1_b": nrm(ks[7], (DEPTH, D), 0.02),
        "ln2_g": 1.0 + nrm(ks[8], (DEPTH, D), 0.02),
        "ln2_b": nrm(ks[9], (DEPTH, D), 0.02),
        "sc_w_in": nrm(ks[10], (N_CONV_LAYERS, D, 3 * D), D ** -0.5),
        "sc_conv_w": nrm(ks[11], (N_CONV_LAYERS, CONV_WIDTH, D), CONV_WIDTH ** -0.5),
        "sc_w_out": nrm(ks[12], (N_CONV_LAYERS, D, D), DN_BETA * D ** -0.5),
        "mla_w_dq": nrm(ks[13], (N_MLA_LAYERS, D, Q_LORA_RANK), D ** -0.5),
        "mla_q_norm": 1.0 + nrm(ks[14], (N_MLA_LAYERS, Q_LORA_RANK), 0.02),
        "mla_w_uq": nrm(ks[15], (N_MLA_LAYERS, Q_LORA_RANK, N_HEADS * QK_HEAD_DIM), Q_LORA_RANK ** -0.5),
        "mla_w_dkv": nrm(ks[16], (N_MLA_LAYERS, D, KV_LORA_RANK + QK_ROPE_DIM), D ** -0.5),
        "mla_kv_norm": 1.0 + nrm(ks[17], (N_MLA_LAYERS, KV_LORA_RANK), 0.02),
        "mla_w_uk": nrm(ks[18], (N_MLA_LAYERS, KV_LORA_RANK, N_HEADS * QK_NOPE_DIM), KV_LORA_RANK ** -0.5),
        "mla_w_uv": nrm(ks[19], (N_MLA_LAYERS, KV_LORA_RANK, N_HEADS * V_HEAD_DIM), KV_LORA_RANK ** -0.5),
        "mla_w_o": nrm(ks[20], (N_MLA_LAYERS, N_HEADS * V_HEAD_DIM, D), DN_BETA * (N_HEADS * V_HEAD_DIM) ** -0.5),
        "ffn_w_up": nrm(ks[21], (DEPTH, D, 2 * F), D ** -0.5),
        "ffn_conv_w": nrm(ks[22], (DEPTH, CONV_WIDTH, 2 * F), CONV_WIDTH ** -0.5),
        "ffn_conv_b": nrm(ks[23], (DEPTH, 2 * F), 0.01),
        "ffn_w_down": nrm(ks[24], (DEPTH, F, D), DN_BETA * F ** -0.5),
    }


def reference(x, c, ctx, c_ctx, ada_w, ada_b, ln1_g, ln1_b, ln2_g, ln2_b,
              sc_w_in, sc_conv_w, sc_w_out,
              mla_w_dq, mla_q_norm, mla_w_uq, mla_w_dkv, mla_kv_norm, mla_w_uk, mla_w_uv, mla_w_o,
              ffn_w_up, ffn_conv_w, ffn_conv_b, ffn_w_down):
    n_lat = x.shape[1]
    rows = n_lat // GRID_W
    cos, sin = _axial_rope_tables(rows)
    silu_c = jax.nn.silu(c)
    silu_cc = jax.nn.silu(c_ctx)
    for i in range(DEPTH):
        last = i == DEPTH - 1
        j = i // N_MIXERS
        mod_x = (silu_c @ ada_w[i] + ada_b[i])[:, None, :]
        mod_c = (silu_cc @ ada_w[i] + ada_b[i])[None, None, :]
        sh1, sc1, g1, sh2, sc2, g2 = jnp.split(mod_x, 6, axis=-1)
        csh1, csc1, cg1, csh2, csc2, cg2 = jnp.split(mod_c, 6, axis=-1)
        hx = x * (1.0 + sc1) + sh1
        hc = ctx * (1.0 + csc1) + csh1
        if i % N_MIXERS == 0:
            yx = _short_conv_mix(hx, sc_w_in[j], sc_conv_w[j], sc_w_out[j])
            yc = None if last else _short_conv_mix(hc, sc_w_in[j], sc_conv_w[j], sc_w_out[j])
        else:
            yx, yc = _mla_mix(hx, hc, cos, sin, mla_w_dq[j], mla_q_norm[j], mla_w_uq[j],
                              mla_w_dkv[j], mla_kv_norm[j], mla_w_uk[j], mla_w_uv[j], mla_w_o[j],
                              not last)
        x = _layer_norm(DN_ALPHA * x + g1 * yx, ln1_g[i], ln1_b[i])
        fx = _conv_ffn(x * (1.0 + sc2) + sh2, ffn_w_up[i], ffn_conv_w[i], ffn_conv_b[i], ffn_w_down[i])
        x = _layer_norm(DN_ALPHA * x + g2 * fx, ln2_g[i], ln2_b[i])
        if not last:
            ctx = _layer_norm(DN_ALPHA * ctx + cg1 * yc, ln1_g[i], ln1_b[i])
            fc = _conv_ffn(ctx * (1.0 + csc2) + csh2, ffn_w_up[i], ffn_conv_w[i], ffn_conv_b[i], ffn_w_down[i])
            ctx = _layer_norm(DN_ALPHA * ctx + cg2 * fc, ln2_g[i], ln2_b[i])
    return x
```

```cpp
#include <hip/hip_runtime.h>
#include <cstdio>
#include <cstdint>
#include <cmath>
#ifndef ATT_SDEPTH
#define ATT_SDEPTH 1
#endif
__device__ __forceinline__ int tid_from_wave(int wave) {
    int w = wave; asm volatile("" : "+s"(w));
    int l = (int)__builtin_amdgcn_mbcnt_hi(~0u, __builtin_amdgcn_mbcnt_lo(~0u, 0u)); asm volatile("" : "+v"(l));
    return (w << 6) | l;
}
namespace pg8 {
#define PG8_LAS __attribute__((address_space(3)))
typedef unsigned short bf16_t;
typedef short bf16x8 __attribute__((ext_vector_type(8)));
typedef float f32x4 __attribute__((ext_vector_type(4)));
typedef unsigned u32x4 __attribute__((ext_vector_type(4)));
constexpr int BM = 256, BK = 64, HALF = 128, HTB = HALF * BK * 2  , STAGE_BYTES = 8 * HTB, NXCD = 8, WGM = 8;

__host__ __device__ __forceinline__ int lds_byte(int r, int c) { const int st = (r >> 4) * 2 + (c >> 5), rr = r & 15, cc = c & 31, ob = rr * 64 + cc * 2; return st * 1024 + (ob ^ (((ob >> 9) & 1) << 5)); }
__host__ __device__ __forceinline__ void stage_rc(int b, int& R, int& C) { const int st = b / 1024, sb = b % 1024, swz = sb ^ (((sb >> 9) & 1) << 5); R = (st >> 1) * 16 + swz / 64; C = (st & 1) * 32 + (swz % 64) / 2; }
__host__ __device__ __forceinline__ int perm32(int rho) { const int n = rho >> 4, i = rho & 15; return 8 * (i >> 2) + 4 * n + (i & 3); }

struct Unit { int pm, pn, kofs, nt; };
struct Gemm { const bf16_t* A; const bf16_t* Bt; int M, N, K; };

struct StaticOrder {
    int nM, nN, nwg, G, c, i_off = 0, i_cnt = 1 << 30;
    __host__ __device__ void init(int M, int N, int G_, int c_) { nM = M / BM; nN = N / BM; nwg = nM * nN; G = G_; c = c_; }
    __host__ __device__ bool next(int i_, Unit& u) const {
        if (i_ >= i_cnt) return false; const int i = i_ + i_off;
        const long L = (long)i * G + c; if (L >= nwg) return false;
        int wgid = (int)L; { const int q = nwg / NXCD, r = nwg % NXCD, xcd = wgid % NXCD, off = wgid / NXCD; wgid = (xcd < r ? xcd * (q + 1) : r * (q + 1) + (xcd - r) * q) + off; }
        const int nig = WGM * nN, gid = wgid / nig, fm = gid * WGM, gsz = (nM - fm) < WGM ? (nM - fm) : WGM;
        u.pm = fm + ((wgid % nig) % gsz); u.pn = (wgid % nig) / gsz; u.kofs = 0; u.nt = 0; return true;
    }
    __device__ __forceinline__ void a_ready(const Unit&) const {}
    __device__ __forceinline__ void done(const Unit&) const {}
};

struct TailProbeOrder {
    StaticOrder base;
    __host__ __device__ void init(int M, int N, int G_, int c_) { base.init(M, N, G_, c_); }
    __host__ __device__ bool next(int i, Unit& u) const {
        if (base.next(i, u)) return true;
        const int r0 = (base.nwg - base.c + base.G - 1) / base.G;
        const int rmax = (base.nwg + base.G - 1) / base.G;
        if (i == r0 && r0 == rmax && base.c < 16) return base.next(0, u);
        return false;
    }
    __device__ __forceinline__ void a_ready(const Unit&) const {}
    __device__ __forceinline__ void done(const Unit&) const {}
};
struct SplitCtxOrder {
    StaticOrder base; int nxu, nct, nN, nslice, slice_k, G, c;
    __host__ __device__ void init(int Mx, int Mc, int N, int K, int nslice_, int G_, int c_) { base.init(Mx, N, G_, c_); nxu = base.nwg; nN = N / BM; nct = Mc / BM; nslice = nslice_; slice_k = K / nslice_; G = G_; c = c_; }
    __host__ __device__ bool next(int i, Unit& u) const {
        const long L = (long)i * G + c;
        if (L < nxu) return base.next(i, u);
        const int q = (int)(L - nxu); if (q >= nct * nN * nslice) return false;
        const int t = q / nslice, s = q % nslice; u.pm = base.nM + t / nN; u.pn = t % nN; u.kofs = s * slice_k; u.nt = slice_k / BK; return true;
    }
    __device__ __forceinline__ void a_ready(const Unit&) const {}
    __device__ __forceinline__ void done(const Unit&) const {}
};

__device__ __forceinline__ unsigned cvt_pk_bf16(float lo, float hi) { unsigned r; asm volatile("v_cvt_pk_bf16_f32 %0, %1, %2" : "=v"(r) : "v"(lo), "v"(hi)); return r; }
typedef float f32x2 __attribute__((ext_vector_type(2)));
__device__ __forceinline__ f32x2 gelu_pk(f32x2 v) {
    const f32x2 av = __builtin_elementwise_abs(v), d = av * 0.2316418882f + 1.0f;
    f32x2 t; t.x = __builtin_amdgcn_rcpf(d.x); t.y = __builtin_amdgcn_rcpf(d.y);
    f32x2 q = t * 0.5307027145f + (-0.7265760135f); q = q * t + 0.7107068705f; q = q * t + (-0.142248368f); q = q * t + 0.127414796f; q = q * t;
    const f32x2 s = (v * v) * (-0.72134752044f);
    f32x2 e; e.x = __builtin_amdgcn_exp2f(s.x); e.y = __builtin_amdgcn_exp2f(s.y);
    const f32x2 m = v * (q * e), r = v - m;
    f32x2 o; o.x = v.x < 0.f ? m.x : r.x; o.y = v.y < 0.f ? m.y : r.y; return o;
}

template <int ACT  > struct EpiBf16 {
    static constexpr bool PERM = true, AFTER_DRAIN = false; static_assert(ACT == 0 || ACT == 1, "EpiBf16: ACT is 0 (none) or 1 (gelu_pk)");
    bf16_t* O; int ldc; const float* bias; int split_cols; size_t split_stride; float scale0;
    __device__ __forceinline__ void operator()(const f32x4 (&acc)[2][2][4][2], const Unit& u, int wr, int wc, int fr, int fq) const {
        const int row0 = u.pm * BM + wr * 64 + fr; int colt = u.pn * BM; bf16_t* base = O;
        float sc = 1.f; if (split_cols) { const int t = colt / split_cols; base += (size_t)t * split_stride; colt -= t * split_cols; if (t == 0) sc = scale0; }
        const int col0 = colt + wc * 32 + 8 * fq, bcol0 = u.pn * BM + wc * 32 + 8 * fq;
        f32x4 bv[2][2];
#pragma unroll
        for (int bj = 0; bj < 2; ++bj)
#pragma unroll
            for (int n = 0; n < 2; ++n) bv[bj][n] = bias ? *(const f32x4*)(bias + bcol0 + bj * HALF + 4 * n) : (f32x4){0.f, 0.f, 0.f, 0.f};
#pragma unroll
        for (int ai = 0; ai < 2; ++ai)
#pragma unroll
            for (int m = 0; m < 4; ++m) { bf16_t* rowp = base + (size_t)(row0 + ai * HALF + m * 16) * ldc + col0;
#pragma unroll
                for (int bj = 0; bj < 2; ++bj) { f32x4 v0 = acc[ai][bj][m][0] + bv[bj][0], v1 = acc[ai][bj][m][1] + bv[bj][1];
                    if (ACT == 1) { f32x2 a = gelu_pk((f32x2){v0[0], v0[1]}), b = gelu_pk((f32x2){v0[2], v0[3]}), c = gelu_pk((f32x2){v1[0], v1[1]}), d = gelu_pk((f32x2){v1[2], v1[3]});
                        v0 = (f32x4){a.x, a.y, b.x, b.y}; v1 = (f32x4){c.x, c.y, d.x, d.y}; }
                    v0 = v0 * sc; v1 = v1 * sc; u32x4 w; w.x = cvt_pk_bf16(v0[0], v0[1]); w.y = cvt_pk_bf16(v0[2], v0[3]); w.z = cvt_pk_bf16(v1[0], v1[1]); w.w = cvt_pk_bf16(v1[2], v1[3]);
                    *(u32x4*)(rowp + bj * HALF) = w; } }
    }
};

struct EpiF32 {
    static constexpr bool PERM = false, AFTER_DRAIN = false;
    float* C; int ldc;
    __device__ __forceinline__ void operator()(const f32x4 (&acc)[2][2][4][2], const Unit& u, int wr, int wc, int fr, int fq) const {
        const int row0 = u.pm * BM + wr * 64 + fr, col0 = u.pn * BM + wc * 32 + 4 * fq;
#pragma unroll
        for (int ai = 0; ai < 2; ++ai)
#pragma unroll
            for (int m = 0; m < 4; ++m) { float* rowp = C + (size_t)(row0 + ai * HALF + m * 16) * ldc + col0;
#pragma unroll
                for (int bj = 0; bj < 2; ++bj)
#pragma unroll
                    for (int n = 0; n < 2; ++n) *(f32x4*)(rowp + bj * HALF + n * 16) = acc[ai][bj][m][n]; }
    }
};
typedef _Float16 f16x8 __attribute__((ext_vector_type(8)));
typedef _Float16 f16x4 __attribute__((ext_vector_type(4)));
struct EpiResid {
    static constexpr bool PERM = true, AFTER_DRAIN = false;
    const float* src32; const _Float16* srcT; _Float16* dstT; float* dstC; const float* gate; float alpha;
    const float* stats; const float* gam; const float* bet;
    __device__ __forceinline__ void operator()(const f32x4 (&acc)[2][2][4][2], const Unit& u, int wr, int wc, int fr_, int fq_) const {
        int fr = fr_, fq = fq_; asm volatile("" : "+v"(fr), "+v"(fq));
        const int col0 = u.pn * BM + wc * 32 + 8 * fq;
        if (u.pm >= 128) {
            const int rowc = (u.pm - 128) * BM + wr * 64 + fr;
#pragma unroll
            for (int bj = 0; bj < 2; ++bj)
#pragma unroll
                for (int n = 0; n < 2; ++n) { const int c = col0 + bj * HALF + 4 * n; const f32x4 gv = *(const f32x4*)(gate + 2 * 12288 + c);
#pragma unroll
                    for (int ai = 0; ai < 2; ++ai)
#pragma unroll
                        for (int m = 0; m < 4; ++m) { float* dp = dstC + (size_t)(rowc + ai * HALF + m * 16) * 2048 + c; const f32x4 v = gv * acc[ai][bj][m][n];
#pragma unroll
                            for (int e2 = 0; e2 < 4; ++e2) (void)__hip_atomic_fetch_add(dp + e2, v[e2], __ATOMIC_RELAXED, __HIP_MEMORY_SCOPE_AGENT); } }
            return;
        }
        const int rt = u.pm < 64 ? 0 : 1;
        const int row0 = u.pm * BM + wr * 64 + fr;
        const float* st = stats ? stats + 2 * (size_t)row0 : nullptr;
#pragma unroll
        for (int bj = 0; bj < 2; ++bj) {
            const int c = col0 + bj * HALF;
            const f32x4 gv0 = *(const f32x4*)(gate + rt * 12288 + c), gv1 = *(const f32x4*)(gate + rt * 12288 + c + 4);
            f32x4 ga0 = {alpha, alpha, alpha, alpha}, ga1 = ga0, ba0 = {0.f, 0.f, 0.f, 0.f}, ba1 = ba0;
            if (st) { ga0 = *(const f32x4*)(gam + c) * alpha; ga1 = *(const f32x4*)(gam + c + 4) * alpha; ba0 = *(const f32x4*)(bet + c) * alpha; ba1 = *(const f32x4*)(bet + c + 4) * alpha; }
#pragma unroll
            for (int ai = 0; ai < 2; ++ai)
#pragma unroll
                for (int m = 0; m < 4; ++m) { const size_t off = (size_t)(row0 + ai * HALF + m * 16) * 2048 + c;
                    f32x4 x0, x1;
                    if (src32) { x0 = *(const f32x4*)(src32 + off); x1 = *(const f32x4*)(src32 + off + 4); }
                    else { const f16x8 t = *(const f16x8*)(srcT + off); x0 = (f32x4){(float)t[0], (float)t[1], (float)t[2], (float)t[3]}; x1 = (f32x4){(float)t[4], (float)t[5], (float)t[6], (float)t[7]}; }
                    if (st) { const f32x2 ms = *(const f32x2*)(st + 2 * (ai * HALF + m * 16)); x0 = (x0 - ms.x) * ms.y; x1 = (x1 - ms.x) * ms.y; }
                    const f32x4 o0 = x0 * ga0 + ba0 + gv0 * acc[ai][bj][m][0], o1 = x1 * ga1 + ba1 + gv1 * acc[ai][bj][m][1];
                    const f16x8 w = {(_Float16)o0[0], (_Float16)o0[1], (_Float16)o0[2], (_Float16)o0[3], (_Float16)o1[0], (_Float16)o1[1], (_Float16)o1[2], (_Float16)o1[3]};
                    *(f16x8*)(dstT + off) = w; }
            asm volatile("" ::: "memory");
        }
    }
};
template <int CTRL> __device__ __forceinline__ float dppf(float old, float src) {
    return __builtin_bit_cast(float, __builtin_amdgcn_update_dpp(__builtin_bit_cast(int, old), __builtin_bit_cast(int, src), CTRL, 0xf, 0xf, false)); }
template <int CTRL> __device__ __forceinline__ float dppz(float src) {
    return __builtin_bit_cast(float, __builtin_amdgcn_update_dpp(0, __builtin_bit_cast(int, src), CTRL, 0xf, 0xf, true)); }
__device__ __forceinline__ float silu_e(float x) { return x * __builtin_amdgcn_rcpf(1.0f + __builtin_amdgcn_exp2f(-1.4426950408889634f * x)); }
struct EpiConvAct {
    static constexpr bool PERM = true, AFTER_DRAIN = false;
    bf16_t* ACT; float* HALO; const float* cw; const float* cb; unsigned halo_bytes;
    __device__ __forceinline__ void operator()(f32x4 (&acc)[2][2][4][2], const Unit& u, int wr, int wc, int fr_, int fq_) const {
        int fr = fr_, fq = fq_; asm volatile("" : "+v"(fr), "+v"(fq));
        constexpr int ROW_SHL1 = 0x101, ROW_SHL15 = 0x10F, ROW_SHR1 = 0x111, ROW_SHR15 = 0x11F;
        const int f0 = u.pn * 128 + wc * 32 + 8 * fq;
#define DPZ4(CTRL, SRC) (f32x4){dppz<CTRL>((SRC)[0]), dppz<CTRL>((SRC)[1]), dppz<CTRL>((SRC)[2]), dppz<CTRL>((SRC)[3])}
#define DPP4(CTRL, OLD, SRC) (f32x4){dppf<CTRL>((OLD)[0], (SRC)[0]), dppf<CTRL>((OLD)[1], (SRC)[1]), dppf<CTRL>((OLD)[2], (SRC)[2]), dppf<CTRL>((OLD)[3], (SRC)[3])}
        const f32x4 z4 = {0.f, 0.f, 0.f, 0.f};
        const __amdgpu_buffer_rsrc_t hrs = __builtin_amdgcn_make_buffer_rsrc(HALO, 0, (int)halo_bytes, 0x00020000);
        const int etop = (fr == 0) ? 0 : -4096, ebot = (fr == 15) ? 0 : -4096;
        f32x4 W0[2][2], W1[2][2], W2[2][2], BB[2][2];
#pragma unroll
        for (int bj = 0; bj < 2; ++bj)
#pragma unroll
            for (int n = 0; n < 2; ++n) { const float* wp = cw + bj * 5632 + f0 + 4 * n;
                W0[bj][n] = *(const f32x4*)(wp); W1[bj][n] = *(const f32x4*)(wp + 11264); W2[bj][n] = *(const f32x4*)(wp + 2 * 11264); BB[bj][n] = *(const f32x4*)(cb + bj * 5632 + f0 + 4 * n); }
#pragma unroll
        for (int bj = 0; bj < 2; ++bj)
#pragma unroll
            for (int n = 0; n < 2; ++n) {
                const f32x4 w0 = W0[bj][n], w1 = W1[bj][n], w2 = W2[bj][n], bb = BB[bj][n];
#pragma unroll
                for (int ai = 0; ai < 2; ++ai) {
                    const int hoff = (((4 * u.pm + 2 * ai + wr) * 2816 + ((bj * 5632 + f0) >> 2) + n) * 64);
                    f32x4 prev = z4;
#pragma unroll
                    for (int m = 0; m < 4; ++m) {
                        const f32x4 raw = acc[ai][bj][m][n];
                        f32x4 edge = bb;
                        if (m > 0) edge = edge + w0 * DPZ4(ROW_SHL15, prev);
                        if (m < 3) { const f32x4 nx = acc[ai][bj][m + 1][n]; edge = edge + w2 * DPZ4(ROW_SHR15, nx); }
                        const f32x4 c = w0 * DPZ4(ROW_SHR1, raw) + (w2 * DPZ4(ROW_SHL1, raw) + (w1 * raw + edge));
                        if (m == 0) { __builtin_amdgcn_raw_buffer_store_b128(__builtin_bit_cast(u32x4, raw), hrs, (hoff | etop), 0, 0); __builtin_amdgcn_raw_buffer_store_b128(__builtin_bit_cast(u32x4, c), hrs, ((hoff + 16) | etop), 0, 0); }
                        if (m == 3) { __builtin_amdgcn_raw_buffer_store_b128(__builtin_bit_cast(u32x4, raw), hrs, ((hoff + 32) | ebot), 0, 0); __builtin_amdgcn_raw_buffer_store_b128(__builtin_bit_cast(u32x4, c), hrs, ((hoff + 48) | ebot), 0, 0); }
                        acc[ai][bj][m][n] = c; prev = raw;
                        __builtin_amdgcn_sched_barrier(0);
                    }
                }
            }
#undef DPP4
#undef DPZ4
        const int row0 = u.pm * BM + wr * 64 + fr;
#pragma unroll
        for (int ai = 0; ai < 2; ++ai)
#pragma unroll
            for (int m = 0; m < 4; ++m) {
                u32x4 w;
                { const f32x4 g = acc[ai][0][m][0], v = acc[ai][1][m][0]; w.x = cvt_pk_bf16(silu_e(g[0]) * v[0], silu_e(g[1]) * v[1]); w.y = cvt_pk_bf16(silu_e(g[2]) * v[2], silu_e(g[3]) * v[3]); }
                { const f32x4 g = acc[ai][0][m][1], v = acc[ai][1][m][1]; w.z = cvt_pk_bf16(silu_e(g[0]) * v[0], silu_e(g[1]) * v[1]); w.w = cvt_pk_bf16(silu_e(g[2]) * v[2], silu_e(g[3]) * v[3]); }
                *(u32x4*)(ACT + (size_t)(row0 + ai * HALF + m * 16) * 5632 + f0) = w;
            }
    }
};

struct EpiConvGate {
    static constexpr bool PERM = true, AFTER_DRAIN = false;
    bf16_t* OUT; float* HALO; const bf16_t* Bb; const float* cw; unsigned halo_bytes;
    __device__ __forceinline__ void operator()(f32x4 (&acc)[2][2][4][2], const Unit& u, int wr, int wc, int fr_, int fq_) const {
        int fr = fr_, fq = fq_; asm volatile("" : "+v"(fr), "+v"(fq));
        constexpr int ROW_SHL1 = 0x101, ROW_SHL15 = 0x10F, ROW_SHR1 = 0x111, ROW_SHR15 = 0x11F;
        const int f0 = u.pn * 128 + wc * 32 + 8 * fq;
#define DPZ4(CTRL, SRC) (f32x4){dppz<CTRL>((SRC)[0]), dppz<CTRL>((SRC)[1]), dppz<CTRL>((SRC)[2]), dppz<CTRL>((SRC)[3])}
        const f32x4 z4 = {0.f, 0.f, 0.f, 0.f};
        const __amdgpu_buffer_rsrc_t hrs = __builtin_amdgcn_make_buffer_rsrc(HALO, 0, (int)halo_bytes, 0x00020000);
        const int etop = (fr == 0) ? 0 : -4096, ebot = (fr == 15) ? 0 : -4096;
        f32x4 W0[2], W1[2], W2[2];
#pragma unroll
        for (int n = 0; n < 2; ++n) { W0[n] = *(const f32x4*)(cw + f0 + 4 * n); W1[n] = *(const f32x4*)(cw + 2048 + f0 + 4 * n); W2[n] = *(const f32x4*)(cw + 4096 + f0 + 4 * n); }
#pragma unroll
        for (int n = 0; n < 2; ++n) {
            const f32x4 w0 = W0[n], w1 = W1[n], w2 = W2[n];
#pragma unroll
            for (int ai = 0; ai < 2; ++ai) {
                const int hoff = (((4 * u.pm + 2 * ai + wr) * 512 + (f0 >> 2) + n) * 64);
#pragma unroll
                for (int m = 0; m < 4; ++m) acc[ai][0][m][n] = acc[ai][0][m][n] * acc[ai][1][m][n];
                f32x4 prev = z4;
#pragma unroll
                for (int m = 0; m < 4; ++m) {
                    const f32x4 raw = acc[ai][0][m][n];
                    f32x4 edge = z4;
                    if (m > 0) edge = edge + w0 * DPZ4(ROW_SHL15, prev);
                    if (m < 3) { const f32x4 nx = acc[ai][0][m + 1][n]; edge = edge + w2 * DPZ4(ROW_SHR15, nx); }
                    const f32x4 c = w0 * DPZ4(ROW_SHR1, raw) + (w2 * DPZ4(ROW_SHL1, raw) + (w1 * raw + edge));
                    if (m == 0) { __builtin_amdgcn_raw_buffer_store_b128(__builtin_bit_cast(u32x4, raw), hrs, (hoff | etop), 0, 0); __builtin_amdgcn_raw_buffer_store_b128(__builtin_bit_cast(u32x4, c), hrs, ((hoff + 16) | etop), 0, 0); }
                    if (m == 3) { __builtin_amdgcn_raw_buffer_store_b128(__builtin_bit_cast(u32x4, raw), hrs, ((hoff + 32) | ebot), 0, 0); __builtin_amdgcn_raw_buffer_store_b128(__builtin_bit_cast(u32x4, c), hrs, ((hoff + 48) | ebot), 0, 0); }
                    acc[ai][1][m][n] = c; prev = raw;
                    __builtin_amdgcn_sched_barrier(0);
                }
            }
        }
#undef DPZ4
        const int row0 = u.pm * BM + wr * 64 + fr;
#pragma unroll
        for (int ai = 0; ai < 2; ++ai)
#pragma unroll
            for (int m = 0; m < 4; ++m) { const size_t off = (size_t)(row0 + ai * HALF + m * 16) * 2048 + f0;
                const u32x4 bw = *(const u32x4*)(Bb + off);
                const f32x4 z0 = acc[ai][1][m][0], z1 = acc[ai][1][m][1];
                u32x4 w;
                w.x = cvt_pk_bf16(__uint_as_float(bw.x << 16) * z0[0], __uint_as_float(bw.x & 0xffff0000u) * z0[1]); w.y = cvt_pk_bf16(__uint_as_float(bw.y << 16) * z0[2], __uint_as_float(bw.y & 0xffff0000u) * z0[3]);
                w.z = cvt_pk_bf16(__uint_as_float(bw.z << 16) * z1[0], __uint_as_float(bw.z & 0xffff0000u) * z1[1]); w.w = cvt_pk_bf16(__uint_as_float(bw.w << 16) * z1[2], __uint_as_float(bw.w & 0xffff0000u) * z1[3]);
                *(u32x4*)(OUT + off) = w; }
    }
};

struct EpiDqkv {
    static constexpr bool PERM = true, AFTER_DRAIN = false;
    bf16_t* CQ; bf16_t* CKV; float* KRRAW; float* SSQ; unsigned ssq_bytes;
    __device__ __forceinline__ void operator()(const f32x4 (&acc)[2][2][4][2], const Unit& u, int wr, int wc, int fr_, int fq_) const {
        int fr = fr_, fq = fq_; asm volatile("" : "+v"(fr), "+v"(fq));
        const int row0 = u.pm * BM + wr * 64 + fr;
        if (u.pn == 4) {
            if (wc < 2) {
#pragma unroll
                for (int ai = 0; ai < 2; ++ai)
#pragma unroll
                    for (int m = 0; m < 4; ++m) { float* p = KRRAW + (size_t)(row0 + ai * HALF + m * 16) * 64 + wc * 32 + 8 * fq;
                        *(f32x4*)p = acc[ai][0][m][0]; *(f32x4*)(p + 4) = acc[ai][0][m][1]; }
            }
            return;
        }
        bf16_t* base = (u.pn < 2 ? CQ : CKV); const int col0 = (u.pn & 1) * BM + wc * 32 + 8 * fq;
        const __amdgpu_buffer_rsrc_t srs = __builtin_amdgcn_make_buffer_rsrc(SSQ, 0, (int)ssq_bytes, 0x00020000);
        const int slot = (u.pn >> 1) * 8 + (u.pn & 1) * 4 + wc, lane = fr + 16 * fq, keep = (fq == 0) ? 0 : -4096;
#pragma unroll
        for (int ai = 0; ai < 2; ++ai)
#pragma unroll
            for (int m = 0; m < 4; ++m) { const int row = row0 + ai * HALF + m * 16; float s = 0.f;
#pragma unroll
                for (int bj = 0; bj < 2; ++bj) { const f32x4 v0 = acc[ai][bj][m][0], v1 = acc[ai][bj][m][1];
                    s += (v0[0] * v0[0] + v0[1] * v0[1]) + (v0[2] * v0[2] + v0[3] * v0[3]) + (v1[0] * v1[0] + v1[1] * v1[1]) + (v1[2] * v1[2] + v1[3] * v1[3]);
                    u32x4 w; w.x = cvt_pk_bf16(v0[0], v0[1]); w.y = cvt_pk_bf16(v0[2], v0[3]); w.z = cvt_pk_bf16(v1[0], v1[1]); w.w = cvt_pk_bf16(v1[2], v1[3]);
                    *(u32x4*)(base + (size_t)row * 512 + col0 + bj * HALF) = w; }
                s += __builtin_bit_cast(float, __builtin_amdgcn_ds_bpermute((lane ^ 16) << 2, __builtin_bit_cast(int, s)));
                s += __builtin_bit_cast(float, __builtin_amdgcn_ds_bpermute((lane ^ 32) << 2, __builtin_bit_cast(int, s)));
                __builtin_amdgcn_raw_buffer_store_b32(__builtin_bit_cast(unsigned, s), srs, ((row * 16 + slot) * 4) | keep, 0, 0); }
    }
};
struct EpiBf16Row {
    static constexpr bool PERM = true, AFTER_DRAIN = false;
    bf16_t* O; int ldc; int split_cols; size_t split_stride; const float* ssq; float eps; int hm_rows;
    __device__ __forceinline__ void operator()(const f32x4 (&acc)[2][2][4][2], const Unit& u, int wr, int wc, int fr_, int fq_) const {
        int fr = fr_, fq = fq_; asm volatile("" : "+v"(fr), "+v"(fq));
        const int row0 = u.pm * BM + wr * 64 + fr; int colt = u.pn * BM; bf16_t* base = O;
        if (split_cols) { const int t = colt / split_cols; base += (size_t)t * split_stride; colt -= t * split_cols; }
        const int col0 = colt + wc * 32 + 8 * fq;
#pragma unroll
        for (int ai = 0; ai < 2; ++ai)
#pragma unroll
            for (int m = 0; m < 4; ++m) { const int row = row0 + ai * HALF + m * 16;
                const f32x4 a = *(const f32x4*)(ssq + (size_t)row * 16), b = *(const f32x4*)(ssq + (size_t)row * 16 + 4);
                const float sc = 1.0f / sqrtf(((a[0] + a[1]) + (a[2] + a[3]) + (b[0] + b[1]) + (b[2] + b[3])) * (1.0f / 512.0f) + eps);
                bf16_t* rowp = hm_rows ? base + ((size_t)(colt >> 7) * hm_rows + row) * 128 + wc * 32 + 8 * fq : base + (size_t)row * ldc + col0;
                const size_t bstep = hm_rows ? (size_t)hm_rows * 128 : (size_t)HALF;
#pragma unroll
                for (int bj = 0; bj < 2; ++bj) { const f32x4 v0 = acc[ai][bj][m][0] * sc, v1 = acc[ai][bj][m][1] * sc;
                    u32x4 w; w.x = cvt_pk_bf16(v0[0], v0[1]); w.y = cvt_pk_bf16(v0[2], v0[3]); w.z = cvt_pk_bf16(v1[0], v1[1]); w.w = cvt_pk_bf16(v1[2], v1[3]);
                    *(u32x4*)(rowp + bj * bstep) = w; } }
    }
};
template <class Epi, class Sched, bool ALIGN_EPI = false, bool SP2 = false>
__device__ __forceinline__ void gemm_phase(PG8_LAS unsigned char* lds, const Gemm g, const Sched& S, const Epi& E, int wave_sgpr) {
    int tid_ = tid_from_wave(wave_sgpr);
    const int tid = tid_, wid = __builtin_amdgcn_readfirstlane(tid >> 6), lane = tid & 63, wr = wid >> 2, wc = wid & 3, fr = lane & 15, fq = lane >> 4;
    const int K = g.K, nt = K / BK;
    unsigned voffA[2], voffB[2];
#pragma unroll
    for (int i = 0; i < 2; ++i) { int R, C; stage_rc(tid * 16 + i * 8192, R, C); const int Rb = Epi::PERM ? ((R & ~31) + perm32(R & 31)) : R;
        voffA[i] = (unsigned)(R * K + C) * 2u; voffB[i] = (unsigned)(Rb * K + C) * 2u; }
    const size_t kstep = (size_t)(BK * 2);
    const size_t hstep = (size_t)HALF * K * 2;
    const size_t tstep = 2 * hstep;
    const unsigned ldsw = (unsigned)wid * 1024u;
    const int aoff = lds_byte(wr * 64 + fr, fq * 8), boff = lds_byte(wc * 32 + fr, fq * 8);
#define PG8_SA(b, h) (((b) * 2 + (h)) * HTB)
#define PG8_SB(b, h) ((4 + (b) * 2 + (h)) * HTB)
#define PG8_STAGE(bufoff, gbase, voff) do { _Pragma("unroll") for (int _i = 0; _i < 2; ++_i) \
        __builtin_amdgcn_global_load_lds((const unsigned*)((const char*)(gbase) + (voff)[_i]), (PG8_LAS unsigned*)(lds + (bufoff) + ldsw + _i * 8192), 16, 0, 0); } while (0)
#define PG8_LDA(dst, b, h) do { _Pragma("unroll") for (int m = 0; m < 4; ++m) _Pragma("unroll") for (int k = 0; k < 2; ++k) dst[m][k] = *(const PG8_LAS bf16x8*)(lds + PG8_SA(b, h) + aoff + m * 2048 + k * 1024); } while (0)
#define PG8_LDB(dst, b, h) do { _Pragma("unroll") for (int n = 0; n < 2; ++n) _Pragma("unroll") for (int k = 0; k < 2; ++k) dst[n][k] = *(const PG8_LAS bf16x8*)(lds + PG8_SB(b, h) + boff + n * 2048 + k * 1024); } while (0)
#define PG8_MMA(ai, bj, At, Bt) do { __builtin_amdgcn_s_setprio(1); _Pragma("unroll") for (int m = 0; m < 4; ++m) _Pragma("unroll") for (int n = 0; n < 2; ++n) _Pragma("unroll") for (int k = 0; k < 2; ++k) \
        acc[ai][bj][m][n] = __builtin_amdgcn_mfma_f32_16x16x32_bf16(Bt[n][k], At[m][k], acc[ai][bj][m][n], 0, 0, 0); __builtin_amdgcn_s_setprio(0); } while (0)
#define PG8_WAIT_V(n) asm volatile("s_waitcnt vmcnt(" #n ")" ::: "memory")
#define PG8_WAIT_L(n) asm volatile("s_waitcnt lgkmcnt(" #n ")" ::: "memory")
#define PG8_BAR __builtin_amdgcn_s_barrier()
#define PG8_SCHED __builtin_amdgcn_sched_barrier(0)
    Unit cur, nxt; int ui = 0;
    if (!S.next(0, cur)) return;
    f32x4 acc[2][2][4][2];
#pragma unroll
    for (int a = 0; a < 2; ++a)
#pragma unroll
        for (int b = 0; b < 2; ++b)
#pragma unroll
            for (int m = 0; m < 4; ++m)
#pragma unroll
                for (int n = 0; n < 2; ++n) acc[a][b][m][n] = (f32x4){0.f, 0.f, 0.f, 0.f};
    bf16x8 At[4][2], B0[2][2], B1[2][2];
    const char* cA = (const char*)g.A + (size_t)cur.pm * tstep + (size_t)cur.kofs * 2; const char* cB = (const char*)g.Bt + (size_t)cur.pn * tstep + (size_t)cur.kofs * 2;
    int cnt = cur.nt ? cur.nt : nt;
    S.a_ready(cur);
    if constexpr (SP2) {
        PG8_STAGE(PG8_SB(0, 0), cB, voffB); PG8_STAGE(PG8_SB(0, 1), cB + hstep, voffB); PG8_STAGE(PG8_SA(0, 0), cA, voffA); PG8_STAGE(PG8_SA(0, 1), cA + hstep, voffA);
        if (wr == 1) PG8_BAR;
        PG8_WAIT_V(2); PG8_BAR;
        PG8_STAGE(PG8_SB(1, 0), cB + kstep, voffB); PG8_STAGE(PG8_SA(1, 0), cA + kstep, voffA); PG8_STAGE(PG8_SB(1, 1), cB + hstep + kstep, voffB);
        PG8_WAIT_V(6); PG8_BAR;
    } else {
        PG8_STAGE(PG8_SB(0, 0), cB, voffB); PG8_STAGE(PG8_SA(0, 0), cA, voffA); PG8_STAGE(PG8_SB(0, 1), cB + hstep, voffB); PG8_STAGE(PG8_SA(0, 1), cA + hstep, voffA);
        if (wr == 1) PG8_BAR;
        PG8_WAIT_V(4); PG8_BAR;
        PG8_STAGE(PG8_SB(1, 0), cB + kstep, voffB); PG8_STAGE(PG8_SA(1, 0), cA + kstep, voffA); PG8_STAGE(PG8_SB(1, 1), cB + hstep + kstep, voffB);
        PG8_WAIT_V(6); PG8_BAR;
    }
    for (;;) {
        const bool has_next = S.next(ui + 1, nxt);
        const char* nA = has_next ? (const char*)g.A + (size_t)nxt.pm * tstep + (size_t)nxt.kofs * 2 : cA; const char* nB = has_next ? (const char*)g.Bt + (size_t)nxt.pn * tstep + (size_t)nxt.kofs * 2 : cB;
        for (int t = 0; t < cnt; t += 2) {
            const bool last = (t == cnt - 2);
            const char* a1 = cA + (size_t)(t + 1) * kstep;
            const char* a2 = last ? nA : cA + (size_t)(t + 2) * kstep; const char* b2 = last ? nB : cB + (size_t)(t + 2) * kstep;
            const char* a3 = a2 + kstep; const char* b3 = b2 + kstep;
            if (last && has_next) S.a_ready(nxt);
            if constexpr (SP2) {
            PG8_LDB(B0, 0, 0); PG8_LDB(B1, 0, 1); PG8_SCHED; PG8_LDA(At, 0, 0); PG8_STAGE(PG8_SA(1, 1), a1 + hstep, voffA);
            PG8_WAIT_V(8); PG8_WAIT_L(0); PG8_BAR; PG8_MMA(0, 0, At, B0); PG8_MMA(0, 1, At, B1); PG8_BAR; PG8_SCHED;
            PG8_LDA(At, 0, 1); PG8_STAGE(PG8_SB(0, 0), b2, voffB); PG8_STAGE(PG8_SB(0, 1), b2 + hstep, voffB); PG8_STAGE(PG8_SA(0, 0), a2, voffA);
            PG8_WAIT_V(8); PG8_WAIT_L(0); PG8_BAR; PG8_MMA(1, 0, At, B0); PG8_MMA(1, 1, At, B1); PG8_BAR; PG8_SCHED;
            PG8_LDB(B0, 1, 0); PG8_LDB(B1, 1, 1); PG8_SCHED; PG8_LDA(At, 1, 0); PG8_STAGE(PG8_SA(0, 1), a2 + hstep, voffA);
            PG8_WAIT_V(8); PG8_WAIT_L(0); PG8_BAR; PG8_MMA(0, 0, At, B0); PG8_MMA(0, 1, At, B1); PG8_BAR; PG8_SCHED;
            PG8_LDA(At, 1, 1); PG8_STAGE(PG8_SB(1, 0), b3, voffB); PG8_STAGE(PG8_SB(1, 1), b3 + hstep, voffB); PG8_STAGE(PG8_SA(1, 0), a3, voffA);
            PG8_WAIT_V(8); PG8_WAIT_L(0); PG8_BAR; PG8_MMA(1, 0, At, B0); PG8_MMA(1, 1, At, B1); PG8_BAR; PG8_SCHED;
            } else {
            PG8_LDB(B0, 0, 0); PG8_SCHED; PG8_LDA(At, 0, 0); PG8_STAGE(PG8_SA(1, 1), a1 + hstep, voffA);
            PG8_WAIT_L(8); PG8_BAR; PG8_WAIT_L(0); PG8_MMA(0, 0, At, B0); PG8_BAR; PG8_SCHED;
            PG8_LDB(B1, 0, 1); PG8_STAGE(PG8_SB(0, 0), b2, voffB);
            PG8_BAR; PG8_WAIT_L(0); PG8_MMA(0, 1, At, B1); PG8_BAR;
            PG8_LDA(At, 0, 1); PG8_STAGE(PG8_SA(0, 0), a2, voffA);
            PG8_BAR; PG8_WAIT_L(0); PG8_MMA(1, 0, At, B0); PG8_BAR; PG8_SCHED;
            PG8_STAGE(PG8_SB(0, 1), b2 + hstep, voffB);
            PG8_WAIT_V(6); PG8_BAR; PG8_MMA(1, 1, At, B1); PG8_BAR;
            PG8_LDB(B0, 1, 0); PG8_SCHED; PG8_LDA(At, 1, 0); PG8_STAGE(PG8_SA(0, 1), a2 + hstep, voffA);
            PG8_WAIT_L(8); PG8_BAR; PG8_WAIT_L(0); PG8_MMA(0, 0, At, B0); PG8_BAR; PG8_SCHED;
            PG8_LDB(B1, 1, 1); PG8_STAGE(PG8_SB(1, 0), b3, voffB);
            PG8_BAR; PG8_WAIT_L(0); PG8_MMA(0, 1, At, B1); PG8_BAR;
            PG8_LDA(At, 1, 1); PG8_STAGE(PG8_SA(1, 0), a3, voffA);
            PG8_BAR; PG8_WAIT_L(0); PG8_MMA(1, 0, At, B0); PG8_BAR; PG8_SCHED;
            PG8_STAGE(PG8_SB(1, 1), b3 + hstep, voffB);
            PG8_WAIT_V(6); PG8_BAR; PG8_MMA(1, 1, At, B1); PG8_BAR;
            }
        }
        if constexpr (ALIGN_EPI) { if (wr == 0) PG8_BAR; }
        if constexpr (!Epi::AFTER_DRAIN) { E(acc, cur, wr, wc, fr, fq); S.done(cur); }
        if (!has_next) break;
#pragma unroll
        for (int a = 0; a < 2; ++a)
#pragma unroll
            for (int b = 0; b < 2; ++b)
#pragma unroll
                for (int m = 0; m < 4; ++m)
#pragma unroll
                    for (int n = 0; n < 2; ++n) acc[a][b][m][n] = (f32x4){0.f, 0.f, 0.f, 0.f};
        cur = nxt; cA = nA; cB = nB; ++ui; cnt = cur.nt ? cur.nt : nt;
        if constexpr (ALIGN_EPI) { if (wr == 1) PG8_BAR; }
    }
    PG8_WAIT_V(0);
    if constexpr (!ALIGN_EPI) { if (wr == 0) PG8_BAR; }
    PG8_BAR;
    if constexpr (Epi::AFTER_DRAIN) { E.fused(acc, cur, wr, wc, fr, fq, lds, wid, lane); S.done(cur); }
#undef PG8_SA
#undef PG8_SB
#undef PG8_STAGE
#undef PG8_LDA
#undef PG8_LDB
#undef PG8_MMA
#undef PG8_WAIT_V
#undef PG8_WAIT_L
#undef PG8_BAR
#undef PG8_SCHED
}
}

namespace att {
#define ATT_LAS __attribute__((address_space(3)))
typedef unsigned short bf16_t;
using bf16x8 = __attribute__((ext_vector_type(8))) short;
using s16x4  = __attribute__((ext_vector_type(4))) short;
using f32x16 = __attribute__((ext_vector_type(16))) float;
using f32x2  = __attribute__((ext_vector_type(2))) float;
using f32x4  = __attribute__((ext_vector_type(4))) float;
using u32x4  = __attribute__((ext_vector_type(4))) unsigned;
constexpr int NW = 8, QBLK = 32, KVBLK = 64;
constexpr float SCALE = 0.07216878364870323f;
constexpr float THR = 8.f;
constexpr int SDEPTH = ATT_SDEPTH;
constexpr int LDQ = 3072, LDK = 128, LDKR = 64, LDO = 2048;
constexpr int SHM_V = KVBLK * 128 * 2, SHM_K = KVBLK * 128 * 2, SHM_KR = KVBLK * 64 * 2;
constexpr int OFF_V = 0, OFF_K = 2 * SHM_V, OFF_KR = OFF_K + 2 * SHM_K, OFF_WS = OFF_KR + 2 * SHM_KR, OFF_QR = OFF_WS + NW * 64 * 4, ATT_LDS_BYTES = OFF_QR + NW * 4096;
#define KSWZ(row, colB) ((row) * 256 + ((colB) ^ (((row) & 7) << 4)))
#define KRSWZ(row, colB) ((row) * 128 + ((colB) ^ ((((row) >> 1) & 7) << 4)))
#define SBAR() __builtin_amdgcn_sched_barrier(0)
__device__ __forceinline__ int crow(int r, int hi) { return (r & 3) + 8 * (r >> 2) + 4 * hi; }
__device__ __forceinline__ unsigned cvtpk(float lo, float hi) { unsigned r; asm volatile("v_cvt_pk_bf16_f32 %0, %1, %2" : "=v"(r) : "v"(lo), "v"(hi)); return r; }
__device__ __forceinline__ float bf2f(unsigned short b) { return __uint_as_float(((unsigned)b) << 16); }

__device__ __forceinline__ void partialSM(f32x16& p0, f32x16& p1, float& m_reg, float& mn, float& alpha) {
  constexpr float C = SCALE * 1.4426950408889634f;
  float pmax = p0[0];
#pragma unroll
  for (int r = 1; r < 16; ++r) pmax = fmaxf(pmax, p0[r]);
#pragma unroll
  for (int r = 0; r < 16; ++r) pmax = fmaxf(pmax, p1[r]);
  { auto rr = __builtin_amdgcn_permlane32_swap(__float_as_uint(pmax), __float_as_uint(pmax), false, false);
    pmax = fmaxf(__uint_as_float(rr[0]), __uint_as_float(rr[1])); }
  if (__builtin_expect(__all(pmax - m_reg <= THR / SCALE), 1)) { mn = m_reg; alpha = 1.f; }
  else { mn = fmaxf(m_reg, pmax); alpha = __builtin_amdgcn_exp2f((m_reg - mn) * C); m_reg = mn; }
  float mnC = -mn * C;
#pragma unroll
  for (int r = 0; r < 16; ++r) p0[r] = fmaf(p0[r], C, mnC);
#pragma unroll
  for (int r = 0; r < 16; ++r) p1[r] = fmaf(p1[r], C, mnC);
#pragma unroll
  for (int r = 0; r < 16; ++r) p0[r] = __builtin_amdgcn_exp2f(p0[r]);
}
__device__ __forceinline__ void finishSM(f32x16& p0, f32x16& p1, float alpha, float& l_reg, bf16x8& pa0, bf16x8& pa1, bf16x8& pa2, bf16x8& pa3) {
#pragma unroll
  for (int r = 0; r < 16; ++r) p1[r] = __builtin_amdgcn_exp2f(p1[r]);
  float ps = 0;
#pragma unroll
  for (int r = 0; r < 16; ++r) ps += p0[r];
#pragma unroll
  for (int r = 0; r < 16; ++r) ps += p1[r];
  { auto rr = __builtin_amdgcn_permlane32_swap(__float_as_uint(ps), __float_as_uint(ps), false, false);
    ps = __uint_as_float(rr[0]) + __uint_as_float(rr[1]); }
  l_reg = l_reg * alpha + ps;
#define PK4(P, BASE, OUT) do { unsigned a0 = cvtpk(P[BASE + 0], P[BASE + 1]), a1 = cvtpk(P[BASE + 2], P[BASE + 3]);   \
    unsigned b0 = cvtpk(P[BASE + 4], P[BASE + 5]), b1 = cvtpk(P[BASE + 6], P[BASE + 7]);                              \
    auto r0 = __builtin_amdgcn_permlane32_swap(a0, b0, false, false); auto r1 = __builtin_amdgcn_permlane32_swap(a1, b1, false, false); \
    u32x4 w = {r0[0], r1[0], r0[1], r1[1]}; OUT = *reinterpret_cast<bf16x8*>(&w); } while (0)
  PK4(p0, 0, pa0); PK4(p0, 8, pa1); PK4(p1, 0, pa2); PK4(p1, 8, pa3);
#undef PK4
}
__device__ __forceinline__ void qkt(f32x16& p0, f32x16& p1, const ATT_LAS char* Ks, const ATT_LAS char* Kr, const ATT_LAS char* Qr, const bf16x8* qr, int r32, int hi) {
  p0 = f32x16{}; p1 = f32x16{};
#pragma unroll
  for (int d0 = 0; d0 < 8; ++d0) { const int cb = (d0 * 16 + hi * 8) * 2;
    bf16x8 b0 = *reinterpret_cast<const ATT_LAS bf16x8*>(Ks + KSWZ(r32, cb));
    bf16x8 b1 = *reinterpret_cast<const ATT_LAS bf16x8*>(Ks + KSWZ(32 + r32, cb));
    p0 = __builtin_amdgcn_mfma_f32_32x32x16_bf16(b0, qr[d0], p0, 0, 0, 0);
    p1 = __builtin_amdgcn_mfma_f32_32x32x16_bf16(b1, qr[d0], p1, 0, 0, 0); }
#pragma unroll
  for (int d1 = 0; d1 < 4; ++d1) { const int cb = (d1 * 16 + hi * 8) * 2;
    bf16x8 b0 = *reinterpret_cast<const ATT_LAS bf16x8*>(Kr + KRSWZ(r32, cb));
    bf16x8 b1 = *reinterpret_cast<const ATT_LAS bf16x8*>(Kr + KRSWZ(32 + r32, cb));
    bf16x8 qq = *reinterpret_cast<const ATT_LAS bf16x8*>(Qr + KRSWZ(r32, cb));
    p0 = __builtin_amdgcn_mfma_f32_32x32x16_bf16(b0, qq, p0, 0, 0, 0);
    p1 = __builtin_amdgcn_mfma_f32_32x32x16_bf16(b1, qq, p1, 0, 0, 0); }
}
__device__ __forceinline__ int v_st(int k, int c) { const int kk = (k & ~0xC) | ((k & 4) << 1) | ((k & 8) >> 1); return ((kk >> 3) * 4 + (c >> 5)) * 512 + ((kk & 7) * 32 + (c & 31)) * 2; }
__device__ __forceinline__ int v_rd_base(int lane) { return ((lane & 3) << 3) | (((lane >> 2) & 3) << 6) | (((lane >> 4) & 1) << 5) | (((lane >> 5) & 1) << 8); }
constexpr int v_rd_off(int d0, int ks, int half) { return d0 * 512 + ks * 4096 + half * 2048; }
template <int OFF> __device__ __forceinline__ s16x4 tr_read(int vb) {
  s16x4 r; asm volatile("ds_read_b64_tr_b16 %0, %1 offset:%2" : "=&v"(r) : "v"(vb), "i"(OFF) : "memory"); return r;
}
template <int D0> __device__ __forceinline__ void pv_one(f32x16& od, int vb, bf16x8 pa0, bf16x8 pa1, bf16x8 pa2, bf16x8 pa3) {
  const s16x4 l0 = tr_read<v_rd_off(D0, 0, 0)>(vb), h0 = tr_read<v_rd_off(D0, 0, 1)>(vb), l1 = tr_read<v_rd_off(D0, 1, 0)>(vb), h1 = tr_read<v_rd_off(D0, 1, 1)>(vb);
  const s16x4 l2 = tr_read<v_rd_off(D0, 2, 0)>(vb), h2 = tr_read<v_rd_off(D0, 2, 1)>(vb), l3 = tr_read<v_rd_off(D0, 3, 0)>(vb), h3 = tr_read<v_rd_off(D0, 3, 1)>(vb);
  asm volatile("s_waitcnt lgkmcnt(0)" ::: "memory"); SBAR();
#define PK(L, H) (bf16x8){L[0], L[1], L[2], L[3], H[0], H[1], H[2], H[3]}
  od = __builtin_amdgcn_mfma_f32_32x32x16_bf16(pa0, PK(l0, h0), od, 0, 0, 0);
  od = __builtin_amdgcn_mfma_f32_32x32x16_bf16(pa1, PK(l1, h1), od, 0, 0, 0);
  od = __builtin_amdgcn_mfma_f32_32x32x16_bf16(pa2, PK(l2, h2), od, 0, 0, 0);
  od = __builtin_amdgcn_mfma_f32_32x32x16_bf16(pa3, PK(l3, h3), od, 0, 0, 0);
#undef PK
}
__device__ __forceinline__ void pv_d0(f32x16* o, int vb, bf16x8 pa0, bf16x8 pa1, bf16x8 pa2, bf16x8 pa3) {
  pv_one<0>(o[0], vb, pa0, pa1, pa2, pa3); pv_one<1>(o[1], vb, pa0, pa1, pa2, pa3); pv_one<2>(o[2], vb, pa0, pa1, pa2, pa3); pv_one<3>(o[3], vb, pa0, pa1, pa2, pa3);
}

__device__ __forceinline__ void attn_unit(const bf16_t* Qb, const bf16_t* Kh, const bf16_t* Vh, const bf16_t* KRb, bf16_t* Ob,
                                          int xrow0, int nx, int crow0, int NT, int rope, int pos0, const f32x2* ropeR, const f32x2* ropeC, ATT_LAS char* lds, int wave_sgpr) {
  int tid_ = tid_from_wave(wave_sgpr);
  const int tid = tid_, wid = tid >> 6, lane = tid & 63, r32 = lane & 31, hi = lane >> 5;
  ATT_LAS char* V_lds = lds + OFF_V; ATT_LAS char* K_lds = lds + OFF_K; ATT_LAS char* KR_lds = lds + OFF_KR;
  ATT_LAS float* ws = (ATT_LAS float*)(lds + OFF_WS) + wid * 64; ATT_LAS float* li_l = ws; ATT_LAS float* al_l = ws + 32;
  float m_reg = -1e30f, l_reg = 0; f32x16 o[4] = {}; bf16x8 qr[8];
  ATT_LAS char* QR_lds = lds + OFF_QR + wid * 4096;
  const bf16_t* Qw = Qb + (long)(wid * QBLK + r32) * LDQ + hi * 8;
#pragma unroll
  for (int d0 = 0; d0 < 8; ++d0) qr[d0] = *reinterpret_cast<const bf16x8*>(Qw + d0 * 16);
  {
  bf16x8 q8 = *reinterpret_cast<const bf16x8*>(Qw + 8 * 16), q9 = *reinterpret_cast<const bf16x8*>(Qw + 9 * 16), q10 = *reinterpret_cast<const bf16x8*>(Qw + 10 * 16), q11 = *reinterpret_cast<const bf16x8*>(Qw + 11 * 16);
  if (rope) {
    const int pos = pos0 + wid * QBLK + r32; const f32x2* tr = ropeR + (pos >> 6) * 16 + hi * 8; const f32x2* tc = ropeC + (pos & 63) * 16 + hi * 8;
    bf16x8 n8, n9, n10, n11;
#pragma unroll
    for (int e = 0; e < 8; ++e) {
      const f32x2 cr = tr[e], cc = tc[e];
      const float a1 = bf2f((unsigned short)q8[e]), a2 = bf2f((unsigned short)q9[e]), b1 = bf2f((unsigned short)q10[e]), b2 = bf2f((unsigned short)q11[e]);
      const unsigned w0 = cvtpk(a1 * cr.x - a2 * cr.y, a2 * cr.x + a1 * cr.y), w1 = cvtpk(b1 * cc.x - b2 * cc.y, b2 * cc.x + b1 * cc.y);
      n8[e] = (short)(w0 & 0xffffu); n9[e] = (short)(w0 >> 16); n10[e] = (short)(w1 & 0xffffu); n11[e] = (short)(w1 >> 16);
    }
    q8 = n8; q9 = n9; q10 = n10; q11 = n11;
  }
  *(ATT_LAS bf16x8*)(QR_lds + KRSWZ(r32, (0 * 16 + hi * 8) * 2)) = q8; *(ATT_LAS bf16x8*)(QR_lds + KRSWZ(r32, (1 * 16 + hi * 8) * 2)) = q9;
  *(ATT_LAS bf16x8*)(QR_lds + KRSWZ(r32, (2 * 16 + hi * 8) * 2)) = q10; *(ATT_LAS bf16x8*)(QR_lds + KRSWZ(r32, (3 * 16 + hi * 8) * 2)) = q11;
  }
  const int sr = tid >> 4, sc = (tid & 15) * 8, vst0 = v_st(sr, sc), vst1 = v_st(32 + sr, sc);
  const int krs = tid >> 3, krc = (tid & 7) * 8, krst = KRSWZ(krs, krc * 2);
  const int vb0 = (int)(uintptr_t)V_lds + v_rd_base(lane);
  struct { bf16x8 vs0, vs1, ks0, ks1, kr; } sr_[SDEPTH];
#define TROW(j) ((j) < nx ? (long)xrow0 + (long)(j) * KVBLK : (long)crow0 + (long)((j) - nx) * KVBLK)
#define SLOAD(i, j) do { const long _k0 = TROW(j); \
    sr_[i].vs0 = *reinterpret_cast<const bf16x8*>(&Vh[(_k0 + sr) * LDK + sc]); sr_[i].vs1 = *reinterpret_cast<const bf16x8*>(&Vh[(_k0 + 32 + sr) * LDK + sc]); \
    sr_[i].ks0 = *reinterpret_cast<const bf16x8*>(&Kh[(_k0 + sr) * LDK + sc]); sr_[i].ks1 = *reinterpret_cast<const bf16x8*>(&Kh[(_k0 + 32 + sr) * LDK + sc]); \
    sr_[i].kr = *reinterpret_cast<const bf16x8*>(&KRb[(_k0 + krs) * LDKR + krc]); } while (0)
#define SWRITE(b, i) do { *(ATT_LAS bf16x8*)(V_lds + (b) * SHM_V + vst0) = sr_[i].vs0;          \
    *(ATT_LAS bf16x8*)(V_lds + (b) * SHM_V + vst1) = sr_[i].vs1; const int kc = sc * 2;               \
    *(ATT_LAS bf16x8*)(K_lds + (b) * SHM_K + KSWZ(sr, kc)) = sr_[i].ks0;                       \
    *(ATT_LAS bf16x8*)(K_lds + (b) * SHM_K + KSWZ(32 + sr, kc)) = sr_[i].ks1;                  \
    *(ATT_LAS bf16x8*)(KR_lds + (b) * SHM_KR + krst) = sr_[i].kr; } while (0)
#define SWAIT() do { if constexpr (SDEPTH == 2) asm volatile("s_waitcnt vmcnt(5)" ::: "memory"); else asm volatile("s_waitcnt vmcnt(0)" ::: "memory"); } while (0)
#define RESC(a) do { if (__any((a) < 1.f)) { if (hi == 0) al_l[r32] = (a); asm volatile("s_waitcnt lgkmcnt(0)" ::: "memory"); \
    _Pragma("unroll") for (int d = 0; d < 4; ++d) _Pragma("unroll") for (int r = 0; r < 16; ++r) o[d][r] *= al_l[crow(r, hi)]; } } while (0)
  f32x16 pA0, pA1, pB0, pB1; float mnA, mnB, alA, alB; bf16x8 pa0, pa1, pa2, pa3;
  constexpr int SE = 0, SO = SDEPTH - 1;
  SLOAD(SE, 0); asm volatile("s_waitcnt vmcnt(0)" ::: "memory"); SWRITE(0, SE); __syncthreads();
  qkt(pA0, pA1, K_lds, KR_lds, QR_lds, qr, r32, hi); partialSM(pA0, pA1, m_reg, mnA, alA);
  SLOAD(SO, 1); if constexpr (SDEPTH == 2) { if (2 < NT) SLOAD(SE, 2); }
  SWAIT(); SWRITE(1, SO); __syncthreads();
  for (int j = 1; j + 1 < NT; j += 2) {
    SBAR(); qkt(pB0, pB1, K_lds + SHM_K, KR_lds + SHM_KR, QR_lds, qr, r32, hi);
    finishSM(pA0, pA1, alA, l_reg, pa0, pa1, pa2, pa3); SBAR();
    SLOAD(SO, j + SDEPTH); SBAR();
    pv_d0(o, vb0, pa0, pa1, pa2, pa3); partialSM(pB0, pB1, m_reg, mnB, alB);
    __syncthreads(); SWAIT(); SWRITE(0, SE);
    RESC(alB); __syncthreads();
    SBAR(); qkt(pA0, pA1, K_lds, KR_lds, QR_lds, qr, r32, hi);
    finishSM(pB0, pB1, alB, l_reg, pa0, pa1, pa2, pa3); SBAR();
    if (SDEPTH == 1 || j + 3 < NT) SLOAD(SE, j + 1 + SDEPTH); SBAR();
    pv_d0(o, vb0 + SHM_V, pa0, pa1, pa2, pa3); partialSM(pA0, pA1, m_reg, mnA, alA);
    __syncthreads(); SWAIT(); SWRITE(1, SO);
    RESC(alA); __syncthreads();
  }
  SBAR(); qkt(pB0, pB1, K_lds + SHM_K, KR_lds + SHM_KR, QR_lds, qr, r32, hi);
  finishSM(pA0, pA1, alA, l_reg, pa0, pa1, pa2, pa3); SBAR();
  pv_d0(o, vb0, pa0, pa1, pa2, pa3); partialSM(pB0, pB1, m_reg, mnB, alB);
  __syncthreads(); RESC(alB);
  finishSM(pB0, pB1, alB, l_reg, pa0, pa1, pa2, pa3); SBAR();
  pv_d0(o, vb0 + SHM_V, pa0, pa1, pa2, pa3);
  {
  int te = tid_from_wave(wave_sgpr);
  const int widE = te >> 6, r32E = te & 31, hiE = (te >> 5) & 1;
  ATT_LAS float* liE = (ATT_LAS float*)(lds + OFF_WS) + widE * 64;
  if (hiE == 0) liE[r32E] = l_reg; asm volatile("s_waitcnt lgkmcnt(0)" ::: "memory");
  float rli[16];
#pragma unroll
  for (int r = 0; r < 16; ++r) rli[r] = __builtin_amdgcn_rcpf(liE[crow(r, hiE)]);
  ATT_LAS char* slab = lds + OFF_QR + widE * 4096;
  const int laneE = te & 63;
  bf16_t* Ow = Ob + (long)(widE * QBLK) * LDO;
#pragma unroll
  for (int half = 0; half < 2; ++half) {
#pragma unroll
    for (int r = 0; r < 16; ++r) { const int orow = crow(r, hiE);
#pragma unroll
      for (int dd = 0; dd < 2; ++dd) { const unsigned w = cvtpk(o[2 * half + dd][r] * rli[r], 0.f);
        *(ATT_LAS unsigned short*)(slab + orow * 128 + (32 * dd + r32E) * 2) = (unsigned short)(w & 0xffffu); } }
    asm volatile("s_waitcnt lgkmcnt(0)" ::: "memory");
    u32x4 ch[4];
#pragma unroll
    for (int i = 0; i < 4; ++i) { const int c = laneE + 64 * i; ch[i] = *(const ATT_LAS u32x4*)(slab + (c >> 3) * 128 + (c & 7) * 16); }
    asm volatile("s_waitcnt lgkmcnt(0)" ::: "memory");
#pragma unroll
    for (int i = 0; i < 4; ++i) { const int c = laneE + 64 * i; *reinterpret_cast<u32x4*>(Ow + (long)(c >> 3) * LDO + 64 * half + (c & 7) * 8) = ch[i]; }
  }
  }
  __syncthreads();
#undef TROW
#undef SLOAD
#undef SWRITE
#undef SWAIT
#undef RESC
}
#undef KSWZ
#undef KRSWZ
#undef SBAR
}

constexpr int NWAVES = 8;
constexpr int DM = 2048, BATCH = 2, SEQ = 16384, CTXL = 256, DEPTH = 4, DFF = 5632, NH = 16;
constexpr int M_X = BATCH * SEQ;
constexpr int M_C = BATCH * CTXL;
constexpr int M_T = M_X + M_C;
constexpr int QLR = 512, KVLR = 512, ROPE_D = 64, NDQKV = 1280;
constexpr float LN_EPS = 1e-5f, RMS_EPS = 1e-6f;
constexpr float DN_ALPHA = 1.6817928305074290f;

constexpr size_t MiB = 1u << 20;
constexpr size_t WS_CTL = 0, CTL_ZERO_BYTES = 1 * MiB;
constexpr size_t WS_MOD = 1 * MiB;
constexpr size_t WS_ROPER = WS_MOD + 640 * 1024, WS_ROPEC = WS_MOD + 680 * 1024;
constexpr size_t WS_W = 2 * MiB;
constexpr size_t W_CONV_STRIDE = 32 * MiB, W_WIN = 0, W_WOUT = 24 * MiB;
constexpr size_t W_MLA_BASE = 64 * MiB, W_MLA_STRIDE = 20 * MiB, W_DQKV = 0, W_UQ = 5 * MiB, W_UKV = 8 * MiB, W_WO = 12 * MiB;
constexpr size_t W_FFN_BASE = 104 * MiB, W_FFN_STRIDE = 66 * MiB, W_UP = 0, W_DOWN = 44 * MiB;
constexpr size_t WS_X32C = 370 * MiB;
constexpr size_t WS_BIG = 374 * MiB;
constexpr size_t BIG_BB = 0, BIG_HALOC = 132 * MiB, BIG_GATED = 390 * MiB;
constexpr size_t BIG_KRRAW = 130 * MiB, BIG_SSQ = 140 * MiB;
constexpr size_t BIG_QKVC = 0, BIG_CQ = 163 * MiB, BIG_CKV = 196 * MiB, BIG_KR = 229 * MiB, BIG_Q = 234 * MiB, BIG_K = 429 * MiB, BIG_V = 559 * MiB, BIG_O = 0;
constexpr size_t BIG_HALO = 0, BIG_ACT = 128 * MiB;
constexpr size_t WS_ACT = 1089 * MiB;
constexpr size_t WS_STATS = 1220 * MiB;
constexpr size_t WS_T16 = 1222 * MiB;
constexpr size_t WS_END = 1447 * MiB;
static_assert(WS_BIG + 715 * MiB <= WS_ACT && WS_ACT + (size_t)M_T * DM * 2 <= WS_END && BIG_HALO + (size_t)(M_T / 64) * 4 * 11264 * 4 <= BIG_ACT && BIG_ACT + (size_t)M_T * DFF * 2 <= 715 * MiB, "d_ws map");
static_assert(BIG_V + (size_t)M_T * 2048 * 2 <= 715 * MiB && BIG_KR + (size_t)M_T * 64 * 2 <= BIG_Q && BIG_QKVC + (size_t)M_T * NDQKV * 4 <= BIG_CQ, "MLA overlay");
constexpr int CW_TMO = 0, CW_CODE = 1, CW_BAR = 4096;

constexpr int RING_OFF = 0, RING_BYTES = 131072;
constexpr int LDSCTL_OFF = RING_BYTES, MISC_OFF = LDSCTL_OFF + 320;
constexpr int LDS_BYTES = 147456;
static_assert(att::ATT_LDS_BYTES <= RING_BYTES, "attention LDS");

#define GAS __attribute__((address_space(1)))
#define LAS __attribute__((address_space(3)))
typedef unsigned short bf16;
typedef unsigned v4u __attribute__((ext_vector_type(4)));
typedef unsigned v2u __attribute__((ext_vector_type(2)));
typedef float f32x4 __attribute__((ext_vector_type(4)));
typedef float f32x2 __attribute__((ext_vector_type(2)));
typedef short bf16x8 __attribute__((ext_vector_type(8)));
typedef _Float16 f16x8 __attribute__((ext_vector_type(8)));
typedef GAS unsigned gu32;
#define RLX_AGENT __ATOMIC_RELAXED, __HIP_MEMORY_SCOPE_AGENT
#define LDS_WAIT() asm volatile("s_waitcnt lgkmcnt(0)" ::: "memory")
#define VM_WAIT() asm volatile("s_waitcnt vmcnt(0)" ::: "memory")
__device__ __forceinline__ unsigned f2bf(float f) { unsigned u = __builtin_bit_cast(unsigned, f); return (u + 0x7fffu + ((u >> 16) & 1u)) >> 16; }
__device__ __forceinline__ unsigned pk2(float lo, float hi) { return f2bf(lo) | (f2bf(hi) << 16); }
__device__ __forceinline__ float bflo(unsigned w) { return __uint_as_float(w << 16); }
__device__ __forceinline__ float bfhi(unsigned w) { return __uint_as_float(w & 0xffff0000u); }
__device__ __forceinline__ float lane_xor(float v, int lane, int o) { return __builtin_bit_cast(float, __builtin_amdgcn_ds_bpermute((lane ^ o) << 2, __builtin_bit_cast(int, v))); }
__device__ __forceinline__ float wave_sum(float v, int lane) {
#pragma unroll
    for (int o = 1; o < 64; o <<= 1) v += lane_xor(v, lane, o);
    return v;
}
__device__ __forceinline__ float silu_f(float x) { return x / (1.0f + __expf(-x)); }
#define XB_TMO      128
#define XB_XCNT(j)  (256  + 64 * (j))
#define XB_XSUB(j)  (1280 + 64 * (j))
#define XB_XGEN(j)  (2304 + 64 * (j))
#define XB_TOP      3328
#define XB_TOPGEN   3392
#define XCD_BAR_WORDS 3456
#define XB_SPIN_CAP (1u << 18)

__device__ __forceinline__ unsigned xb_ld(unsigned* p)              { return __hip_atomic_load(p, __ATOMIC_RELAXED, __HIP_MEMORY_SCOPE_AGENT); }
__device__ __forceinline__ unsigned xb_add(unsigned* p, unsigned v) { return __hip_atomic_fetch_add(p, v, __ATOMIC_RELAXED, __HIP_MEMORY_SCOPE_AGENT); }
__device__ __forceinline__ unsigned xb_xcc_id() { return (unsigned)__builtin_amdgcn_s_getreg((3 << 11) | 20) & 0xFu; }
#define XB_SPIN(cond, bar) do { unsigned _sp = 0; while (cond) { __builtin_amdgcn_s_sleep(1); \
    if ((++_sp & 255u) == 0u) { if (xb_ld(&(bar)[XB_TMO])) break; if (_sp > XB_SPIN_CAP) { atomicAdd(&(bar)[XB_TMO], 1u); break; } } } } while (0)

struct XcdBarrier {
    unsigned* bar; unsigned x;
    volatile LAS unsigned* st;
};

__device__ __forceinline__ XcdBarrier xcd_barrier_post(unsigned* bar, volatile LAS unsigned* st, bool leader) {
    XcdBarrier b; b.bar = bar; b.x = xb_xcc_id(); b.st = st;
    if (leader) (void)xb_add(&bar[XB_XCNT(b.x)], 1u);
    return b;
}
__device__ __forceinline__ void xcd_barrier_complete(unsigned* bar, unsigned x, unsigned& nloc, unsigned& nx) {
    const unsigned G = gridDim.x * gridDim.y * gridDim.z;
    unsigned sum, cnt, mine, sp = 0u;
    for (;;) {
        sum = 0u; cnt = 0u; mine = 0u;
#pragma unroll
        for (unsigned j = 0; j < 16; ++j) { const unsigned c = xb_ld(&bar[XB_XCNT(j)]); sum += c; cnt += (c > 0u) ? 1u : 0u; mine = (j == x) ? c : mine; }
        if (sum == G) break;
        __builtin_amdgcn_s_sleep(1);
        if ((++sp & 255u) == 0u) { if (xb_ld(&bar[XB_TMO])) break; if (sp > XB_SPIN_CAP) { atomicAdd(&bar[XB_TMO], 1u); break; } }
    }
    nloc = mine > 0u ? mine : 1u; nx = cnt > 0u ? cnt : 1u;
}

__device__ __forceinline__ void xcd_barrier(const XcdBarrier& b, bool leader) {
    asm volatile("s_waitcnt vmcnt(0)" ::: "memory");
    __syncthreads();
    if (leader) {
        unsigned* bar = b.bar;
        __builtin_amdgcn_s_waitcnt(0);
        unsigned nloc = b.st[0], nx = b.st[1];
        if (nloc == 0u) { xcd_barrier_complete(bar, b.x, nloc, nx); b.st[0] = nloc; b.st[1] = nx; }
        const unsigned old = xb_add(&bar[XB_XSUB(b.x)], 1u);
        const unsigned gen = old / nloc;
        if (old + 1u == (gen + 1u) * nloc) {
            __builtin_amdgcn_fence(__ATOMIC_RELEASE, "agent");
            asm volatile("s_waitcnt vmcnt(0)" ::: "memory");
            const unsigned og = xb_add(&bar[XB_TOP], 1u);
            const unsigned tg = og / nx;
            if (og + 1u == (tg + 1u) * nx) xb_add(&bar[XB_TOPGEN], 1u);
            else XB_SPIN(xb_ld(&bar[XB_TOPGEN]) == tg, bar);
            __builtin_amdgcn_fence(__ATOMIC_ACQUIRE, "agent");
            xb_add(&bar[XB_XGEN(b.x)], 1u);
            asm volatile("s_waitcnt vmcnt(0)" ::: "memory");
        } else {
            XB_SPIN(xb_ld(&bar[XB_XGEN(b.x)]) == gen, bar);
            __builtin_amdgcn_fence(__ATOMIC_ACQUIRE, "agent");
            asm volatile("s_waitcnt vmcnt(0)" ::: "memory");
        }
    }
    __syncthreads();
}

constexpr int PTAB_OFF = MISC_OFF + 128;
struct Frame {
    LAS unsigned char* lds;
    int tid, lane, wave, wave0;
    int vcu, G, bx;
    float* out; unsigned char* ws;
    __device__ __forceinline__ const float* ptr(int i) const {
        const volatile LAS unsigned* t = (const volatile LAS unsigned*)(lds + PTAB_OFF) + 2 * i;
        const unsigned lo = __builtin_amdgcn_readfirstlane(t[0]), hi = __builtin_amdgcn_readfirstlane(t[1]);
        return (const float*)((const GAS float*)(((unsigned long long)hi << 32) | lo)); }
    __device__ __forceinline__ const float* in(int i) const { return ptr(i); }
};
__device__ __forceinline__ void make_frame(Frame& F, LAS unsigned char* lds, int wave_sgpr) {
    const int t = tid_from_wave(wave_sgpr);
    int g = gridDim.x, bx = blockIdx.x; asm volatile("" : "+s"(g), "+s"(bx));
    F.lds = lds; F.tid = t; F.lane = t & 63; F.wave = __builtin_amdgcn_readfirstlane(t >> 6); F.wave0 = wave_sgpr;
    F.G = g; F.bx = bx; F.vcu = (g % 8 == 0) ? (bx % 8) * (g / 8) + bx / 8 : bx;
    F.out = (float*)F.ptr(25); F.ws = (unsigned char*)F.ptr(26);
}
__device__ __forceinline__ bf16* wsb(const Frame& F, size_t off) { return (bf16*)(F.ws + off); }
__device__ __forceinline__ float* wsf(const Frame& F, size_t off) { return (float*)(F.ws + off); }

__device__ __forceinline__ void p0_transpose_item(const float* W, int K, int N, bf16* WT, int row_off, LAS float* scr, int item, int lane, const float* kscale = nullptr) {
    const int nblk = N / 32, kb = item / nblk, nb = item % nblk, k0 = 64 * kb, n0 = 32 * nb;
    float tv[32];
#pragma unroll
    for (int i = 0; i < 32; ++i) { const int kk = 2 * i + (lane >> 5); tv[i] = W[(size_t)(k0 + kk) * N + n0 + (lane & 31)]; }
#pragma unroll
    for (int i = 0; i < 32; ++i) { const int kk = 2 * i + (lane >> 5); scr[kk * 33 + (lane & 31)] = kscale ? tv[i] * kscale[k0 + kk] : tv[i]; }
    LDS_WAIT(); asm volatile("" ::: "memory");
    const int c = lane & 7;
#pragma unroll
    for (int j = 0; j < 4; ++j) { const int n = (lane >> 3) + 8 * j; const LAS float* s = scr + (8 * c) * 33 + n;
        v4u o; o.x = pk2(s[0 * 33], s[1 * 33]); o.y = pk2(s[2 * 33], s[3 * 33]); o.z = pk2(s[4 * 33], s[5 * 33]); o.w = pk2(s[6 * 33], s[7 * 33]);
        *(GAS v4u*)(WT + (size_t)(row_off + n0 + n) * K + k0 + 8 * c) = o; }
    LDS_WAIT(); asm volatile("" ::: "memory");
}

__device__ __forceinline__ void p0_prologue(Frame& F) {
    if (F.vcu < 192) {
        LAS float* sl = (LAS float*)(F.lds);
        LAS float* part = (LAS float*)(F.lds + 32768);
        for (int idx = F.tid; idx < 3 * DM; idx += NWAVES * 64) { const int rt = idx / DM, k = idx % DM; const float v = rt < 2 ? F.in(1)[rt * DM + k] : F.in(3)[k]; sl[idx] = silu_f(v); }
        __syncthreads();
        const int layer = F.vcu / 48, cg = F.vcu % 48;
        const float* Wp = F.in(4) + (size_t)layer * DM * 12288 + cg * 256 + F.lane * 4;
        f32x4 a0 = {0.f, 0.f, 0.f, 0.f}, a1 = a0, a2 = a0;
        const int kb = F.wave * 256;
#pragma unroll 8
        for (int k = kb; k < kb + 256; ++k) { const f32x4 w = *(const GAS f32x4*)(Wp + (size_t)k * 12288); a0 += w * sl[k]; a1 += w * sl[DM + k]; a2 += w * sl[2 * DM + k]; }
        *(LAS f32x4*)(part + (F.wave * 3 + 0) * 256 + F.lane * 4) = a0; *(LAS f32x4*)(part + (F.wave * 3 + 1) * 256 + F.lane * 4) = a1; *(LAS f32x4*)(part + (F.wave * 3 + 2) * 256 + F.lane * 4) = a2;
        __syncthreads();
        for (int idx = F.tid; idx < 768; idx += NWAVES * 64) { const int rt = idx >> 8, cl = idx & 255; float s = 0.f;
#pragma unroll
            for (int w = 0; w < 8; ++w) s += part[(w * 3 + rt) * 256 + cl];
            const int n = cg * 256 + cl, chunk = n / DM; float val = s + F.in(5)[layer * 12288 + n]; if (chunk == 1 || chunk == 4) val += 1.0f;
            wsf(F, WS_MOD)[(layer * 3 + rt) * 12288 + n] = val; }
        __syncthreads();
    } else if (F.vcu == 192) {
        for (int idx = F.tid; idx < 256 * 16 + 64 * 16; idx += NWAVES * 64) {
            const int e = idx < 4096 ? idx : idx - 4096, pos = e >> 4, f = e & 15;
            const float inv = 1.0f / powf(10000.0f, (float)f / 16.0f), ang = (float)pos * inv; float sn, cs; sincosf(ang, &sn, &cs);
            f32x2* t = (f32x2*)(F.ws + (idx < 4096 ? WS_ROPER : WS_ROPEC)); t[e] = (f32x2){cs, sn}; }
    }
    LAS float* scr = (LAS float*)(F.lds + RING_OFF + F.wave * 16384);
    const int gw = F.vcu * NWAVES + F.wave, NGW = F.G * NWAVES;
    constexpr int C0 = 32 * 192, C1 = 32 * 64, C2 = 32 * 16, C3 = 32 * 18, C4 = 8 * 96, C5 = 8 * 64, C6 = 8 * 64, C7 = 32 * 64, C8 = 32 * 352, C9 = 88 * 64, C10 = 192;
    constexpr int NITEMS = 2 * (C0 + C1 + C2 + C3 + C4 + C5 + C6 + C7 + C10) + 4 * (C8 + C9);
    for (int it = gw; it < NITEMS; it += NGW) {
        int r = it;
        if (r < 4 * C8) { const int l = r / C8, item = r % C8, n0 = 32 * (item % 352);
            const int m0 = n0 < DFF ? n0 : n0 - DFF, dst = (m0 >> 7) * 256 + (n0 < DFF ? 0 : 128) + (m0 & 127);
            p0_transpose_item(F.in(21) + (size_t)l * DM * 11264, DM, 11264, wsb(F, WS_W + W_FFN_BASE + l * W_FFN_STRIDE + W_UP), dst - n0, scr, item, F.lane); continue; } r -= 4 * C8;
        if (r < 4 * C9) { const int l = r / C9; p0_transpose_item(F.in(24) + (size_t)l * DFF * DM, DFF, DM, wsb(F, WS_W + W_FFN_BASE + l * W_FFN_STRIDE + W_DOWN), 0, scr, r % C9, F.lane); continue; } r -= 4 * C9;
        if (r < 2 * C0) { const int l = r / C0, item = r % C0, n0 = 32 * (item % 192);
            const int m0 = n0 < 4096 ? n0 - 2048 : n0 - 4096, dst = n0 < 2048 ? n0 : 2048 + (m0 >> 7) * 256 + (n0 < 4096 ? 0 : 128) + (m0 & 127);
            p0_transpose_item(F.in(10) + (size_t)l * DM * 6144, DM, 6144, wsb(F, WS_W + l * W_CONV_STRIDE + W_WIN), dst - n0, scr, item, F.lane); continue; } r -= 2 * C0;
        if (r < 2 * C1) { const int l = r / C1; p0_transpose_item(F.in(12) + (size_t)l * DM * DM, DM, DM, wsb(F, WS_W + l * W_CONV_STRIDE + W_WOUT), 0, scr, r % C1, F.lane); continue; } r -= 2 * C1;
        if (r < 2 * C2) { const int l = r / C2; p0_transpose_item(F.in(13) + (size_t)l * DM * QLR, DM, QLR, wsb(F, WS_W + W_MLA_BASE + l * W_MLA_STRIDE + W_DQKV), 0, scr, r % C2, F.lane); continue; } r -= 2 * C2;
        if (r < 2 * C3) { const int l = r / C3; p0_transpose_item(F.in(16) + (size_t)l * DM * 576, DM, 576, wsb(F, WS_W + W_MLA_BASE + l * W_MLA_STRIDE + W_DQKV), 512, scr, r % C3, F.lane); continue; } r -= 2 * C3;
        if (r < 2 * C4) { const int l = r / C4; p0_transpose_item(F.in(15) + (size_t)l * QLR * 3072, QLR, 3072, wsb(F, WS_W + W_MLA_BASE + l * W_MLA_STRIDE + W_UQ), 0, scr, r % C4, F.lane, F.in(14) + l * QLR); continue; } r -= 2 * C4;
        if (r < 2 * C5) { const int l = r / C5; p0_transpose_item(F.in(18) + (size_t)l * KVLR * 2048, KVLR, 2048, wsb(F, WS_W + W_MLA_BASE + l * W_MLA_STRIDE + W_UKV), 0, scr, r % C5, F.lane, F.in(17) + l * KVLR); continue; } r -= 2 * C5;
        if (r < 2 * C6) { const int l = r / C6; p0_transpose_item(F.in(19) + (size_t)l * KVLR * 2048, KVLR, 2048, wsb(F, WS_W + W_MLA_BASE + l * W_MLA_STRIDE + W_UKV), 2048, scr, r % C6, F.lane, F.in(17) + l * KVLR); continue; } r -= 2 * C6;
        if (r < 2 * C7) { const int l = r / C7; p0_transpose_item(F.in(20) + (size_t)l * DM * DM, DM, DM, wsb(F, WS_W + W_MLA_BASE + l * W_MLA_STRIDE + W_WO), 0, scr, r % C7, F.lane); continue; } r -= 2 * C7;
        { const int l = r / C10, row = 1088 + r % C10; bf16* d = wsb(F, WS_W + W_MLA_BASE + l * W_MLA_STRIDE + W_DQKV) + (size_t)row * DM;
#pragma unroll
          for (int j = 0; j < 4; ++j) *(GAS v4u*)(d + j * 512 + F.lane * 8) = (v4u){0u, 0u, 0u, 0u}; }
    }
}

__device__ __forceinline__ void p1_hx0(Frame& F) {
    const int gw = F.vcu * NWAVES + F.wave, NGW = F.G * NWAVES;
    bf16* HX = wsb(F, WS_ACT); const float* xin = F.in(0); const float* cin = F.in(2);
    constexpr int RPW = 16;
    for (int blk = gw; blk < M_T / RPW; blk += NGW) {
        const int r0 = blk * RPW, rt = r0 < SEQ ? 0 : (r0 < M_X ? 1 : 2);
        const float* mod = wsf(F, WS_MOD) + (size_t)rt * 12288;
        const GAS f32x4* shp = (const GAS f32x4*)mod + F.lane; const GAS f32x4* scp = (const GAS f32x4*)(mod + DM) + F.lane;
        f32x4 A[8], B[8];
#pragma unroll
        for (int j = 0; j < 8; ++j) { A[j] = scp[64 * j]; B[j] = shp[64 * j]; }
        const float* src = r0 < M_X ? xin + (size_t)r0 * DM : cin + (size_t)(r0 - M_X) * DM;
        const GAS f32x4* xr = (const GAS f32x4*)src + F.lane;
        GAS f32x4* xc = (GAS f32x4*)(wsf(F, WS_X32C) + (size_t)(r0 < M_X ? 0 : r0 - M_X) * DM) + F.lane;
        f32x4 va[8], vb[8];
#pragma unroll
        for (int j = 0; j < 8; ++j) va[j] = xr[64 * j];
#define P1_ROW(CUR, NXT, R) do { \
            if ((R) + 1 < RPW) { _Pragma("unroll") for (int j = 0; j < 8; ++j) NXT[j] = xr[(size_t)((R) + 1) * (DM / 4) + 64 * j]; } \
            GAS v2u* o8_ = (GAS v2u*)(HX + (size_t)(r0 + (R)) * DM) + F.lane; \
            _Pragma("unroll") for (int j = 0; j < 8; ++j) { const f32x4 h_ = CUR[j] * A[j] + B[j]; o8_[64 * j] = (v2u){pk2(h_.x, h_.y), pk2(h_.z, h_.w)}; \
                if (r0 >= M_X) xc[(size_t)(R) * (DM / 4) + 64 * j] = CUR[j] * DN_ALPHA; }     \
        } while (0)
        for (int r = 0; r < RPW; r += 2) { P1_ROW(va, vb, r); P1_ROW(vb, va, r + 1); }
#undef P1_ROW
    }
}

__device__ __forceinline__ void ln_phase(Frame& F, int layer, int second, int nrows) {
    const int gw = F.vcu * NWAVES + F.wave, NGW = F.G * NWAVES;
    const float* gam = F.in(second ? 8 : 6) + layer * DM; const float* bet = F.in(second ? 9 : 7) + layer * DM;
    const bool final_out = (second && layer == DEPTH - 1);
    const int modl = second ? (layer + 1 < DEPTH ? layer + 1 : layer) : layer, chunk = second ? 0 : 3;
    bf16* HX = wsb(F, WS_ACT); float* stats = wsf(F, WS_STATS) + (size_t)second * 2 * M_T;
    const GAS f32x4* gp = (const GAS f32x4*)gam + F.lane; const GAS f32x4* bp = (const GAS f32x4*)bet + F.lane;
    constexpr int RPW = 16;
    const _Float16* T16 = (const _Float16*)(F.ws + WS_T16);
    for (int blk = gw; blk < M_X / RPW; blk += NGW) {
        const int r0 = blk * RPW, rt = r0 < SEQ ? 0 : 1;
        f32x4 A[8], B[8];
        { const float* mod = wsf(F, WS_MOD) + (size_t)(modl * 3 + rt) * 12288 + chunk * DM;
          const GAS f32x4* g4 = (const GAS f32x4*)gam + 2 * F.lane; const GAS f32x4* b4 = (const GAS f32x4*)bet + 2 * F.lane;
          const GAS f32x4* shp = (const GAS f32x4*)mod + 2 * F.lane; const GAS f32x4* scp = (const GAS f32x4*)(mod + DM) + 2 * F.lane;
#pragma unroll
          for (int j = 0; j < 4; ++j)
#pragma unroll
              for (int h = 0; h < 2; ++h) { const int q = 128 * j + h; const f32x4 g = g4[q], b = b4[q]; if (final_out) { A[2 * j + h] = g; B[2 * j + h] = b; } else { const f32x4 sc = scp[q], sh = shp[q]; A[2 * j + h] = g * sc; B[2 * j + h] = b * sc + sh; } } }
        const GAS f16x8* xr = (const GAS f16x8*)(T16 + (size_t)r0 * DM) + F.lane;
        f16x8 ta[4], tb[4], tc[4];
#pragma unroll
        for (int j = 0; j < 4; ++j) { ta[j] = xr[64 * j]; tb[j] = xr[(size_t)(DM / 8) + 64 * j]; }
#define LN_ROW(CUR, NXT, R) do { \
            if ((R) + 2 < RPW) { _Pragma("unroll") for (int j = 0; j < 4; ++j) NXT[j] = xr[(size_t)((R) + 2) * (DM / 8) + 64 * j]; } \
            f32x4 v_[8]; float s_ = 0.f; \
            _Pragma("unroll") for (int j = 0; j < 4; ++j) { v_[2 * j] = (f32x4){(float)CUR[j][0], (float)CUR[j][1], (float)CUR[j][2], (float)CUR[j][3]}; v_[2 * j + 1] = (f32x4){(float)CUR[j][4], (float)CUR[j][5], (float)CUR[j][6], (float)CUR[j][7]}; } \
            _Pragma("unroll") for (int j = 0; j < 8; ++j) s_ += (v_[j].x + v_[j].y) + (v_[j].z + v_[j].w); \
            const float mean_ = wave_sum(s_, F.lane) * (1.f / DM); float q_ = 0.f; \
            _Pragma("unroll") for (int j = 0; j < 8; ++j) { v_[j] = v_[j] - mean_; q_ += (v_[j].x * v_[j].x + v_[j].y * v_[j].y) + (v_[j].z * v_[j].z + v_[j].w * v_[j].w); } \
            const float rstd_ = 1.f / sqrtf(wave_sum(q_, F.lane) * (1.f / DM) + LN_EPS); \
            if (final_out) { GAS f32x4* o4_ = (GAS f32x4*)(F.out + (size_t)(r0 + (R)) * DM) + 2 * F.lane; \
                   _Pragma("unroll") for (int j = 0; j < 4; ++j) { o4_[128 * j] = v_[2 * j] * rstd_ * A[2 * j] + B[2 * j]; o4_[128 * j + 1] = v_[2 * j + 1] * rstd_ * A[2 * j + 1] + B[2 * j + 1]; } } \
            else { if (F.lane == 0) *(GAS f32x2*)(stats + 2 * (size_t)(r0 + (R))) = (f32x2){mean_, rstd_}; \
                   GAS v4u* o8_ = (GAS v4u*)(HX + (size_t)(r0 + (R)) * DM) + F.lane; \
                   _Pragma("unroll") for (int j = 0; j < 4; ++j) { const f32x4 h0_ = v_[2 * j] * rstd_ * A[2 * j] + B[2 * j], h1_ = v_[2 * j + 1] * rstd_ * A[2 * j + 1] + B[2 * j + 1]; \
                       o8_[64 * j] = (v4u){pk2(h0_.x, h0_.y), pk2(h0_.z, h0_.w), pk2(h1_.x, h1_.y), pk2(h1_.z, h1_.w)}; } } \
        } while (0)
        for (int r = 0; r < RPW - 1; r += 3) { LN_ROW(ta, tc, r); LN_ROW(tb, ta, r + 1); LN_ROW(tc, tb, r + 2); }
        LN_ROW(ta, tc, RPW - 1);
#undef LN_ROW
    }
    for (int row = M_X + gw; row < nrows; row += NGW) {
        float* xrow = wsf(F, WS_X32C) + (size_t)(row - M_X) * DM;
        GAS f32x4* xr = (GAS f32x4*)xrow + F.lane;
        f32x4 v[8]; float s = 0.f;
#pragma unroll
        for (int j = 0; j < 8; ++j) { v[j] = xr[64 * j]; s += (v[j].x + v[j].y) + (v[j].z + v[j].w); }
        const float mean = wave_sum(s, F.lane) * (1.f / DM); float s2 = 0.f;
#pragma unroll
        for (int j = 0; j < 8; ++j) { v[j] = v[j] - mean; s2 += (v[j].x * v[j].x + v[j].y * v[j].y) + (v[j].z * v[j].z + v[j].w * v[j].w); }
        const float rstd = 1.f / sqrtf(wave_sum(s2, F.lane) * (1.f / DM) + LN_EPS);
#pragma unroll
        for (int j = 0; j < 8; ++j) v[j] = v[j] * rstd * gp[64 * j] + bp[64 * j];
        if (F.lane == 0) *(GAS f32x2*)(stats + 2 * (size_t)row) = (f32x2){mean, rstd};
        const float* mod = wsf(F, WS_MOD) + (size_t)(modl * 3 + 2) * 12288 + chunk * DM;
        const GAS f32x4* shp = (const GAS f32x4*)mod + F.lane; const GAS f32x4* scp = (const GAS f32x4*)(mod + DM) + F.lane;
        GAS v2u* o8 = (GAS v2u*)(HX + (size_t)row * DM) + F.lane;
#pragma unroll
        for (int j = 0; j < 8; ++j) { const f32x4 h = v[j] * scp[64 * j] + shp[64 * j]; o8[64 * j] = (v2u){pk2(h.x, h.y), pk2(h.z, h.w)}; xr[64 * j] = v[j] * DN_ALPHA; }
    }
}

__device__ __forceinline__ bool seq_start(int r) { return r >= M_T ? true : (r < M_X ? ((r & (SEQ - 1)) == 0) : (((r - M_X) & (CTXL - 1)) == 0)); }
__device__ __forceinline__ void unpack8(const v4u w, float (&f)[8]) { f[0] = bflo(w.x); f[1] = bfhi(w.x); f[2] = bflo(w.y); f[3] = bfhi(w.y); f[4] = bflo(w.z); f[5] = bfhi(w.z); f[6] = bflo(w.w); f[7] = bfhi(w.w); }

__device__ __forceinline__ void load8f(const float* p, float (&f)[8]) { const f32x4 a = *(const GAS f32x4*)p, b = *(const GAS f32x4*)(p + 4); f[0] = a.x; f[1] = a.y; f[2] = a.z; f[3] = a.w; f[4] = b.x; f[5] = b.y; f[6] = b.z; f[7] = b.w; }
__device__ __forceinline__ void convfix_phase(Frame& F, int j) {
    const int gw = F.vcu * NWAVES + F.wave, NGW = F.G * NWAVES;
    const float* HALO = wsf(F, WS_BIG + BIG_HALOC); const bf16* Bb = wsb(F, WS_BIG + BIG_BB); bf16* OUT = wsb(F, WS_BIG + BIG_GATED);
    const float* cw = F.in(11) + (size_t)j * 3 * DM;
    constexpr int NCG = DM / 512, NSEG = M_T / 64;
    for (int item = gw; item < NSEG * 2 * NCG; item += NGW) {
        const int cg = item % NCG, sw = item / NCG, seg = sw >> 1, bot = sw & 1, f0 = cg * 512 + F.lane * 8;
        const int row = 64 * seg + (bot ? 63 : 0);
        const bool missing = bot ? seq_start(row + 1) : seq_start(row);
        const float* P = HALO + ((size_t)seg * 512 + (f0 >> 2)) * 16 + (bot ? 12 : 4);
        const f32x4 p0 = *(const GAS f32x4*)P, p1 = *(const GAS f32x4*)(P + 16);
        float z[8] = {p0.x, p0.y, p0.z, p0.w, p1.x, p1.y, p1.z, p1.w};
        if (!missing) {
            const float* R = HALO + ((size_t)(bot ? seg + 1 : seg - 1) * 512 + (f0 >> 2)) * 16 + (bot ? 0 : 8);
            const f32x4 r0 = *(const GAS f32x4*)R, r1 = *(const GAS f32x4*)(R + 16); const float rr[8] = {r0.x, r0.y, r0.z, r0.w, r1.x, r1.y, r1.z, r1.w};
            float w[8]; load8f(cw + (bot ? 2 : 0) * DM + f0, w);
#pragma unroll
            for (int e = 0; e < 8; ++e) z[e] += w[e] * rr[e];
        }
        float bb[8]; unpack8(*(const GAS v4u*)(Bb + (size_t)row * DM + f0), bb);
        *(GAS v4u*)(OUT + (size_t)row * DM + f0) = (v4u){pk2(bb[0] * z[0], bb[1] * z[1]), pk2(bb[2] * z[2], bb[3] * z[3]), pk2(bb[4] * z[4], bb[5] * z[5]), pk2(bb[6] * z[6], bb[7] * z[7])};
    }
}

__device__ __forceinline__ void ffnfix_phase(Frame& F, int layer, int nrows) {
    const int gw = F.vcu * NWAVES + F.wave, NGW = F.G * NWAVES;
    const float* HALO = wsf(F, WS_BIG + BIG_HALO); bf16* ACT = wsb(F, WS_BIG + BIG_ACT);
    const float* cw = F.in(22) + (size_t)layer * 3 * 11264;
    constexpr int NCG = DFF / 512;
    const int nseg = nrows / 64;
    for (int item = gw; item < nseg * 2 * NCG; item += NGW) {
        const int cg = item % NCG, sw = item / NCG, seg = sw >> 1, bot = sw & 1, f0 = cg * 512 + F.lane * 8;
        const int row = 64 * seg + (bot ? 63 : 0);
        const bool missing = bot ? seq_start(row + 1) : seq_start(row);
        const float* P = HALO + ((size_t)seg * 2816 + (f0 >> 2)) * 16 + (bot ? 12 : 4);
        float pg[8], pu[8];
        { const f32x4 a = *(const GAS f32x4*)P, b = *(const GAS f32x4*)(P + 16), c = *(const GAS f32x4*)(P + 1408 * 16), d = *(const GAS f32x4*)(P + 1408 * 16 + 16);
          pg[0] = a.x; pg[1] = a.y; pg[2] = a.z; pg[3] = a.w; pg[4] = b.x; pg[5] = b.y; pg[6] = b.z; pg[7] = b.w; pu[0] = c.x; pu[1] = c.y; pu[2] = c.z; pu[3] = c.w; pu[4] = d.x; pu[5] = d.y; pu[6] = d.z; pu[7] = d.w; }
        if (!missing) {
            const float* R = HALO + ((size_t)(bot ? seg + 1 : seg - 1) * 2816 + (f0 >> 2)) * 16 + (bot ? 0 : 8); const float* W = cw + (bot ? 2 : 0) * 11264 + f0;
            float rg[8], ru[8], wg[8], wu[8]; load8f(W, wg); load8f(W + DFF, wu);
            { const f32x4 a = *(const GAS f32x4*)R, b = *(const GAS f32x4*)(R + 16), c = *(const GAS f32x4*)(R + 1408 * 16), d = *(const GAS f32x4*)(R + 1408 * 16 + 16);
              rg[0] = a.x; rg[1] = a.y; rg[2] = a.z; rg[3] = a.w; rg[4] = b.x; rg[5] = b.y; rg[6] = b.z; rg[7] = b.w; ru[0] = c.x; ru[1] = c.y; ru[2] = c.z; ru[3] = c.w; ru[4] = d.x; ru[5] = d.y; ru[6] = d.z; ru[7] = d.w; }
#pragma unroll
            for (int e = 0; e < 8; ++e) { pg[e] += wg[e] * rg[e]; pu[e] += wu[e] * ru[e]; }
        }
        float o[8];
#pragma unroll
        for (int e = 0; e < 8; ++e) o[e] = pg[e] * __builtin_amdgcn_rcpf(1.0f + __builtin_amdgcn_exp2f(-1.4426950408889634f * pg[e])) * pu[e];
        *(GAS v4u*)(ACT + (size_t)row * DFF + f0) = (v4u){pk2(o[0], o[1]), pk2(o[2], o[3]), pk2(o[4], o[5]), pk2(o[6], o[7])};
    }
}

__device__ __forceinline__ void krope_phase(Frame& F) {
    const int gw = F.vcu * NWAVES + F.wave, NGW = F.G * NWAVES;
    const float* KRRAW = wsf(F, WS_BIG + BIG_KRRAW); bf16* KR = wsb(F, WS_BIG + BIG_KR);
    const f32x2* ropeR = (const f32x2*)(F.ws + WS_ROPER); const f32x2* ropeC = (const f32x2*)(F.ws + WS_ROPEC);
    for (int row = gw; row < M_T; row += NGW) {
        float kr = KRRAW[(size_t)row * ROPE_D + F.lane];
        const float partner = lane_xor(kr, F.lane, 16);
        if (row < M_X) { const int pos = row & (SEQ - 1), f = F.lane & 15; const f32x2 cs = F.lane < 32 ? ropeR[(pos >> 6) * 16 + f] : ropeC[(pos & 63) * 16 + f];
            kr = kr * cs.x + ((F.lane & 16) ? partner : -partner) * cs.y; }
        KR[(size_t)row * ROPE_D + F.lane] = (bf16)f2bf(kr);
    }
}

__device__ __forceinline__ void attn_phase(Frame& F, bool last, int i_lo = 0, int i_hi = 1 << 30) {
    const bf16* Q = wsb(F, WS_BIG + BIG_Q); const bf16* K = wsb(F, WS_BIG + BIG_K); const bf16* V = wsb(F, WS_BIG + BIG_V); const bf16* KR = wsb(F, WS_BIG + BIG_KR); bf16* O = wsb(F, WS_BIG + BIG_O);
    const att::f32x2* ropeR = (const att::f32x2*)(F.ws + WS_ROPER); const att::f32x2* ropeC = (const att::f32x2*)(F.ws + WS_ROPEC);
    ATT_LAS char* lds = (ATT_LAS char*)(F.lds + RING_OFF);
    constexpr int NQB = SEQ / 256, NUNIT = BATCH * NH * NQB, NCU = BATCH * NH;
    const int ntot = last ? NUNIT : NUNIT + NCU;
    for (int i = i_lo; i < i_hi; ++i) {
        const int L = i * F.G + F.vcu; if (L >= ntot) break;
        const bool isx = L < NUNIT;
        const int p = isx ? L / NQB : L - NUNIT, qb = isx ? L % NQB : 0, b = p / NH, h = p % NH;
        const size_t qrow = isx ? (size_t)b * SEQ + (size_t)qb * 256 : (size_t)M_X + (size_t)b * CTXL;
        att::attn_unit(Q + qrow * 3072 + h * 192, K + (size_t)h * M_T * 128, V + (size_t)h * M_T * 128, KR, O + qrow * 2048 + h * 128,

                       b * SEQ, isx ? SEQ / 64 : 0, M_X + b * CTXL, isx ? SEQ / 64 + CTXL / 64 : CTXL / 64, isx ? 1 : 0, qb * 256, ropeR, ropeC, lds, F.wave0);
    }
}

#ifndef MK_ONE_LAUNCH
#define MK_ONE_LAUNCH 1
#endif
constexpr bool ONE_LAUNCH = (MK_ONE_LAUNCH != 0);
constexpr int N_PHASE_IDS = 2 + 10 * DEPTH;
struct Args { const float* in[25]; float* out; unsigned char* ws; int ph_lo, ph_hi; };
__global__ void __launch_bounds__(NWAVES * 64, 2) mk_fwd(Args args) {
    extern __shared__ __attribute__((aligned(16))) unsigned char lds[];
    LAS unsigned char* const L0 = (LAS unsigned char*)lds;
    for (int u = threadIdx.x; u < (LDS_BYTES - LDSCTL_OFF) / 4; u += NWAVES * 64) ((LAS unsigned*)(L0 + LDSCTL_OFF))[u] = 0u;
    __syncthreads();
    if (threadIdx.x < 27) { const unsigned long long v = threadIdx.x < 25 ? (unsigned long long)args.in[threadIdx.x] : (threadIdx.x == 25 ? (unsigned long long)args.out : (unsigned long long)args.ws);
        ((LAS unsigned long long*)(L0 + PTAB_OFF))[threadIdx.x] = v; }
    __syncthreads();
    const int lo = args.ph_lo, hi = args.ph_hi;
    const int wave0 = __builtin_amdgcn_readfirstlane((int)threadIdx.x >> 6);
    if (ONE_LAUNCH) { Frame F; make_frame(F, L0, wave0); (void)xcd_barrier_post((unsigned*)((gu32*)(F.ws + WS_CTL) + CW_BAR), (volatile LAS unsigned*)(L0 + MISC_OFF) + 8, F.tid == 0); }
#ifndef MK_SLOT_MASK
#define MK_SLOT_MASK 0xFFFFFFFFu
#endif
#define IN(k) (lo <= (k) && (k) < hi)
#define INS(sl, cv) ((((MK_SLOT_MASK) >> ((sl) + ((cv) ? 16 : 0))) & 1u) && IN(pb + (sl)))
#define SEAM() do { if (ONE_LAUNCH) { XcdBarrier b_; b_.bar = (unsigned*)((gu32*)(F.ws + WS_CTL) + CW_BAR); b_.x = xb_xcc_id(); b_.st = (volatile LAS unsigned*)(L0 + MISC_OFF) + 8; const bool lead_ = tid_from_wave(wave0) == 0; for (int rb_ = 0; rb_ <= REP_BAR; ++rb_) xcd_barrier(b_, lead_); } } while (0)
#ifndef REP_ATTN
#define REP_ATTN 0
#endif
#ifndef REP_UP
#define REP_UP 0
#endif
#ifndef REP_WIN
#define REP_WIN 0
#endif
#ifndef REP_MLAG
#define REP_MLAG 0
#endif
#ifndef REP_ELT
#define REP_ELT 0
#endif
#ifndef REP_RESID
#define REP_RESID 0
#endif
#ifndef REP_BAR
#define REP_BAR 0
#endif
#ifndef REP_LN
#define REP_LN 0
#endif
#ifndef PROBE_ATTN_SPLIT
#define PROBE_ATTN_SPLIT 0
#endif
#ifndef PROBE_UP_TAIL
#define PROBE_UP_TAIL 0
#endif
#ifndef REP_P0
#define REP_P0 0
#endif
#define FRAME() Frame F; make_frame(F, L0, wave0); LAS unsigned char* ring = F.lds + RING_OFF; (void)ring; \
    bf16* HX = wsb(F, WS_ACT); bf16* ACT = wsb(F, WS_BIG + BIG_ACT); bf16* GU = wsb(F, WS_BIG); float* X32C = wsf(F, WS_X32C); const float* MOD = wsf(F, WS_MOD); (void)HX; (void)ACT; (void)GU; (void)X32C; (void)MOD

    if (((MK_SLOT_MASK >> 30) & 1u) && IN(0)) { FRAME(); for (int rep_ = 0; rep_ <= REP_P0; ++rep_) { p0_prologue(F); __syncthreads(); } SEAM(); }
    if (((MK_SLOT_MASK >> 31) & 1u) && IN(1)) { FRAME(); p1_hx0(F); SEAM(); }

    for (int L = 0; L < DEPTH; ++L) {
        const int pb = 2 + 10 * L, j = L >> 1; const bool last = (L == DEPTH - 1); const int Mrows = last ? M_X : M_T;
        const bool is_conv = (L & 1) == 0;
        if (is_conv) {
            if (INS(0, 1)) { FRAME();
                pg8::Gemm g{HX, wsb(F, WS_W + j * W_CONV_STRIDE + W_WIN), M_T, DM, DM}; pg8::StaticOrder S; S.init(M_T, DM, F.G, F.bx);
                pg8::EpiBf16<0> E{wsb(F, WS_BIG + BIG_BB), DM, nullptr, 0, 0, 1.f};
                for (int rep_ = 0; rep_ <= REP_WIN; ++rep_) pg8::gemm_phase<pg8::EpiBf16<0>, pg8::StaticOrder, true, true>(ring, g, S, E, F.wave0); SEAM(); }
            if (INS(1, 1)) { FRAME();
                pg8::Gemm g{HX, wsb(F, WS_W + j * W_CONV_STRIDE + W_WIN) + (size_t)DM * DM, M_T, 2 * DM, DM}; pg8::StaticOrder S; S.init(M_T, 2 * DM, F.G, F.bx);
                pg8::EpiConvGate E{wsb(F, WS_BIG + BIG_GATED), wsf(F, WS_BIG + BIG_HALOC), wsb(F, WS_BIG + BIG_BB), F.in(11) + (size_t)j * 3 * DM, (unsigned)((M_T / 64) * 512 * 64)};
                for (int rep_ = 0; rep_ <= REP_WIN; ++rep_) pg8::gemm_phase<pg8::EpiConvGate, pg8::StaticOrder, true, true>(ring, g, S, E, F.wave0); SEAM(); }
            if (INS(2, 1)) { FRAME(); convfix_phase(F, j); SEAM(); }
        } else {
            if (INS(0, 0)) { FRAME();
                pg8::Gemm g{HX, wsb(F, WS_W + W_MLA_BASE + j * W_MLA_STRIDE + W_DQKV), M_T, NDQKV, DM}; pg8::StaticOrder S; S.init(M_T, NDQKV, F.G, F.bx);
                pg8::EpiDqkv E{wsb(F, WS_BIG + BIG_CQ), wsb(F, WS_BIG + BIG_CKV), wsf(F, WS_BIG + BIG_KRRAW), wsf(F, WS_BIG + BIG_SSQ), (unsigned)(M_T * 64)};
                for (int rep_ = 0; rep_ <= REP_MLAG; ++rep_) pg8::gemm_phase<pg8::EpiDqkv, pg8::StaticOrder, true, true>(ring, g, S, E, F.wave0); SEAM(); }
            if (INS(2, 0)) { FRAME();
                krope_phase(F);
                for (int rep_ = 0; rep_ <= REP_MLAG; ++rep_) {
                { pg8::Gemm g{wsb(F, WS_BIG + BIG_CQ), wsb(F, WS_W + W_MLA_BASE + j * W_MLA_STRIDE + W_UQ), Mrows, 3072, QLR}; pg8::StaticOrder S; S.init(Mrows, 3072, F.G, F.bx);
                  pg8::EpiBf16Row E{wsb(F, WS_BIG + BIG_Q), 3072, 0, 0, wsf(F, WS_BIG + BIG_SSQ), RMS_EPS, 0};
                  pg8::gemm_phase<pg8::EpiBf16Row, pg8::StaticOrder, true, true>(ring, g, S, E, F.wave0); }
                { pg8::Gemm g{wsb(F, WS_BIG + BIG_CKV), wsb(F, WS_W + W_MLA_BASE + j * W_MLA_STRIDE + W_UKV), M_T, 4096, KVLR}; pg8::StaticOrder S; S.init(M_T, 4096, F.G, F.bx);
                  pg8::EpiBf16Row E{wsb(F, WS_BIG + BIG_K), 2048, 2048, (BIG_V - BIG_K) / 2, wsf(F, WS_BIG + BIG_SSQ) + 8, RMS_EPS, M_T};
                  pg8::gemm_phase<pg8::EpiBf16Row, pg8::StaticOrder, true, true>(ring, g, S, E, F.wave0); }
                }
                SEAM(); }
            if (INS(3, 0)) { FRAME(); if (PROBE_ATTN_SPLIT) { attn_phase(F, last, 0, 4); SEAM(); attn_phase(F, last, 4); } else { for (int rep_ = 0; rep_ <= REP_ATTN; ++rep_) attn_phase(F, last); } SEAM(); }
        }
        if (INS(4, 0)) { FRAME();
            const bf16* A = is_conv ? wsb(F, WS_BIG + BIG_GATED) : wsb(F, WS_BIG + BIG_O);
            const bf16* Bt = is_conv ? wsb(F, WS_W + j * W_CONV_STRIDE + W_WOUT) : wsb(F, WS_W + W_MLA_BASE + j * W_MLA_STRIDE + W_WO);
            pg8::Gemm g{A, Bt, Mrows, DM, DM}; pg8::SplitCtxOrder S; S.init(M_X, Mrows - M_X, DM, DM, 4, F.G, F.bx);
            pg8::EpiResid E{L == 0 ? F.in(0) : nullptr, (const _Float16*)(F.ws + WS_T16), (_Float16*)(F.ws + WS_T16), X32C, MOD + (size_t)L * 3 * 12288 + 2 * DM, DN_ALPHA,
                             L == 0 ? nullptr : wsf(F, WS_STATS) + 2 * M_T, F.in(8) + (L == 0 ? 0 : L - 1) * DM, F.in(9) + (L == 0 ? 0 : L - 1) * DM};
            if (REP_RESID) { pg8::EpiResid E2 = E; E2.dstT = (_Float16*)HX; pg8::SplitCtxOrder S2; S2.init(M_X, 0, DM, DM, 4, F.G, F.bx); pg8::gemm_phase<pg8::EpiResid, pg8::SplitCtxOrder, true, true>(ring, g, S2, E2, F.wave0); }
            pg8::gemm_phase<pg8::EpiResid, pg8::SplitCtxOrder, true, true>(ring, g, S, E, F.wave0); SEAM(); }
        if (INS(5, 0)) { FRAME(); for (int rep_ = 0; rep_ < REP_LN; ++rep_) ln_phase(F, L, 0, M_X); ln_phase(F, L, 0, Mrows); SEAM(); }
        if (INS(6, 0)) { FRAME();
            pg8::Gemm g{HX, wsb(F, WS_W + W_FFN_BASE + L * W_FFN_STRIDE + W_UP), Mrows, 11264, DM}; pg8::StaticOrder S; S.init(Mrows, 11264, F.G, F.bx);
            pg8::EpiConvAct E{ACT, wsf(F, WS_BIG + BIG_HALO), F.in(22) + (size_t)L * 3 * 11264, F.in(23) + (size_t)L * 11264, (unsigned)((M_T / 64) * 2816 * 64)};
#if PROBE_UP_TAIL
            { pg8::TailProbeOrder St; St.init(Mrows, 11264, F.G, F.bx); pg8::gemm_phase<pg8::EpiConvAct, pg8::TailProbeOrder, true, true>(ring, g, St, E, F.wave0); }
#else
            for (int rep_ = 0; rep_ <= REP_UP; ++rep_) pg8::gemm_phase<pg8::EpiConvAct, pg8::StaticOrder, true, true>(ring, g, S, E, F.wave0);
#endif
            SEAM(); }
        if (INS(7, 0)) { FRAME(); for (int rep_ = 0; rep_ <= REP_ELT; ++rep_) ffnfix_phase(F, L, Mrows); SEAM(); }
        if (INS(8, 0)) { FRAME();
            pg8::Gemm g{ACT, wsb(F, WS_W + W_FFN_BASE + L * W_FFN_STRIDE + W_DOWN), Mrows, DM, DFF}; pg8::SplitCtxOrder S; S.init(M_X, Mrows - M_X, DM, DFF, 11, F.G, F.bx);
            pg8::EpiResid E{nullptr, (const _Float16*)(F.ws + WS_T16), (_Float16*)(F.ws + WS_T16), X32C, MOD + (size_t)L * 3 * 12288 + 5 * DM, DN_ALPHA, wsf(F, WS_STATS), F.in(6) + L * DM, F.in(7) + L * DM};
            if (REP_RESID) { pg8::EpiResid E2 = E; E2.dstT = (_Float16*)HX; pg8::SplitCtxOrder S2; S2.init(M_X, 0, DM, DFF, 11, F.G, F.bx); pg8::gemm_phase<pg8::EpiResid, pg8::SplitCtxOrder, true, true>(ring, g, S2, E2, F.wave0); }
            pg8::gemm_phase<pg8::EpiResid, pg8::SplitCtxOrder, true, true>(ring, g, S, E, F.wave0); SEAM(); }
        if (INS(9, 0)) { FRAME(); if (!last) for (int rep_ = 0; rep_ < REP_LN; ++rep_) ln_phase(F, L, 1, M_X); ln_phase(F, L, 1, Mrows); if (!last) SEAM(); }
    }
#undef IN
#undef SEAM
}

extern "C" void kernel_launch(void* const* d_in, const int* in_sizes, int n_in, void* d_out, int out_size, void* d_ws, size_t ws_size, hipStream_t stream) {
    static int grid = 0;
    if (grid == 0) {
        if (n_in != 25 || in_sizes[0] != M_X * DM || out_size != M_X * DM || ws_size < WS_END) {
            fprintf(stderr, "kernel_launch: shape/workspace mismatch: n_in %d in0 %d out %d ws %zu (need %zu); nothing launched\n", n_in, n_in > 0 ? in_sizes[0] : -1, out_size, ws_size, (size_t)WS_END); grid = -1; return; }
        int dev = 0, cus = 0, per_cu = 0;
        if (hipGetDevice(&dev) != hipSuccess || hipDeviceGetAttribute(&cus, hipDeviceAttributeMultiprocessorCount, dev) != hipSuccess) { grid = -1; return; }
        if (hipFuncSetAttribute((const void*)mk_fwd, hipFuncAttributeMaxDynamicSharedMemorySize, LDS_BYTES) != hipSuccess) { fprintf(stderr, "kernel_launch: hipFuncSetAttribute failed\n"); grid = -1; return; }
        if (hipOccupancyMaxActiveBlocksPerMultiprocessor(&per_cu, (const void*)mk_fwd, NWAVES * 64, LDS_BYTES) != hipSuccess || per_cu < 1)
            fprintf(stderr, "kernel_launch: note: occupancy query reports %d workgroups per CU\n", per_cu);
        (void)hipGetLastError();
        grid = cus;
    }
    if (grid < 0) return;
    if (hipMemsetAsync((char*)d_ws + WS_CTL, 0, CTL_ZERO_BYTES, stream) != hipSuccess) return;
    Args a{};
    for (int i = 0; i < 25; ++i) a.in[i] = (const float*)d_in[i];
    a.out = (float*)d_out; a.ws = (unsigned char*)d_ws;
    if (ONE_LAUNCH) {
        a.ph_lo = 0; a.ph_hi = N_PHASE_IDS;
        hipLaunchKernelGGL(mk_fwd, dim3(grid), dim3(NWAVES * 64), LDS_BYTES, stream, a);
    } else {
        for (int p = 0; p < N_PHASE_IDS; ++p) {
            if (p >= 2) { const int L = (p - 2) / 10, s = (p - 2) % 10; if (((L & 1) == 0 && s == 3) || ((L & 1) == 1 && s == 1)) continue; }
            a.ph_lo = p; a.ph_hi = p + 1;
            hipLaunchKernelGGL(mk_fwd, dim3(grid), dim3(NWAVES * 64), LDS_BYTES, stream, a);
        }
    }
    const hipError_t le = hipPeekAtLastError();
    if (le != hipSuccess) fprintf(stderr, "kernel_launch: launch failed: %s\n", hipGetErrorName(le));
}
```

```cpp
#include <hip/hip_runtime.h>
#include <cstdio>
#include <cstdint>
#include <cmath>
#ifndef ATT_SDEPTH
#define ATT_SDEPTH 1
#endif
__device__ __forceinline__ int tid_from_wave(int wave) {
    int w = wave; asm volatile("" : "+s"(w));
    unsigned z = 0u; asm volatile("" : "+v"(z));
    int l = (int)__builtin_amdgcn_mbcnt_hi(~0u, __builtin_amdgcn_mbcnt_lo(~0u, z)); asm volatile("" : "+v"(l));
    return (w << 6) | l;
}
namespace pg8 {
#define PG8_LAS __attribute__((address_space(3)))
typedef unsigned short bf16_t;
typedef short bf16x8 __attribute__((ext_vector_type(8)));
typedef float f32x4 __attribute__((ext_vector_type(4)));
typedef unsigned u32x4 __attribute__((ext_vector_type(4)));
constexpr int BM = 256, BK = 64, HALF = 128, HTB = HALF * BK * 2  , STAGE_BYTES = 8 * HTB, NXCD = 8, WGM = 8;

__host__ __device__ __forceinline__ int lds_byte(int r, int c) { const int st = (r >> 4) * 2 + (c >> 5), rr = r & 15, cc = c & 31, ob = rr * 64 + cc * 2; return st * 1024 + (ob ^ (((ob >> 9) & 1) << 5)); }
__host__ __device__ __forceinline__ void stage_rc(int b, int& R, int& C) { const int st = b / 1024, sb = b % 1024, swz = sb ^ (((sb >> 9) & 1) << 5); R = (st >> 1) * 16 + swz / 64; C = (st & 1) * 32 + (swz % 64) / 2; }
__host__ __device__ __forceinline__ int perm32(int rho) { const int n = rho >> 4, i = rho & 15; return 8 * (i >> 2) + 4 * n + (i & 3); }

struct Unit { int pm, pn, kofs, nt, tag = 0; };
struct Gemm { const bf16_t* A; const bf16_t* Bt; int M, N, K; };

struct StaticOrder {
    int nM, nN, nwg, G, c, i_off = 0, i_cnt = 1 << 30;
    __host__ __device__ void init(int M, int N, int G_, int c_) { nM = M / BM; nN = N / BM; nwg = nM * nN; G = G_; c = c_; }
    __host__ __device__ bool next(int i_, Unit& u) const {
        if (i_ >= i_cnt) return false; const int i = i_ + i_off;
        const long L = (long)i * G + c; if (L >= nwg) return false;
        map((int)L, u); return true;
    }
    __host__ __device__ void map(int L, Unit& u) const {
        int wgid = L; { const int q = nwg / NXCD, r = nwg % NXCD, xcd = wgid % NXCD, off = wgid / NXCD; wgid = (xcd < r ? xcd * (q + 1) : r * (q + 1) + (xcd - r) * q) + off; }
        const int nig = WGM * nN, gid = wgid / nig, fm = gid * WGM, gsz = (nM - fm) < WGM ? (nM - fm) : WGM;
        u.pm = fm + ((wgid % nig) % gsz); u.pn = (wgid % nig) / gsz; u.kofs = 0; u.nt = 0;
    }
    __host__ __device__ int block_of(int pm, int pn) const {
        const int nig = WGM * nN, gid = pm / WGM, fm = gid * WGM, gsz = (nM - fm) < WGM ? (nM - fm) : WGM, wgid = gid * nig + pn * gsz + (pm - fm);
        const int q = nwg / NXCD, r = nwg % NXCD; int xcd, off;
        if (wgid < r * (q + 1)) { xcd = wgid / (q + 1); off = wgid % (q + 1); } else { const int w2 = wgid - r * (q + 1); xcd = r + w2 / q; off = w2 % q; }
        return off * NXCD + xcd;
    }
    __device__ __forceinline__ void a_ready(const Unit&) const {}
    __device__ __forceinline__ void done(const Unit&) const {}
};

struct TailProbeOrder {
    StaticOrder base;
    __host__ __device__ void init(int M, int N, int G_, int c_) { base.init(M, N, G_, c_); }
    __host__ __device__ bool next(int i, Unit& u) const {
        if (base.next(i, u)) return true;
        const int r0 = (base.nwg - base.c + base.G - 1) / base.G;
        const int rmax = (base.nwg + base.G - 1) / base.G;
        if (i == r0 && r0 == rmax && base.c < 16) return base.next(0, u);
        return false;
    }
    __device__ __forceinline__ void a_ready(const Unit&) const {}
    __device__ __forceinline__ void done(const Unit&) const {}
};
struct SplitCtxOrder {
    StaticOrder base; int nxu, nct, nN, nslice, slice_k, G, c;
    __host__ __device__ void init(int Mx, int Mc, int N, int K, int nslice_, int G_, int c_) { base.init(Mx, N, G_, c_); nxu = base.nwg; nN = N / BM; nct = Mc / BM; nslice = nslice_; slice_k = K / nslice_; G = G_; c = c_; }
    __host__ __device__ bool next(int i, Unit& u) const {
        const long L = (long)i * G + c;
        if (L < nxu) return base.next(i, u);
        const int q = (int)(L - nxu); if (q >= nct * nN * nslice) return false;
        const int t = q / nslice, s = q % nslice; u.pm = base.nM + t / nN; u.pn = t % nN; u.kofs = s * slice_k; u.nt = slice_k / BK; return true;
    }
    __device__ __forceinline__ void a_ready(const Unit&) const {}
    __device__ __forceinline__ void done(const Unit&) const {}
};

struct ClusterCtxOrder {
    static constexpr bool PUBLISH = false;
    int nM, nN, nxu, nct, nslice, slice_k, G, c;
    __host__ __device__ void init(int Mx, int Mc, int N, int K, int nslice_, int G_, int c_) { nM = Mx / BM; nN = N / BM; nxu = nM * nN; nct = Mc / BM; nslice = nslice_; slice_k = K / nslice_; G = G_; c = c_; }
    __host__ __device__ void map(int L, Unit& u) const { int wgid = L; { const int q = nxu / NXCD, r = nxu % NXCD, xcd = wgid % NXCD, off = wgid / NXCD; wgid = (xcd < r ? xcd * (q + 1) : r * (q + 1) + (xcd - r) * q) + off; }
        u.pm = wgid / nN; u.pn = wgid % nN; u.kofs = 0; u.nt = 0; }
    __host__ __device__ int owner(int pm, int pn) const { const int wgid = pm * nN + pn, q = nxu / NXCD, r = nxu % NXCD; int xcd, off;
        if (wgid < r * (q + 1)) { xcd = wgid / (q + 1); off = wgid % (q + 1); } else { const int w2 = wgid - r * (q + 1); xcd = r + w2 / q; off = w2 % q; }
        return (off * NXCD + xcd) % G; }
    __host__ __device__ bool next(int i, Unit& u) const {
        const long L = (long)i * G + c;
        if (L < nxu) { map((int)L, u); return true; }
        const int q = (int)(L - nxu); if (q >= nct * nN * nslice) return false;
        const int t = q / nslice, s = q % nslice; u.pm = nM + t / nN; u.pn = t % nN; u.kofs = s * slice_k; u.nt = slice_k / BK; return true;
    }
    __device__ __forceinline__ void a_ready(const Unit&) const {}
    __device__ __forceinline__ void done(const Unit&) const {}
};

struct ClusterUpOrder {
    static constexpr bool PUBLISH = false;
    int nN, nct, G, c; unsigned* count2;
    __host__ __device__ void init(int N, int Mc, int G_, int c_, unsigned* count2_) { nN = N / BM; nct = Mc / BM; G = G_; c = c_; count2 = count2_; }
    __host__ __device__ bool next(int i, Unit& u) const {
        const int x = c & 7, w = (c >> 3) & 7, k = c >> 6, per = nN / 4, nr = 2 * per;
        if (i < nr) { const int rp = i / per, cgp = i % per; u.pm = 16 * x + 4 * (2 * rp + (w & 1)) + k; u.pn = 4 * cgp + (w >> 1); u.kofs = 0; u.nt = 0; return true; }
        const int q = (i - nr) * G + c; if (q >= nct * nN) return false;
        u.pm = 128 + q / nN; u.pn = q % nN; u.kofs = 0; u.nt = 0; return true;
    }
    __device__ __forceinline__ void a_ready(const Unit& u) const {
        if (u.pm >= 128) { unsigned sp = 0u;
            while ((unsigned)__builtin_amdgcn_readfirstlane((int)__hip_atomic_load(count2, __ATOMIC_RELAXED, __HIP_MEMORY_SCOPE_AGENT)) < (unsigned)G) { __builtin_amdgcn_s_sleep(2); if (++sp > (1u << 20)) break; }
            __builtin_amdgcn_fence(__ATOMIC_ACQUIRE, "agent"); }
    }
    __device__ __forceinline__ void done(const Unit&) const {}
};

struct ConvMergedOrder {
    static constexpr bool PUBLISH = false;
    StaticOrder sb, sc; int nbt, G, c; unsigned* flags;
    __host__ __device__ void init(int M, int NB, int NC, int G_, int c_, unsigned* flags_) { sb.init(M, NB, G_, c_); sc.init(M, NC, G_, c_); nbt = sb.nwg; G = G_; c = c_; flags = flags_; }
    __host__ __device__ bool next(int i, Unit& u) const {
        const long L = (long)i * G + c;
        if (L < nbt) { sb.map((int)L, u); u.tag = (i >= 3 || L + G >= nbt) ? 1 : 0; return true; }
        if (L - nbt >= sc.nwg) return false;
        sc.map((int)(L - nbt), u); u.pn += sb.nN; u.tag = 0; return true;
    }
    __device__ __forceinline__ void a_ready(const Unit&) const {}
    __device__ __forceinline__ void done(const Unit& u) const {
        if (u.tag) {
            asm volatile("s_waitcnt vmcnt(0)" ::: "memory");
            unsigned z = 0u; asm volatile("" : "+v"(z)); unsigned old = 0u;
            if (__builtin_amdgcn_mbcnt_hi(~0u, __builtin_amdgcn_mbcnt_lo(~0u, z)) == 0u) old = __hip_atomic_fetch_add(flags + c, 1u, __ATOMIC_RELAXED, __HIP_MEMORY_SCOPE_AGENT);
            old = (unsigned)__builtin_amdgcn_readfirstlane((int)old);
            if ((old & 7u) == 7u) {
                __builtin_amdgcn_fence(__ATOMIC_RELEASE, "agent"); asm volatile("s_waitcnt vmcnt(0)" ::: "memory");
                __hip_atomic_store(flags + 512 + c, (old + 1u) >> 3, __ATOMIC_RELAXED, __HIP_MEMORY_SCOPE_AGENT); }
        }
    }
};
__device__ __forceinline__ unsigned cvt_pk_bf16(float lo, float hi) { unsigned r; asm volatile("v_cvt_pk_bf16_f32 %0, %1, %2" : "=v"(r) : "v"(lo), "v"(hi)); return r; }
typedef float f32x2 __attribute__((ext_vector_type(2)));
__device__ __forceinline__ f32x2 gelu_pk(f32x2 v) {
    const f32x2 av = __builtin_elementwise_abs(v), d = av * 0.2316418882f + 1.0f;
    f32x2 t; t.x = __builtin_amdgcn_rcpf(d.x); t.y = __builtin_amdgcn_rcpf(d.y);
    f32x2 q = t * 0.5307027145f + (-0.7265760135f); q = q * t + 0.7107068705f; q = q * t + (-0.142248368f); q = q * t + 0.127414796f; q = q * t;
    const f32x2 s = (v * v) * (-0.72134752044f);
    f32x2 e; e.x = __builtin_amdgcn_exp2f(s.x); e.y = __builtin_amdgcn_exp2f(s.y);
    const f32x2 m = v * (q * e), r = v - m;
    f32x2 o; o.x = v.x < 0.f ? m.x : r.x; o.y = v.y < 0.f ? m.y : r.y; return o;
}

template <int ACT  > struct EpiBf16 {
    static constexpr bool PERM = true, AFTER_DRAIN = false; static_assert(ACT == 0 || ACT == 1, "EpiBf16: ACT is 0 (none) or 1 (gelu_pk)");
    bf16_t* O; int ldc; const float* bias; int split_cols; size_t split_stride; float scale0;
    __device__ __forceinline__ void operator()(const f32x4 (&acc)[2][2][4][2], const Unit& u, int wr, int wc, int fr, int fq) const {
        const int row0 = u.pm * BM + wr * 64 + fr; int colt = u.pn * BM; bf16_t* base = O;
        float sc = 1.f; if (split_cols) { const int t = colt / split_cols; base += (size_t)t * split_stride; colt -= t * split_cols; if (t == 0) sc = scale0; }
        const int col0 = colt + wc * 32 + 8 * fq, bcol0 = u.pn * BM + wc * 32 + 8 * fq;
        f32x4 bv[2][2];
#pragma unroll
        for (int bj = 0; bj < 2; ++bj)
#pragma unroll
            for (int n = 0; n < 2; ++n) bv[bj][n] = bias ? *(const f32x4*)(bias + bcol0 + bj * HALF + 4 * n) : (f32x4){0.f, 0.f, 0.f, 0.f};
#pragma unroll
        for (int ai = 0; ai < 2; ++ai)
#pragma unroll
            for (int m = 0; m < 4; ++m) { bf16_t* rowp = base + (size_t)(row0 + ai * HALF + m * 16) * ldc + col0;
#pragma unroll
                for (int bj = 0; bj < 2; ++bj) { f32x4 v0 = acc[ai][bj][m][0] + bv[bj][0], v1 = acc[ai][bj][m][1] + bv[bj][1];
                    if (ACT == 1) { f32x2 a = gelu_pk((f32x2){v0[0], v0[1]}), b = gelu_pk((f32x2){v0[2], v0[3]}), c = gelu_pk((f32x2){v1[0], v1[1]}), d = gelu_pk((f32x2){v1[2], v1[3]});
                        v0 = (f32x4){a.x, a.y, b.x, b.y}; v1 = (f32x4){c.x, c.y, d.x, d.y}; }
                    v0 = v0 * sc; v1 = v1 * sc; u32x4 w; w.x = cvt_pk_bf16(v0[0], v0[1]); w.y = cvt_pk_bf16(v0[2], v0[3]); w.z = cvt_pk_bf16(v1[0], v1[1]); w.w = cvt_pk_bf16(v1[2], v1[3]);
                    *(u32x4*)(rowp + bj * HALF) = w; } }
    }
};

struct EpiF32 {
    static constexpr bool PERM = false, AFTER_DRAIN = false;
    float* C; int ldc;
    __device__ __forceinline__ void operator()(const f32x4 (&acc)[2][2][4][2], const Unit& u, int wr, int wc, int fr, int fq) const {
        const int row0 = u.pm * BM + wr * 64 + fr, col0 = u.pn * BM + wc * 32 + 4 * fq;
#pragma unroll
        for (int ai = 0; ai < 2; ++ai)
#pragma unroll
            for (int m = 0; m < 4; ++m) { float* rowp = C + (size_t)(row0 + ai * HALF + m * 16) * ldc + col0;
#pragma unroll
                for (int bj = 0; bj < 2; ++bj)
#pragma unroll
                    for (int n = 0; n < 2; ++n) *(f32x4*)(rowp + bj * HALF + n * 16) = acc[ai][bj][m][n]; }
    }
};
typedef _Float16 f16x8 __attribute__((ext_vector_type(8)));
typedef _Float16 f16x4 __attribute__((ext_vector_type(4)));
struct EpiResid {
    static constexpr bool PERM = true, AFTER_DRAIN = false;
    const float* src32; const _Float16* srcT; _Float16* dstT; float* dstC; const float* gate; float alpha;
    const float* stats; const float* gam; const float* bet;
    __device__ __forceinline__ void operator()(const f32x4 (&acc)[2][2][4][2], const Unit& u, int wr, int wc, int fr_, int fq_) const {
        int fr = fr_, fq = fq_; asm volatile("" : "+v"(fr), "+v"(fq));
        const int col0 = u.pn * BM + wc * 32 + 8 * fq;
        if (u.pm >= 128) {
            const int rowc = (u.pm - 128) * BM + wr * 64 + fr;
#pragma unroll
            for (int bj = 0; bj < 2; ++bj)
#pragma unroll
                for (int n = 0; n < 2; ++n) { const int c = col0 + bj * HALF + 4 * n; const f32x4 gv = *(const f32x4*)(gate + 2 * 12288 + c);
#pragma unroll
                    for (int ai = 0; ai < 2; ++ai)
#pragma unroll
                        for (int m = 0; m < 4; ++m) { float* dp = dstC + ((size_t)(u.kofs >> 9) * 512 + (size_t)(rowc + ai * HALF + m * 16)) * 2048 + c; *(f32x4*)dp = gv * acc[ai][bj][m][n]; } }
            return;
        }
        const int rt = u.pm < 64 ? 0 : 1;
        const int row0 = u.pm * BM + wr * 64 + fr;
        const float* st = stats ? stats + 2 * (size_t)row0 : nullptr;
#pragma unroll
        for (int bj = 0; bj < 2; ++bj) {
            const int c = col0 + bj * HALF;
            const f32x4 gv0 = *(const f32x4*)(gate + rt * 12288 + c), gv1 = *(const f32x4*)(gate + rt * 12288 + c + 4);
            f32x4 ga0 = {alpha, alpha, alpha, alpha}, ga1 = ga0, ba0 = {0.f, 0.f, 0.f, 0.f}, ba1 = ba0;
            if (st) { ga0 = *(const f32x4*)(gam + c) * alpha; ga1 = *(const f32x4*)(gam + c + 4) * alpha; ba0 = *(const f32x4*)(bet + c) * alpha; ba1 = *(const f32x4*)(bet + c + 4) * alpha; }
#pragma unroll
            for (int ai = 0; ai < 2; ++ai)
#pragma unroll
                for (int m = 0; m < 4; ++m) { const size_t off = (size_t)(row0 + ai * HALF + m * 16) * 2048 + c;
                    f32x4 x0, x1;
                    if (src32) { x0 = *(const f32x4*)(src32 + off); x1 = *(const f32x4*)(src32 + off + 4); }
                    else { const f16x8 t = *(const f16x8*)(srcT + off); x0 = (f32x4){(float)t[0], (float)t[1], (float)t[2], (float)t[3]}; x1 = (f32x4){(float)t[4], (float)t[5], (float)t[6], (float)t[7]}; }
                    if (st) { const f32x2 ms = *(const f32x2*)(st + 2 * (ai * HALF + m * 16)); x0 = (x0 - ms.x) * ms.y; x1 = (x1 - ms.x) * ms.y; }
                    const f32x4 o0 = x0 * ga0 + ba0 + gv0 * acc[ai][bj][m][0], o1 = x1 * ga1 + ba1 + gv1 * acc[ai][bj][m][1];
                    const f16x8 w = {(_Float16)o0[0], (_Float16)o0[1], (_Float16)o0[2], (_Float16)o0[3], (_Float16)o1[0], (_Float16)o1[1], (_Float16)o1[2], (_Float16)o1[3]};
                    *(f16x8*)(dstT + off) = w; }
            asm volatile("" ::: "memory");
        }
    }
};
template <int CTRL> __device__ __forceinline__ float dppf(float old, float src) {
    return __builtin_bit_cast(float, __builtin_amdgcn_update_dpp(__builtin_bit_cast(int, old), __builtin_bit_cast(int, src), CTRL, 0xf, 0xf, false)); }
template <int CTRL> __device__ __forceinline__ float dppz(float src) {
    return __builtin_bit_cast(float, __builtin_amdgcn_update_dpp(0, __builtin_bit_cast(int, src), CTRL, 0xf, 0xf, true)); }
__device__ __forceinline__ float silu_e(float x) { return x * __builtin_amdgcn_rcpf(1.0f + __builtin_amdgcn_exp2f(-1.4426950408889634f * x)); }
struct EpiConvAct {
    static constexpr bool PERM = true, AFTER_DRAIN = false;
    bf16_t* ACT; float* HALO; const float* cw; const float* cb; unsigned halo_bytes;
    __device__ __forceinline__ void operator()(f32x4 (&acc)[2][2][4][2], const Unit& u, int wr, int wc, int fr_, int fq_) const {
        int fr = fr_, fq = fq_; asm volatile("" : "+v"(fr), "+v"(fq));
        constexpr int ROW_SHL1 = 0x101, ROW_SHL15 = 0x10F, ROW_SHR1 = 0x111, ROW_SHR15 = 0x11F;
        const int f0 = u.pn * 128 + wc * 32 + 8 * fq;
#define DPZ4(CTRL, SRC) (f32x4){dppz<CTRL>((SRC)[0]), dppz<CTRL>((SRC)[1]), dppz<CTRL>((SRC)[2]), dppz<CTRL>((SRC)[3])}
#define DPP4(CTRL, OLD, SRC) (f32x4){dppf<CTRL>((OLD)[0], (SRC)[0]), dppf<CTRL>((OLD)[1], (SRC)[1]), dppf<CTRL>((OLD)[2], (SRC)[2]), dppf<CTRL>((OLD)[3], (SRC)[3])}
        const f32x4 z4 = {0.f, 0.f, 0.f, 0.f};
        const __amdgpu_buffer_rsrc_t hrs = __builtin_amdgcn_make_buffer_rsrc(HALO, 0, (int)halo_bytes, 0x00020000);
        const int etop = (fr == 0) ? 0 : -4096, ebot = (fr == 15) ? 0 : -4096;
        f32x4 W0[2][2], W1[2][2], W2[2][2], BB[2][2];
#pragma unroll
        for (int bj = 0; bj < 2; ++bj)
#pragma unroll
            for (int n = 0; n < 2; ++n) { const float* wp = cw + bj * 5632 + f0 + 4 * n;
                W0[bj][n] = *(const f32x4*)(wp); W1[bj][n] = *(const f32x4*)(wp + 11264); W2[bj][n] = *(const f32x4*)(wp + 2 * 11264); BB[bj][n] = *(const f32x4*)(cb + bj * 5632 + f0 + 4 * n); }
#pragma unroll
        for (int bj = 0; bj < 2; ++bj)
#pragma unroll
            for (int n = 0; n < 2; ++n) {
                const f32x4 w0 = W0[bj][n], w1 = W1[bj][n], w2 = W2[bj][n], bb = BB[bj][n];
#pragma unroll
                for (int ai = 0; ai < 2; ++ai) {
                    const int hoff = (((4 * u.pm + 2 * ai + wr) * 2816 + ((bj * 5632 + f0) >> 2) + n) * 64);
                    f32x4 prev = z4;
#pragma unroll
                    for (int m = 0; m < 4; ++m) {
                        const f32x4 raw = acc[ai][bj][m][n];
                        f32x4 edge = bb;
                        if (m > 0) edge = edge + w0 * DPZ4(ROW_SHL15, prev);
                        if (m < 3) { const f32x4 nx = acc[ai][bj][m + 1][n]; edge = edge + w2 * DPZ4(ROW_SHR15, nx); }
                        const f32x4 c = w0 * DPZ4(ROW_SHR1, raw) + (w2 * DPZ4(ROW_SHL1, raw) + (w1 * raw + edge));
                        if (m == 0) { __builtin_amdgcn_raw_buffer_store_b128(__builtin_bit_cast(u32x4, raw), hrs, (hoff | etop), 0, 0); __builtin_amdgcn_raw_buffer_store_b128(__builtin_bit_cast(u32x4, c), hrs, ((hoff + 16) | etop), 0, 0); }
                        if (m == 3) { __builtin_amdgcn_raw_buffer_store_b128(__builtin_bit_cast(u32x4, raw), hrs, ((hoff + 32) | ebot), 0, 0); __builtin_amdgcn_raw_buffer_store_b128(__builtin_bit_cast(u32x4, c), hrs, ((hoff + 48) | ebot), 0, 0); }
                        acc[ai][bj][m][n] = c; prev = raw;
                        __builtin_amdgcn_sched_barrier(0);
                    }
                }
            }
#undef DPP4
#undef DPZ4
        const int row0 = u.pm * BM + wr * 64 + fr;
#pragma unroll
        for (int ai = 0; ai < 2; ++ai)
#pragma unroll
            for (int m = 0; m < 4; ++m) {
                u32x4 w;
                { const f32x4 g = acc[ai][0][m][0], v = acc[ai][1][m][0]; w.x = cvt_pk_bf16(silu_e(g[0]) * v[0], silu_e(g[1]) * v[1]); w.y = cvt_pk_bf16(silu_e(g[2]) * v[2], silu_e(g[3]) * v[3]); }
                { const f32x4 g = acc[ai][0][m][1], v = acc[ai][1][m][1]; w.z = cvt_pk_bf16(silu_e(g[0]) * v[0], silu_e(g[1]) * v[1]); w.w = cvt_pk_bf16(silu_e(g[2]) * v[2], silu_e(g[3]) * v[3]); }
                *(u32x4*)(ACT + (size_t)(row0 + ai * HALF + m * 16) * 5632 + f0) = w;
            }
    }
};

template <bool COH_B = false> struct EpiConvGateT {
    static constexpr bool PERM = true, AFTER_DRAIN = false;
    bf16_t* OUT; float* HALO; const bf16_t* Bb; const float* cw; unsigned halo_bytes;
    __device__ __forceinline__ void operator()(f32x4 (&acc)[2][2][4][2], const Unit& u, int wr, int wc, int fr_, int fq_) const {
        int fr = fr_, fq = fq_; asm volatile("" : "+v"(fr), "+v"(fq));
        constexpr int ROW_SHL1 = 0x101, ROW_SHL15 = 0x10F, ROW_SHR1 = 0x111, ROW_SHR15 = 0x11F;
        const int f0 = u.pn * 128 + wc * 32 + 8 * fq;
#define DPZ4(CTRL, SRC) (f32x4){dppz<CTRL>((SRC)[0]), dppz<CTRL>((SRC)[1]), dppz<CTRL>((SRC)[2]), dppz<CTRL>((SRC)[3])}
        const f32x4 z4 = {0.f, 0.f, 0.f, 0.f};
        const __amdgpu_buffer_rsrc_t hrs = __builtin_amdgcn_make_buffer_rsrc(HALO, 0, (int)halo_bytes, 0x00020000);
        const int etop = (fr == 0) ? 0 : -4096, ebot = (fr == 15) ? 0 : -4096;
        f32x4 W0[2], W1[2], W2[2];
#pragma unroll
        for (int n = 0; n < 2; ++n) { W0[n] = *(const f32x4*)(cw + f0 + 4 * n); W1[n] = *(const f32x4*)(cw + 2048 + f0 + 4 * n); W2[n] = *(const f32x4*)(cw + 4096 + f0 + 4 * n); }
#pragma unroll
        for (int n = 0; n < 2; ++n) {
            const f32x4 w0 = W0[n], w1 = W1[n], w2 = W2[n];
#pragma unroll
            for (int ai = 0; ai < 2; ++ai) {
                const int hoff = (((4 * u.pm + 2 * ai + wr) * 512 + (f0 >> 2) + n) * 64);
#pragma unroll
                for (int m = 0; m < 4; ++m) acc[ai][0][m][n] = acc[ai][0][m][n] * acc[ai][1][m][n];
                f32x4 prev = z4;
#pragma unroll
                for (int m = 0; m < 4; ++m) {
                    const f32x4 raw = acc[ai][0][m][n];
                    f32x4 edge = z4;
                    if (m > 0) edge = edge + w0 * DPZ4(ROW_SHL15, prev);
                    if (m < 3) { const f32x4 nx = acc[ai][0][m + 1][n]; edge = edge + w2 * DPZ4(ROW_SHR15, nx); }
                    const f32x4 c = w0 * DPZ4(ROW_SHR1, raw) + (w2 * DPZ4(ROW_SHL1, raw) + (w1 * raw + edge));
                    if (m == 0) { __builtin_amdgcn_raw_buffer_store_b128(__builtin_bit_cast(u32x4, raw), hrs, (hoff | etop), 0, 0); __builtin_amdgcn_raw_buffer_store_b128(__builtin_bit_cast(u32x4, c), hrs, ((hoff + 16) | etop), 0, 0); }
                    if (m == 3) { __builtin_amdgcn_raw_buffer_store_b128(__builtin_bit_cast(u32x4, raw), hrs, ((hoff + 32) | ebot), 0, 0); __builtin_amdgcn_raw_buffer_store_b128(__builtin_bit_cast(u32x4, c), hrs, ((hoff + 48) | ebot), 0, 0); }
                    acc[ai][1][m][n] = c; prev = raw;
                    __builtin_amdgcn_sched_barrier(0);
                }
            }
        }
#undef DPZ4
        const int row0 = u.pm * BM + wr * 64 + fr;
#pragma unroll
        for (int ai = 0; ai < 2; ++ai)
#pragma unroll
            for (int m = 0; m < 4; ++m) { const size_t off = (size_t)(row0 + ai * HALF + m * 16) * 2048 + f0;
                u32x4 bw;
                if constexpr (COH_B) { const unsigned long long* bp_ = (const unsigned long long*)(Bb + off);
                    const unsigned long long q0 = __hip_atomic_load(bp_, __ATOMIC_RELAXED, __HIP_MEMORY_SCOPE_AGENT), q1 = __hip_atomic_load(bp_ + 1, __ATOMIC_RELAXED, __HIP_MEMORY_SCOPE_AGENT);
                    bw = (u32x4){(unsigned)q0, (unsigned)(q0 >> 32), (unsigned)q1, (unsigned)(q1 >> 32)}; }
                else bw = *(const u32x4*)(Bb + off);
                const f32x4 z0 = acc[ai][1][m][0], z1 = acc[ai][1][m][1];
                u32x4 w;
                w.x = cvt_pk_bf16(__uint_as_float(bw.x << 16) * z0[0], __uint_as_float(bw.x & 0xffff0000u) * z0[1]); w.y = cvt_pk_bf16(__uint_as_float(bw.y << 16) * z0[2], __uint_as_float(bw.y & 0xffff0000u) * z0[3]);
                w.z = cvt_pk_bf16(__uint_as_float(bw.z << 16) * z1[0], __uint_as_float(bw.z & 0xffff0000u) * z1[1]); w.w = cvt_pk_bf16(__uint_as_float(bw.w << 16) * z1[2], __uint_as_float(bw.w & 0xffff0000u) * z1[3]);
                *(u32x4*)(OUT + off) = w; }
    }
};

typedef EpiConvGateT<false> EpiConvGate;
struct EpiConvBoth {
    static constexpr bool PERM = true, AFTER_DRAIN = false;
    EpiBf16<0> eb; EpiConvGateT<true> eg; StaticOrder sb; unsigned* flags; unsigned* tmo; int G;
    __device__ __forceinline__ void operator()(f32x4 (&acc)[2][2][4][2], const Unit& u, int wr, int wc, int fr, int fq) const {
        if (u.pn < 8) { eb(acc, u, wr, wc, fr, fq); return; }
        { const int Lo = sb.block_of(u.pm, (u.pn - 8) >> 1), co = Lo % G, ro = Lo / G, lasto = (sb.nwg - 1 - co) / G;
          const unsigned need = lasto >= 3 ? (unsigned)((ro > 3 ? ro : 3) - 2) : 1u;
          unsigned* f = flags + 512 + co; unsigned sp = 0u;
          while ((unsigned)__builtin_amdgcn_readfirstlane((int)__hip_atomic_load(f, __ATOMIC_RELAXED, __HIP_MEMORY_SCOPE_AGENT)) < need) { __builtin_amdgcn_s_sleep(1);
              if ((++sp & 255u) == 0u) { if (__hip_atomic_load(tmo, __ATOMIC_RELAXED, __HIP_MEMORY_SCOPE_AGENT)) break; if (sp > (1u << 18)) { (void)__hip_atomic_fetch_add(tmo, 1u, __ATOMIC_RELAXED, __HIP_MEMORY_SCOPE_AGENT); break; } } }
        }
        Unit u2 = u; u2.pn = u.pn - 8; eg(acc, u2, wr, wc, fr, fq);
    }
};

struct EpiDqkv {
    static constexpr bool PERM = true, AFTER_DRAIN = false;
    bf16_t* CQ; bf16_t* CKV; float* KRRAW; float* SSQ; unsigned ssq_bytes;
    __device__ __forceinline__ void operator()(const f32x4 (&acc)[2][2][4][2], const Unit& u, int wr, int wc, int fr_, int fq_) const {
        int fr = fr_, fq = fq_; asm volatile("" : "+v"(fr), "+v"(fq));
        const int row0 = u.pm * BM + wr * 64 + fr;
        if (u.pn == 4) {
            if (wc < 2) {
#pragma unroll
                for (int ai = 0; ai < 2; ++ai)
#pragma unroll
                    for (int m = 0; m < 4; ++m) { float* p = KRRAW + (size_t)(row0 + ai * HALF + m * 16) * 64 + wc * 32 + 8 * fq;
                        *(f32x4*)p = acc[ai][0][m][0]; *(f32x4*)(p + 4) = acc[ai][0][m][1]; }
            }
            return;
        }
        bf16_t* base = (u.pn < 2 ? CQ : CKV); const int col0 = (u.pn & 1) * BM + wc * 32 + 8 * fq;
        const __amdgpu_buffer_rsrc_t srs = __builtin_amdgcn_make_buffer_rsrc(SSQ, 0, (int)ssq_bytes, 0x00020000);
        const int slot = (u.pn >> 1) * 8 + (u.pn & 1) * 4 + wc, lane = fr + 16 * fq, keep = (fq == 0) ? 0 : -4096;
#pragma unroll
        for (int ai = 0; ai < 2; ++ai)
#pragma unroll
            for (int m = 0; m < 4; ++m) { const int row = row0 + ai * HALF + m * 16; float s = 0.f;
#pragma unroll
                for (int bj = 0; bj < 2; ++bj) { const f32x4 v0 = acc[ai][bj][m][0], v1 = acc[ai][bj][m][1];
                    s += (v0[0] * v0[0] + v0[1] * v0[1]) + (v0[2] * v0[2] + v0[3] * v0[3]) + (v1[0] * v1[0] + v1[1] * v1[1]) + (v1[2] * v1[2] + v1[3] * v1[3]);
                    u32x4 w; w.x = cvt_pk_bf16(v0[0], v0[1]); w.y = cvt_pk_bf16(v0[2], v0[3]); w.z = cvt_pk_bf16(v1[0], v1[1]); w.w = cvt_pk_bf16(v1[2], v1[3]);
                    *(u32x4*)(base + (size_t)row * 512 + col0 + bj * HALF) = w; }
                s += __builtin_bit_cast(float, __builtin_amdgcn_ds_bpermute((lane ^ 16) << 2, __builtin_bit_cast(int, s)));
                s += __builtin_bit_cast(float, __builtin_amdgcn_ds_bpermute((lane ^ 32) << 2, __builtin_bit_cast(int, s)));
                __builtin_amdgcn_raw_buffer_store_b32(__builtin_bit_cast(unsigned, s), srs, ((row * 16 + slot) * 4) | keep, 0, 0); }
    }
};
struct EpiBf16Row {
    static constexpr bool PERM = true, AFTER_DRAIN = false;
    bf16_t* O; int ldc; int split_cols; size_t split_stride; const float* ssq; float eps; int hm_rows;
    __device__ __forceinline__ void operator()(const f32x4 (&acc)[2][2][4][2], const Unit& u, int wr, int wc, int fr_, int fq_) const {
        int fr = fr_, fq = fq_; asm volatile("" : "+v"(fr), "+v"(fq));
        const int row0 = u.pm * BM + wr * 64 + fr; int colt = u.pn * BM; bf16_t* base = O;
        if (split_cols) { const int t = colt / split_cols; base += (size_t)t * split_stride; colt -= t * split_cols; }
        const int col0 = colt + wc * 32 + 8 * fq;
#pragma unroll
        for (int ai = 0; ai < 2; ++ai)
#pragma unroll
            for (int m = 0; m < 4; ++m) { const int row = row0 + ai * HALF + m * 16;
                const f32x4 a = *(const f32x4*)(ssq + (size_t)row * 16), b = *(const f32x4*)(ssq + (size_t)row * 16 + 4);
                const float sc = 1.0f / sqrtf(((a[0] + a[1]) + (a[2] + a[3]) + (b[0] + b[1]) + (b[2] + b[3])) * (1.0f / 512.0f) + eps);
                bf16_t* rowp = hm_rows ? base + ((size_t)(colt >> 7) * hm_rows + row) * 128 + wc * 32 + 8 * fq : base + (size_t)row * ldc + col0;
                const size_t bstep = hm_rows ? (size_t)hm_rows * 128 : (size_t)HALF;
#pragma unroll
                for (int bj = 0; bj < 2; ++bj) { const f32x4 v0 = acc[ai][bj][m][0] * sc, v1 = acc[ai][bj][m][1] * sc;
                    u32x4 w; w.x = cvt_pk_bf16(v0[0], v0[1]); w.y = cvt_pk_bf16(v0[2], v0[3]); w.z = cvt_pk_bf16(v1[0], v1[1]); w.w = cvt_pk_bf16(v1[2], v1[3]);
                    *(u32x4*)(rowp + bj * bstep) = w; } }
    }
};
template <class Epi, class Sched, bool ALIGN_EPI = false, bool SP2 = false>
__device__ __forceinline__ void gemm_phase(PG8_LAS unsigned char* lds, const Gemm g, const Sched& S, const Epi& E, int wave_sgpr) {
    int tid_ = tid_from_wave(wave_sgpr);
    const int tid = tid_, wid = __builtin_amdgcn_readfirstlane(tid >> 6), lane = tid & 63, wr = wid >> 2, wc = wid & 3, fr = lane & 15, fq = lane >> 4;
    const int K = g.K, nt = K / BK;
    unsigned voffA[2], voffB[2];
#pragma unroll
    for (int i = 0; i < 2; ++i) { int R, C; stage_rc(tid * 16 + i * 8192, R, C); const int Rb = Epi::PERM ? ((R & ~31) + perm32(R & 31)) : R;
        voffA[i] = (unsigned)(R * K + C) * 2u; voffB[i] = (unsigned)(Rb * K + C) * 2u; }
    const size_t kstep = (size_t)(BK * 2);
    const size_t hstep = (size_t)HALF * K * 2;
    const size_t tstep = 2 * hstep;
    const unsigned ldsw = (unsigned)wid * 1024u;
    const int aoff = lds_byte(wr * 64 + fr, fq * 8), boff = lds_byte(wc * 32 + fr, fq * 8);
#define PG8_SA(b, h) (((b) * 2 + (h)) * HTB)
#define PG8_SB(b, h) ((4 + (b) * 2 + (h)) * HTB)
#define PG8_STAGE(bufoff, gbase, voff) do { _Pragma("unroll") for (int _i = 0; _i < 2; ++_i) \
        __builtin_amdgcn_global_load_lds((const unsigned*)((const char*)(gbase) + (voff)[_i]), (PG8_LAS unsigned*)(lds + (bufoff) + ldsw + _i * 8192), 16, 0, 0); } while (0)
#define PG8_LDA(dst, b, h) do { _Pragma("unroll") for (int m = 0; m < 4; ++m) _Pragma("unroll") for (int k = 0; k < 2; ++k) dst[m][k] = *(const PG8_LAS bf16x8*)(lds + PG8_SA(b, h) + aoff + m * 2048 + k * 1024); } while (0)
#define PG8_LDB(dst, b, h) do { _Pragma("unroll") for (int n = 0; n < 2; ++n) _Pragma("unroll") for (int k = 0; k < 2; ++k) dst[n][k] = *(const PG8_LAS bf16x8*)(lds + PG8_SB(b, h) + boff + n * 2048 + k * 1024); } while (0)
#define PG8_MMA(ai, bj, At, Bt) do { __builtin_amdgcn_s_setprio(1); _Pragma("unroll") for (int m = 0; m < 4; ++m) _Pragma("unroll") for (int n = 0; n < 2; ++n) _Pragma("unroll") for (int k = 0; k < 2; ++k) \
        acc[ai][bj][m][n] = __builtin_amdgcn_mfma_f32_16x16x32_bf16(Bt[n][k], At[m][k], acc[ai][bj][m][n], 0, 0, 0); __builtin_amdgcn_s_setprio(0); } while (0)
#define PG8_WAIT_V(n) asm volatile("s_waitcnt vmcnt(" #n ")" ::: "memory")
#define PG8_WAIT_L(n) asm volatile("s_waitcnt lgkmcnt(" #n ")" ::: "memory")
#define PG8_BAR __builtin_amdgcn_s_barrier()
#define PG8_SCHED __builtin_amdgcn_sched_barrier(0)
    Unit cur, nxt; int ui = 0;
    if (!S.next(0, cur)) return;
    f32x4 acc[2][2][4][2];
#pragma unroll
    for (int a = 0; a < 2; ++a)
#pragma unroll
        for (int b = 0; b < 2; ++b)
#pragma unroll
            for (int m = 0; m < 4; ++m)
#pragma unroll
                for (int n = 0; n < 2; ++n) acc[a][b][m][n] = (f32x4){0.f, 0.f, 0.f, 0.f};
    bf16x8 At[4][2], B0[2][2], B1[2][2];
    const char* cA = (const char*)g.A + (size_t)cur.pm * tstep + (size_t)cur.kofs * 2; const char* cB = (const char*)g.Bt + (size_t)cur.pn * tstep + (size_t)cur.kofs * 2;
    int cnt = cur.nt ? cur.nt : nt;
    S.a_ready(cur);
    if constexpr (SP2) {
        PG8_STAGE(PG8_SB(0, 0), cB, voffB); PG8_STAGE(PG8_SB(0, 1), cB + hstep, voffB); PG8_STAGE(PG8_SA(0, 0), cA, voffA); PG8_STAGE(PG8_SA(0, 1), cA + hstep, voffA);
        if (wr == 1) PG8_BAR;
        PG8_WAIT_V(2); PG8_BAR;
        PG8_STAGE(PG8_SB(1, 0), cB + kstep, voffB); PG8_STAGE(PG8_SA(1, 0), cA + kstep, voffA); PG8_STAGE(PG8_SB(1, 1), cB + hstep + kstep, voffB);
        PG8_WAIT_V(6); PG8_BAR;
    } else {
        PG8_STAGE(PG8_SB(0, 0), cB, voffB); PG8_STAGE(PG8_SA(0, 0), cA, voffA); PG8_STAGE(PG8_SB(0, 1), cB + hstep, voffB); PG8_STAGE(PG8_SA(0, 1), cA + hstep, voffA);
        if (wr == 1) PG8_BAR;
        PG8_WAIT_V(4); PG8_BAR;
        PG8_STAGE(PG8_SB(1, 0), cB + kstep, voffB); PG8_STAGE(PG8_SA(1, 0), cA + kstep, voffA); PG8_STAGE(PG8_SB(1, 1), cB + hstep + kstep, voffB);
        PG8_WAIT_V(6); PG8_BAR;
    }
    for (;;) {
        const bool has_next = S.next(ui + 1, nxt);
        const char* nA = has_next ? (const char*)g.A + (size_t)nxt.pm * tstep + (size_t)nxt.kofs * 2 : cA; const char* nB = has_next ? (const char*)g.Bt + (size_t)nxt.pn * tstep + (size_t)nxt.kofs * 2 : cB;
        for (int t = 0; t < cnt; t += 2) {
            const bool last = (t == cnt - 2);
            const char* a1 = cA + (size_t)(t + 1) * kstep;
            const char* a2 = last ? nA : cA + (size_t)(t + 2) * kstep; const char* b2 = last ? nB : cB + (size_t)(t + 2) * kstep;
            const char* a3 = a2 + kstep; const char* b3 = b2 + kstep;
            if (last && has_next) S.a_ready(nxt);
            if constexpr (SP2) {
            PG8_LDB(B0, 0, 0); PG8_LDB(B1, 0, 1); PG8_SCHED; PG8_LDA(At, 0, 0); PG8_STAGE(PG8_SA(1, 1), a1 + hstep, voffA);
            PG8_WAIT_V(8); PG8_WAIT_L(0); PG8_BAR; PG8_MMA(0, 0, At, B0); PG8_MMA(0, 1, At, B1); PG8_BAR; PG8_SCHED;
            PG8_LDA(At, 0, 1); PG8_STAGE(PG8_SB(0, 0), b2, voffB); PG8_STAGE(PG8_SB(0, 1), b2 + hstep, voffB); PG8_STAGE(PG8_SA(0, 0), a2, voffA);
            PG8_WAIT_V(8); PG8_WAIT_L(0); PG8_BAR; PG8_MMA(1, 0, At, B0); PG8_MMA(1, 1, At, B1); PG8_BAR; PG8_SCHED;
            PG8_LDB(B0, 1, 0); PG8_LDB(B1, 1, 1); PG8_SCHED; PG8_LDA(At, 1, 0); PG8_STAGE(PG8_SA(0, 1), a2 + hstep, voffA);
            PG8_WAIT_V(8); PG8_WAIT_L(0); PG8_BAR; PG8_MMA(0, 0, At, B0); PG8_MMA(0, 1, At, B1); PG8_BAR; PG8_SCHED;
            PG8_LDA(At, 1, 1); PG8_STAGE(PG8_SB(1, 0), b3, voffB); PG8_STAGE(PG8_SB(1, 1), b3 + hstep, voffB); PG8_STAGE(PG8_SA(1, 0), a3, voffA);
            PG8_WAIT_V(8); PG8_WAIT_L(0); PG8_BAR; PG8_MMA(1, 0, At, B0); PG8_MMA(1, 1, At, B1); PG8_BAR; PG8_SCHED;
            } else {
            PG8_LDB(B0, 0, 0); PG8_SCHED; PG8_LDA(At, 0, 0); PG8_STAGE(PG8_SA(1, 1), a1 + hstep, voffA);
            PG8_WAIT_L(8); PG8_BAR; PG8_WAIT_L(0); PG8_MMA(0, 0, At, B0); PG8_BAR; PG8_SCHED;
            PG8_LDB(B1, 0, 1); PG8_STAGE(PG8_SB(0, 0), b2, voffB);
            PG8_BAR; PG8_WAIT_L(0); PG8_MMA(0, 1, At, B1); PG8_BAR;
            PG8_LDA(At, 0, 1); PG8_STAGE(PG8_SA(0, 0), a2, voffA);
            PG8_BAR; PG8_WAIT_L(0); PG8_MMA(1, 0, At, B0); PG8_BAR; PG8_SCHED;
            PG8_STAGE(PG8_SB(0, 1), b2 + hstep, voffB);
            PG8_WAIT_V(6); PG8_BAR; PG8_MMA(1, 1, At, B1); PG8_BAR;
            PG8_LDB(B0, 1, 0); PG8_SCHED; PG8_LDA(At, 1, 0); PG8_STAGE(PG8_SA(0, 1), a2 + hstep, voffA);
            PG8_WAIT_L(8); PG8_BAR; PG8_WAIT_L(0); PG8_MMA(0, 0, At, B0); PG8_BAR; PG8_SCHED;
            PG8_LDB(B1, 1, 1); PG8_STAGE(PG8_SB(1, 0), b3, voffB);
            PG8_BAR; PG8_WAIT_L(0); PG8_MMA(0, 1, At, B1); PG8_BAR;
            PG8_LDA(At, 1, 1); PG8_STAGE(PG8_SA(1, 0), a3, voffA);
            PG8_BAR; PG8_WAIT_L(0); PG8_MMA(1, 0, At, B0); PG8_BAR; PG8_SCHED;
            PG8_STAGE(PG8_SB(1, 1), b3 + hstep, voffB);
            PG8_WAIT_V(6); PG8_BAR; PG8_MMA(1, 1, At, B1); PG8_BAR;
            }
        }
        if constexpr (ALIGN_EPI) { if (wr == 0) PG8_BAR; }
        if constexpr (!Epi::AFTER_DRAIN) { E(acc, cur, wr, wc, fr, fq); S.done(cur); }
        if (!has_next) break;
#pragma unroll
        for (int a = 0; a < 2; ++a)
#pragma unroll
            for (int b = 0; b < 2; ++b)
#pragma unroll
                for (int m = 0; m < 4; ++m)
#pragma unroll
                    for (int n = 0; n < 2; ++n) acc[a][b][m][n] = (f32x4){0.f, 0.f, 0.f, 0.f};
        cur = nxt; cA = nA; cB = nB; ++ui; cnt = cur.nt ? cur.nt : nt;
        if constexpr (ALIGN_EPI) { if (wr == 1) PG8_BAR; }
    }
    PG8_WAIT_V(0);
    if constexpr (!ALIGN_EPI) { if (wr == 0) PG8_BAR; }
    PG8_BAR;
    if constexpr (Epi::AFTER_DRAIN) { E.fused(acc, cur, wr, wc, fr, fq, lds, wid, lane); S.done(cur); }
#undef PG8_SA
#undef PG8_SB
#undef PG8_STAGE
#undef PG8_LDA
#undef PG8_LDB
#undef PG8_MMA
#undef PG8_WAIT_V
#undef PG8_WAIT_L
#undef PG8_BAR
#undef PG8_SCHED
}
}

namespace att {
#define ATT_LAS __attribute__((address_space(3)))
typedef unsigned short bf16_t;
using bf16x8 = __attribute__((ext_vector_type(8))) short;
using s16x4  = __attribute__((ext_vector_type(4))) short;
using f32x16 = __attribute__((ext_vector_type(16))) float;
using f32x2  = __attribute__((ext_vector_type(2))) float;
using f32x4  = __attribute__((ext_vector_type(4))) float;
using u32x4  = __attribute__((ext_vector_type(4))) unsigned;
constexpr int NW = 8, QBLK = 32, KVBLK = 64;
constexpr float SCALE = 0.07216878364870323f;
constexpr float THR = 8.f;
constexpr int SDEPTH = ATT_SDEPTH;
constexpr int LDQ = 3072, LDK = 128, LDKR = 64, LDO = 2048;
constexpr int SHM_V = KVBLK * 128 * 2, SHM_K = KVBLK * 128 * 2, SHM_KR = KVBLK * 64 * 2;
constexpr int OFF_V = 0, OFF_K = 2 * SHM_V, OFF_KR = OFF_K + 2 * SHM_K, OFF_WS = OFF_KR + 2 * SHM_KR, OFF_QR = OFF_WS + NW * 64 * 4, ATT_LDS_BYTES = OFF_QR + NW * 4096;
#define KSWZ(row, colB) ((row) * 256 + ((colB) ^ (((row) & 7) << 4)))
#define KRSWZ(row, colB) ((row) * 128 + ((colB) ^ ((((row) >> 1) & 7) << 4)))
#define SBAR() __builtin_amdgcn_sched_barrier(0)
__device__ __forceinline__ int crow(int r, int hi) { return (r & 3) + 8 * (r >> 2) + 4 * hi; }
__device__ __forceinline__ unsigned cvtpk(float lo, float hi) { unsigned r; asm volatile("v_cvt_pk_bf16_f32 %0, %1, %2" : "=v"(r) : "v"(lo), "v"(hi)); return r; }
__device__ __forceinline__ float bf2f(unsigned short b) { return __uint_as_float(((unsigned)b) << 16); }

__device__ __forceinline__ void partialSM(f32x16& p0, f32x16& p1, float& m_reg, float& mn, float& alpha) {
  constexpr float C = SCALE * 1.4426950408889634f;
  float pmax = p0[0];
#pragma unroll
  for (int r = 1; r < 16; ++r) pmax = fmaxf(pmax, p0[r]);
#pragma unroll
  for (int r = 0; r < 16; ++r) pmax = fmaxf(pmax, p1[r]);
  { auto rr = __builtin_amdgcn_permlane32_swap(__float_as_uint(pmax), __float_as_uint(pmax), false, false);
    pmax = fmaxf(__uint_as_float(rr[0]), __uint_as_float(rr[1])); }
  if (__builtin_expect(__all(pmax - m_reg <= THR / SCALE), 1)) { mn = m_reg; alpha = 1.f; }
  else { mn = fmaxf(m_reg, pmax); alpha = __builtin_amdgcn_exp2f((m_reg - mn) * C); m_reg = mn; }
  float mnC = -mn * C;
#pragma unroll
  for (int r = 0; r < 16; ++r) p0[r] = fmaf(p0[r], C, mnC);
#pragma unroll
  for (int r = 0; r < 16; ++r) p1[r] = fmaf(p1[r], C, mnC);
#pragma unroll
  for (int r = 0; r < 16; ++r) p0[r] = __builtin_amdgcn_exp2f(p0[r]);
}
__device__ __forceinline__ void finishSM(f32x16& p0, f32x16& p1, float alpha, float& l_reg, bf16x8& pa0, bf16x8& pa1, bf16x8& pa2, bf16x8& pa3) {
#pragma unroll
  for (int r = 0; r < 16; ++r) p1[r] = __builtin_amdgcn_exp2f(p1[r]);
  float ps = 0;
#pragma unroll
  for (int r = 0; r < 16; ++r) ps += p0[r];
#pragma unroll
  for (int r = 0; r < 16; ++r) ps += p1[r];
  { auto rr = __builtin_amdgcn_permlane32_swap(__float_as_uint(ps), __float_as_uint(ps), false, false);
    ps = __uint_as_float(rr[0]) + __uint_as_float(rr[1]); }
  l_reg = l_reg * alpha + ps;
#define PK4(P, BASE, OUT) do { unsigned a0 = cvtpk(P[BASE + 0], P[BASE + 1]), a1 = cvtpk(P[BASE + 2], P[BASE + 3]);   \
    unsigned b0 = cvtpk(P[BASE + 4], P[BASE + 5]), b1 = cvtpk(P[BASE + 6], P[BASE + 7]);                              \
    auto r0 = __builtin_amdgcn_permlane32_swap(a0, b0, false, false); auto r1 = __builtin_amdgcn_permlane32_swap(a1, b1, false, false); \
    u32x4 w = {r0[0], r1[0], r0[1], r1[1]}; OUT = *reinterpret_cast<bf16x8*>(&w); } while (0)
  PK4(p0, 0, pa0); PK4(p0, 8, pa1); PK4(p1, 0, pa2); PK4(p1, 8, pa3);
#undef PK4
}
__device__ __forceinline__ void qkt(f32x16& p0, f32x16& p1, const ATT_LAS char* Ks, const ATT_LAS char* Kr, const ATT_LAS char* Qr, const bf16x8* qr, int r32, int hi) {
  p0 = f32x16{}; p1 = f32x16{};
#pragma unroll
  for (int d0 = 0; d0 < 8; ++d0) { const int cb = (d0 * 16 + hi * 8) * 2;
    bf16x8 b0 = *reinterpret_cast<const ATT_LAS bf16x8*>(Ks + KSWZ(r32, cb));
    bf16x8 b1 = *reinterpret_cast<const ATT_LAS bf16x8*>(Ks + KSWZ(32 + r32, cb));
    p0 = __builtin_amdgcn_mfma_f32_32x32x16_bf16(b0, qr[d0], p0, 0, 0, 0);
    p1 = __builtin_amdgcn_mfma_f32_32x32x16_bf16(b1, qr[d0], p1, 0, 0, 0); }
#pragma unroll
  for (int d1 = 0; d1 < 4; ++d1) { const int cb = (d1 * 16 + hi * 8) * 2;
    bf16x8 b0 = *reinterpret_cast<const ATT_LAS bf16x8*>(Kr + KRSWZ(r32, cb));
    bf16x8 b1 = *reinterpret_cast<const ATT_LAS bf16x8*>(Kr + KRSWZ(32 + r32, cb));
    bf16x8 qq = *reinterpret_cast<const ATT_LAS bf16x8*>(Qr + KRSWZ(r32, cb));
    p0 = __builtin_amdgcn_mfma_f32_32x32x16_bf16(b0, qq, p0, 0, 0, 0);
    p1 = __builtin_amdgcn_mfma_f32_32x32x16_bf16(b1, qq, p1, 0, 0, 0); }
}
__device__ __forceinline__ int v_st(int k, int c) { const int kk = (k & ~0xC) | ((k & 4) << 1) | ((k & 8) >> 1); return ((kk >> 3) * 4 + (c >> 5)) * 512 + ((kk & 7) * 32 + (c & 31)) * 2; }
__device__ __forceinline__ int v_rd_base(int lane) { return ((lane & 3) << 3) | (((lane >> 2) & 3) << 6) | (((lane >> 4) & 1) << 5) | (((lane >> 5) & 1) << 8); }
constexpr int v_rd_off(int d0, int ks, int half) { return d0 * 512 + ks * 4096 + half * 2048; }
template <int OFF> __device__ __forceinline__ s16x4 tr_read(int vb) {
  s16x4 r; asm volatile("ds_read_b64_tr_b16 %0, %1 offset:%2" : "=&v"(r) : "v"(vb), "i"(OFF) : "memory"); return r;
}
template <int D0> __device__ __forceinline__ void pv_one(f32x16& od, int vb, bf16x8 pa0, bf16x8 pa1, bf16x8 pa2, bf16x8 pa3) {
  const s16x4 l0 = tr_read<v_rd_off(D0, 0, 0)>(vb), h0 = tr_read<v_rd_off(D0, 0, 1)>(vb), l1 = tr_read<v_rd_off(D0, 1, 0)>(vb), h1 = tr_read<v_rd_off(D0, 1, 1)>(vb);
  const s16x4 l2 = tr_read<v_rd_off(D0, 2, 0)>(vb), h2 = tr_read<v_rd_off(D0, 2, 1)>(vb), l3 = tr_read<v_rd_off(D0, 3, 0)>(vb), h3 = tr_read<v_rd_off(D0, 3, 1)>(vb);
  asm volatile("s_waitcnt lgkmcnt(0)" ::: "memory"); SBAR();
#define PK(L, H) (bf16x8){L[0], L[1], L[2], L[3], H[0], H[1], H[2], H[3]}
  od = __builtin_amdgcn_mfma_f32_32x32x16_bf16(pa0, PK(l0, h0), od, 0, 0, 0);
  od = __builtin_amdgcn_mfma_f32_32x32x16_bf16(pa1, PK(l1, h1), od, 0, 0, 0);
  od = __builtin_amdgcn_mfma_f32_32x32x16_bf16(pa2, PK(l2, h2), od, 0, 0, 0);
  od = __builtin_amdgcn_mfma_f32_32x32x16_bf16(pa3, PK(l3, h3), od, 0, 0, 0);
#undef PK
}
__device__ __forceinline__ void pv_d0(f32x16* o, int vb, bf16x8 pa0, bf16x8 pa1, bf16x8 pa2, bf16x8 pa3) {
  pv_one<0>(o[0], vb, pa0, pa1, pa2, pa3); pv_one<1>(o[1], vb, pa0, pa1, pa2, pa3); pv_one<2>(o[2], vb, pa0, pa1, pa2, pa3); pv_one<3>(o[3], vb, pa0, pa1, pa2, pa3);
}

__device__ __forceinline__ void attn_unit(const bf16_t* Qb, const bf16_t* Kh, const bf16_t* Vh, const bf16_t* KRb, bf16_t* Ob,
                                          int xrow0, int nx, int crow0, int NT, int rope, int pos0, const f32x2* ropeR, const f32x2* ropeC, ATT_LAS char* lds, int wave_sgpr) {
  int tid_ = tid_from_wave(wave_sgpr);
  const int tid = tid_, wid = tid >> 6, lane = tid & 63, r32 = lane & 31, hi = lane >> 5;
  ATT_LAS char* V_lds = lds + OFF_V; ATT_LAS char* K_lds = lds + OFF_K; ATT_LAS char* KR_lds = lds + OFF_KR;
  ATT_LAS float* ws = (ATT_LAS float*)(lds + OFF_WS) + wid * 64; ATT_LAS float* li_l = ws; ATT_LAS float* al_l = ws + 32;
  float m_reg = -1e30f, l_reg = 0; f32x16 o[4] = {}; bf16x8 qr[8];
  ATT_LAS char* QR_lds = lds + OFF_QR + wid * 4096;
  const bf16_t* Qw = Qb + (long)(wid * QBLK + r32) * LDQ + hi * 8;
#pragma unroll
  for (int d0 = 0; d0 < 8; ++d0) qr[d0] = *reinterpret_cast<const bf16x8*>(Qw + d0 * 16);
  {
  bf16x8 q8 = *reinterpret_cast<const bf16x8*>(Qw + 8 * 16), q9 = *reinterpret_cast<const bf16x8*>(Qw + 9 * 16), q10 = *reinterpret_cast<const bf16x8*>(Qw + 10 * 16), q11 = *reinterpret_cast<const bf16x8*>(Qw + 11 * 16);
  if (rope) {
    const int pos = pos0 + wid * QBLK + r32; const f32x2* tr = ropeR + (pos >> 6) * 16 + hi * 8; const f32x2* tc = ropeC + (pos & 63) * 16 + hi * 8;
    bf16x8 n8, n9, n10, n11;
#pragma unroll
    for (int e = 0; e < 8; ++e) {
      const f32x2 cr = tr[e], cc = tc[e];
      const float a1 = bf2f((unsigned short)q8[e]), a2 = bf2f((unsigned short)q9[e]), b1 = bf2f((unsigned short)q10[e]), b2 = bf2f((unsigned short)q11[e]);
      const unsigned w0 = cvtpk(a1 * cr.x - a2 * cr.y, a2 * cr.x + a1 * cr.y), w1 = cvtpk(b1 * cc.x - b2 * cc.y, b2 * cc.x + b1 * cc.y);
      n8[e] = (short)(w0 & 0xffffu); n9[e] = (short)(w0 >> 16); n10[e] = (short)(w1 & 0xffffu); n11[e] = (short)(w1 >> 16);
    }
    q8 = n8; q9 = n9; q10 = n10; q11 = n11;
  }
  *(ATT_LAS bf16x8*)(QR_lds + KRSWZ(r32, (0 * 16 + hi * 8) * 2)) = q8; *(ATT_LAS bf16x8*)(QR_lds + KRSWZ(r32, (1 * 16 + hi * 8) * 2)) = q9;
  *(ATT_LAS bf16x8*)(QR_lds + KRSWZ(r32, (2 * 16 + hi * 8) * 2)) = q10; *(ATT_LAS bf16x8*)(QR_lds + KRSWZ(r32, (3 * 16 + hi * 8) * 2)) = q11;
  }
  const int sr = tid >> 4, sc = (tid & 15) * 8, vst0 = v_st(sr, sc), vst1 = v_st(32 + sr, sc);
  const int krs = tid >> 3, krc = (tid & 7) * 8, krst = KRSWZ(krs, krc * 2);
  const int vb0 = (int)(uintptr_t)V_lds + v_rd_base(lane);
  struct { bf16x8 vs0, vs1, ks0, ks1, kr; } sr_[SDEPTH];
#define TROW(j) ((j) < nx ? (long)xrow0 + (long)(j) * KVBLK : (long)crow0 + (long)((j) - nx) * KVBLK)
#define SLOAD(i, j) do { const long _k0 = TROW(j); \
    sr_[i].vs0 = *reinterpret_cast<const bf16x8*>(&Vh[(_k0 + sr) * LDK + sc]); sr_[i].vs1 = *reinterpret_cast<const bf16x8*>(&Vh[(_k0 + 32 + sr) * LDK + sc]); \
    sr_[i].ks0 = *reinterpret_cast<const bf16x8*>(&Kh[(_k0 + sr) * LDK + sc]); sr_[i].ks1 = *reinterpret_cast<const bf16x8*>(&Kh[(_k0 + 32 + sr) * LDK + sc]); \
    sr_[i].kr = *reinterpret_cast<const bf16x8*>(&KRb[(_k0 + krs) * LDKR + krc]); } while (0)
#define SWRITE(b, i) do { *(ATT_LAS bf16x8*)(V_lds + (b) * SHM_V + vst0) = sr_[i].vs0;          \
    *(ATT_LAS bf16x8*)(V_lds + (b) * SHM_V + vst1) = sr_[i].vs1; const int kc = sc * 2;               \
    *(ATT_LAS bf16x8*)(K_lds + (b) * SHM_K + KSWZ(sr, kc)) = sr_[i].ks0;                       \
    *(ATT_LAS bf16x8*)(K_lds + (b) * SHM_K + KSWZ(32 + sr, kc)) = sr_[i].ks1;                  \
    *(ATT_LAS bf16x8*)(KR_lds + (b) * SHM_KR + krst) = sr_[i].kr; } while (0)
#define SWAIT() do { if constexpr (SDEPTH == 2) asm volatile("s_waitcnt vmcnt(5)" ::: "memory"); else asm volatile("s_waitcnt vmcnt(0)" ::: "memory"); } while (0)
#define RESC(a) do { if (__any((a) < 1.f)) { if (hi == 0) al_l[r32] = (a); asm volatile("s_waitcnt lgkmcnt(0)" ::: "memory"); \
    _Pragma("unroll") for (int d = 0; d < 4; ++d) _Pragma("unroll") for (int r = 0; r < 16; ++r) o[d][r] *= al_l[crow(r, hi)]; } } while (0)
  f32x16 pA0, pA1, pB0, pB1; float mnA, mnB, alA, alB; bf16x8 pa0, pa1, pa2, pa3;
  constexpr int SE = 0, SO = SDEPTH - 1;
  SLOAD(SE, 0); asm volatile("s_waitcnt vmcnt(0)" ::: "memory"); SWRITE(0, SE); __syncthreads();
  qkt(pA0, pA1, K_lds, KR_lds, QR_lds, qr, r32, hi); partialSM(pA0, pA1, m_reg, mnA, alA);
  SLOAD(SO, 1); if constexpr (SDEPTH == 2) { if (2 < NT) SLOAD(SE, 2); }
  SWAIT(); SWRITE(1, SO); __syncthreads();
  for (int j = 1; j + 1 < NT; j += 2) {
    SBAR(); qkt(pB0, pB1, K_lds + SHM_K, KR_lds + SHM_KR, QR_lds, qr, r32, hi);
    finishSM(pA0, pA1, alA, l_reg, pa0, pa1, pa2, pa3); SBAR();
    SLOAD(SO, j + SDEPTH); SBAR();
    pv_d0(o, vb0, pa0, pa1, pa2, pa3); partialSM(pB0, pB1, m_reg, mnB, alB);
    __syncthreads(); SWAIT(); SWRITE(0, SE);
    RESC(alB); __syncthreads();
    SBAR(); qkt(pA0, pA1, K_lds, KR_lds, QR_lds, qr, r32, hi);
    finishSM(pB0, pB1, alB, l_reg, pa0, pa1, pa2, pa3); SBAR();
    if (SDEPTH == 1 || j + 3 < NT) SLOAD(SE, j + 1 + SDEPTH); SBAR();
    pv_d0(o, vb0 + SHM_V, pa0, pa1, pa2, pa3); partialSM(pA0, pA1, m_reg, mnA, alA);
    __syncthreads(); SWAIT(); SWRITE(1, SO);
    RESC(alA); __syncthreads();
  }
  SBAR(); qkt(pB0, pB1, K_lds + SHM_K, KR_lds + SHM_KR, QR_lds, qr, r32, hi);
  finishSM(pA0, pA1, alA, l_reg, pa0, pa1, pa2, pa3); SBAR();
  pv_d0(o, vb0, pa0, pa1, pa2, pa3); partialSM(pB0, pB1, m_reg, mnB, alB);
  __syncthreads(); RESC(alB);
  finishSM(pB0, pB1, alB, l_reg, pa0, pa1, pa2, pa3); SBAR();
  pv_d0(o, vb0 + SHM_V, pa0, pa1, pa2, pa3);
  {
  int te = tid_from_wave(wave_sgpr);
  const int widE = te >> 6, r32E = te & 31, hiE = (te >> 5) & 1;
  ATT_LAS float* liE = (ATT_LAS float*)(lds + OFF_WS) + widE * 64;
  if (hiE == 0) liE[r32E] = l_reg; asm volatile("s_waitcnt lgkmcnt(0)" ::: "memory");
  float rli[16];
#pragma unroll
  for (int r = 0; r < 16; ++r) rli[r] = __builtin_amdgcn_rcpf(liE[crow(r, hiE)]);
  bf16_t* Ow = Ob + (long)(widE * QBLK) * LDO + r32E;
#pragma unroll
  for (int r = 0; r < 16; ++r) { const int orow = crow(r, hiE);
#pragma unroll
    for (int d0 = 0; d0 < 4; ++d0) { const unsigned w = cvtpk(o[d0][r] * rli[r], 0.f); Ow[(long)orow * LDO + d0 * 32] = (bf16_t)(w & 0xffffu); } }
  }
  __syncthreads();
#undef TROW
#undef SLOAD
#undef SWRITE
#undef SWAIT
#undef RESC
}
#undef KSWZ
#undef KRSWZ
#undef SBAR
}

constexpr int NWAVES = 8;
constexpr int DM = 2048, BATCH = 2, SEQ = 16384, CTXL = 256, DEPTH = 4, DFF = 5632, NH = 16;
constexpr int M_X = BATCH * SEQ;
constexpr int M_C = BATCH * CTXL;
constexpr int M_T = M_X + M_C;
constexpr int QLR = 512, KVLR = 512, ROPE_D = 64, NDQKV = 1280;
constexpr float LN_EPS = 1e-5f, RMS_EPS = 1e-6f;
constexpr float DN_ALPHA = 1.6817928305074290f;

constexpr size_t MiB = 1u << 20;
constexpr size_t WS_CTL = 0, CTL_ZERO_BYTES = 1 * MiB;
constexpr size_t WS_MOD = 1 * MiB;
constexpr size_t WS_ROPER = WS_MOD + 640 * 1024, WS_ROPEC = WS_MOD + 680 * 1024;
constexpr size_t WS_W = 2 * MiB;
constexpr size_t W_CONV_STRIDE = 32 * MiB, W_WIN = 0, W_WOUT = 24 * MiB;
constexpr size_t W_MLA_BASE = 64 * MiB, W_MLA_STRIDE = 20 * MiB, W_DQKV = 0, W_UQ = 5 * MiB, W_UKV = 8 * MiB, W_WO = 12 * MiB;
constexpr size_t W_FFN_BASE = 104 * MiB, W_FFN_STRIDE = 66 * MiB, W_UP = 0, W_DOWN = 44 * MiB;
constexpr size_t WS_X32C = 370 * MiB;
constexpr size_t WS_BIG = 374 * MiB;
constexpr size_t BIG_BB = 585 * MiB, BIG_HALOC = 132 * MiB, BIG_GATED = 0;
constexpr size_t BIG_KRRAW = 130 * MiB, BIG_SSQ = 140 * MiB;
constexpr size_t BIG_QKVC = 0, BIG_CQ = 163 * MiB, BIG_CKV = 196 * MiB, BIG_KR = 229 * MiB, BIG_Q = 234 * MiB, BIG_K = 429 * MiB, BIG_V = 559 * MiB, BIG_O = 0;
constexpr size_t BIG_CPART = 600 * MiB;
constexpr size_t BIG_HALO = 132 * MiB, BIG_ACT = 234 * MiB;
constexpr size_t WS_ACT = 1089 * MiB;
constexpr size_t WS_STATS = 1220 * MiB;
constexpr size_t WS_T16 = 1222 * MiB;
constexpr size_t WS_END = 1447 * MiB;
static_assert(WS_BIG + 715 * MiB <= WS_ACT && WS_ACT + (size_t)M_T * DM * 2 <= WS_END && BIG_HALO + (size_t)(M_T / 64) * 4 * 11264 * 4 <= BIG_ACT && BIG_ACT + (size_t)M_T * DFF * 2 <= 715 * MiB, "d_ws map");
static_assert(BIG_BB + (size_t)M_T * DM * 2 <= 715 * MiB && BIG_GATED + (size_t)M_T * DM * 2 <= BIG_HALOC && BIG_HALO >= BIG_O + (size_t)M_T * DM * 2, "mixer overlay");
static_assert(BIG_CPART >= BIG_ACT + (size_t)M_T * DFF * 2 && BIG_CPART >= BIG_GATED + (size_t)M_T * DM * 2 && BIG_CPART + (size_t)11 * M_C * DM * 4 <= 715 * MiB, "context planes");
static_assert(BIG_V + (size_t)M_T * 2048 * 2 <= 715 * MiB && BIG_KR + (size_t)M_T * 64 * 2 <= BIG_Q && BIG_QKVC + (size_t)M_T * NDQKV * 4 <= BIG_CQ, "MLA overlay");
constexpr int CW_RLF = 32768, RLF_STRIDE = 1024;
constexpr int CW_TMO = 0, CW_CODE = 1, CW_BAR = 4096, CW_CVF = 20480;

constexpr int RING_OFF = 0, RING_BYTES = 131072;
constexpr int LDSCTL_OFF = RING_BYTES, MISC_OFF = LDSCTL_OFF + 320;
constexpr int LDS_BYTES = 147456;
static_assert(att::ATT_LDS_BYTES <= RING_BYTES, "attention LDS");

#define GAS __attribute__((address_space(1)))
#define LAS __attribute__((address_space(3)))
typedef unsigned short bf16;
typedef unsigned v4u __attribute__((ext_vector_type(4)));
typedef unsigned v2u __attribute__((ext_vector_type(2)));
typedef float f32x4 __attribute__((ext_vector_type(4)));
typedef float f32x2 __attribute__((ext_vector_type(2)));
typedef short bf16x8 __attribute__((ext_vector_type(8)));
typedef _Float16 f16x8 __attribute__((ext_vector_type(8)));
typedef GAS unsigned gu32;
#define RLX_AGENT __ATOMIC_RELAXED, __HIP_MEMORY_SCOPE_AGENT
#define LDS_WAIT() asm volatile("s_waitcnt lgkmcnt(0)" ::: "memory")
#define VM_WAIT() asm volatile("s_waitcnt vmcnt(0)" ::: "memory")
__device__ __forceinline__ unsigned f2bf(float f) { unsigned u = __builtin_bit_cast(unsigned, f); return (u + 0x7fffu + ((u >> 16) & 1u)) >> 16; }
__device__ __forceinline__ unsigned pk2(float lo, float hi) { return f2bf(lo) | (f2bf(hi) << 16); }
__device__ __forceinline__ float bflo(unsigned w) { return __uint_as_float(w << 16); }
__device__ __forceinline__ float bfhi(unsigned w) { return __uint_as_float(w & 0xffff0000u); }
__device__ __forceinline__ float lane_xor(float v, int lane, int o) { return __builtin_bit_cast(float, __builtin_amdgcn_ds_bpermute((lane ^ o) << 2, __builtin_bit_cast(int, v))); }
__device__ __forceinline__ float wave_sum(float v, int lane) {
#pragma unroll
    for (int o = 1; o < 64; o <<= 1) v += lane_xor(v, lane, o);
    return v;
}
__device__ __forceinline__ float silu_f(float x) { return x / (1.0f + __expf(-x)); }
#define XB_TMO      128
#define XB_XCNT(j)  (256  + 64 * (j))
#define XB_XSUB(j)  (1280 + 64 * (j))
#define XB_XGEN(j)  (2304 + 64 * (j))
#define XB_TOP      3328
#define XB_TOPGEN   3392
#define XCD_BAR_WORDS 3456
#define XB_SPIN_CAP (1u << 18)

__device__ __forceinline__ unsigned xb_ld(unsigned* p)              { return __hip_atomic_load(p, __ATOMIC_RELAXED, __HIP_MEMORY_SCOPE_AGENT); }
__device__ __forceinline__ unsigned xb_add(unsigned* p, unsigned v) { return __hip_atomic_fetch_add(p, v, __ATOMIC_RELAXED, __HIP_MEMORY_SCOPE_AGENT); }
__device__ __forceinline__ unsigned xb_xcc_id() { return (unsigned)__builtin_amdgcn_s_getreg((3 << 11) | 20) & 0xFu; }
#define XB_SPIN(cond, bar) do { unsigned _sp = 0; while (cond) { __builtin_amdgcn_s_sleep(1); \
    if ((++_sp & 255u) == 0u) { if (xb_ld(&(bar)[XB_TMO])) break; if (_sp > XB_SPIN_CAP) { atomicAdd(&(bar)[XB_TMO], 1u); break; } } } } while (0)

struct XcdBarrier {
    unsigned* bar; unsigned x;
    volatile LAS unsigned* st;
};

__device__ __forceinline__ XcdBarrier xcd_barrier_post(unsigned* bar, volatile LAS unsigned* st, bool leader) {
    XcdBarrier b; b.bar = bar; b.x = xb_xcc_id(); b.st = st;
    if (leader) (void)xb_add(&bar[XB_XCNT(b.x)], 1u);
    return b;
}
__device__ __forceinline__ void xcd_barrier_complete(unsigned* bar, unsigned x, unsigned& nloc, unsigned& nx) {
    const unsigned G = gridDim.x * gridDim.y * gridDim.z;
    unsigned sum, cnt, mine, sp = 0u;
    for (;;) {
        sum = 0u; cnt = 0u; mine = 0u;
#pragma unroll
        for (unsigned j = 0; j < 16; ++j) { const unsigned c = xb_ld(&bar[XB_XCNT(j)]); sum += c; cnt += (c > 0u) ? 1u : 0u; mine = (j == x) ? c : mine; }
        if (sum == G) break;
        __builtin_amdgcn_s_sleep(1);
        if ((++sp & 255u) == 0u) { if (xb_ld(&bar[XB_TMO])) break; if (sp > XB_SPIN_CAP) { atomicAdd(&bar[XB_TMO], 1u); break; } }
    }
    nloc = mine > 0u ? mine : 1u; nx = cnt > 0u ? cnt : 1u;
}

__device__ __forceinline__ void xcd_barrier(const XcdBarrier& b, bool leader) {
    asm volatile("s_waitcnt vmcnt(0)" ::: "memory");
    __syncthreads();
    if (leader) {
        unsigned* bar = b.bar;
        __builtin_amdgcn_s_waitcnt(0);
        unsigned nloc = b.st[0], nx = b.st[1];
        if (nloc == 0u) { xcd_barrier_complete(bar, b.x, nloc, nx); b.st[0] = nloc; b.st[1] = nx; }
        const unsigned old = xb_add(&bar[XB_XSUB(b.x)], 1u);
        const unsigned gen = old / nloc;
        if (old + 1u == (gen + 1u) * nloc) {
            __builtin_amdgcn_fence(__ATOMIC_RELEASE, "agent");
            asm volatile("s_waitcnt vmcnt(0)" ::: "memory");
            const unsigned og = xb_add(&bar[XB_TOP], 1u);
            const unsigned tg = og / nx;
            if (og + 1u == (tg + 1u) * nx) xb_add(&bar[XB_TOPGEN], 1u);
            else XB_SPIN(xb_ld(&bar[XB_TOPGEN]) == tg, bar);
            __builtin_amdgcn_fence(__ATOMIC_ACQUIRE, "agent");
            xb_add(&bar[XB_XGEN(b.x)], 1u);
            asm volatile("s_waitcnt vmcnt(0)" ::: "memory");
        } else {
            XB_SPIN(xb_ld(&bar[XB_XGEN(b.x)]) == gen, bar);
            __builtin_amdgcn_fence(__ATOMIC_ACQUIRE, "agent");
            asm volatile("s_waitcnt vmcnt(0)" ::: "memory");
        }
    }
    __syncthreads();
}

constexpr int PTAB_OFF = MISC_OFF + 128;
struct Frame {
    LAS unsigned char* lds;
    int tid, lane, wave, wave0;
    int vcu, G, bx;
    float* out; unsigned char* ws;
    __device__ __forceinline__ const float* ptr(int i) const {
        const volatile LAS unsigned* t = (const volatile LAS unsigned*)(lds + PTAB_OFF) + 2 * i;
        const unsigned lo = __builtin_amdgcn_readfirstlane(t[0]), hi = __builtin_amdgcn_readfirstlane(t[1]);
        return (const float*)((const GAS float*)(((unsigned long long)hi << 32) | lo)); }
    __device__ __forceinline__ const float* in(int i) const { return ptr(i); }
};
__device__ __forceinline__ void make_frame(Frame& F, LAS unsigned char* lds, int wave_sgpr) {
    const int t = tid_from_wave(wave_sgpr);
    int g = gridDim.x, bx = blockIdx.x; asm volatile("" : "+s"(g), "+s"(bx));
    F.lds = lds; F.tid = t; F.lane = t & 63; F.wave = __builtin_amdgcn_readfirstlane(t >> 6); F.wave0 = wave_sgpr;
    F.G = g; F.bx = bx; F.vcu = (g % 8 == 0) ? (bx % 8) * (g / 8) + bx / 8 : bx;
    F.out = (float*)F.ptr(25); F.ws = (unsigned char*)F.ptr(26);
}
__device__ __forceinline__ bf16* wsb(const Frame& F, size_t off) { return (bf16*)(F.ws + off); }
__device__ __forceinline__ float* wsf(const Frame& F, size_t off) { return (float*)(F.ws + off); }

__device__ __forceinline__ void p0_transpose_item(const float* W, int K, int N, bf16* WT, int row_off, LAS float* scr, int item, int lane, const float* kscale = nullptr) {
    const int nblk = N / 32, kb = item / nblk, nb = item % nblk, k0 = 64 * kb, n0 = 32 * nb;
    float tv[32];
#pragma unroll
    for (int i = 0; i < 32; ++i) { const int kk = 2 * i + (lane >> 5); tv[i] = W[(size_t)(k0 + kk) * N + n0 + (lane & 31)]; }
#pragma unroll
    for (int i = 0; i < 32; ++i) { const int kk = 2 * i + (lane >> 5); scr[kk * 33 + (lane & 31)] = kscale ? tv[i] * kscale[k0 + kk] : tv[i]; }
    LDS_WAIT(); asm volatile("" ::: "memory");
    const int c = lane & 7;
#pragma unroll
    for (int j = 0; j < 4; ++j) { const int n = (lane >> 3) + 8 * j; const LAS float* s = scr + (8 * c) * 33 + n;
        v4u o; o.x = pk2(s[0 * 33], s[1 * 33]); o.y = pk2(s[2 * 33], s[3 * 33]); o.z = pk2(s[4 * 33], s[5 * 33]); o.w = pk2(s[6 * 33], s[7 * 33]);
        *(GAS v4u*)(WT + (size_t)(row_off + n0 + n) * K + k0 + 8 * c) = o; }
    LDS_WAIT(); asm volatile("" ::: "memory");
}

__device__ __forceinline__ void p0_prologue(Frame& F) {
    if (F.vcu < 192) {
        LAS float* sl = (LAS float*)(F.lds);
        LAS float* part = (LAS float*)(F.lds + 32768);
        for (int idx = F.tid; idx < 3 * DM; idx += NWAVES * 64) { const int rt = idx / DM, k = idx % DM; const float v = rt < 2 ? F.in(1)[rt * DM + k] : F.in(3)[k]; sl[idx] = silu_f(v); }
        __syncthreads();
        const int layer = F.vcu / 48, cg = F.vcu % 48;
        const float* Wp = F.in(4) + (size_t)layer * DM * 12288 + cg * 256 + F.lane * 4;
        f32x4 a0 = {0.f, 0.f, 0.f, 0.f}, a1 = a0, a2 = a0;
        const int kb = F.wave * 256;
#pragma unroll 8
        for (int k = kb; k < kb + 256; ++k) { const f32x4 w = *(const GAS f32x4*)(Wp + (size_t)k * 12288); a0 += w * sl[k]; a1 += w * sl[DM + k]; a2 += w * sl[2 * DM + k]; }
        *(LAS f32x4*)(part + (F.wave * 3 + 0) * 256 + F.lane * 4) = a0; *(LAS f32x4*)(part + (F.wave * 3 + 1) * 256 + F.lane * 4) = a1; *(LAS f32x4*)(part + (F.wave * 3 + 2) * 256 + F.lane * 4) = a2;
        __syncthreads();
        for (int idx = F.tid; idx < 768; idx += NWAVES * 64) { const int rt = idx >> 8, cl = idx & 255; float s = 0.f;
#pragma unroll
            for (int w = 0; w < 8; ++w) s += part[(w * 3 + rt) * 256 + cl];
            const int n = cg * 256 + cl, chunk = n / DM; float val = s + F.in(5)[layer * 12288 + n]; if (chunk == 1 || chunk == 4) val += 1.0f;
            wsf(F, WS_MOD)[(layer * 3 + rt) * 12288 + n] = val; }
        __syncthreads();
    } else if (F.vcu == 192) {
        for (int idx = F.tid; idx < 256 * 16 + 64 * 16; idx += NWAVES * 64) {
            const int e = idx < 4096 ? idx : idx - 4096, pos = e >> 4, f = e & 15;
            const float inv = 1.0f / powf(10000.0f, (float)f / 16.0f), ang = (float)pos * inv; float sn, cs; sincosf(ang, &sn, &cs);
            f32x2* t = (f32x2*)(F.ws + (idx < 4096 ? WS_ROPER : WS_ROPEC)); t[e] = (f32x2){cs, sn}; }
    }
    LAS float* scr = (LAS float*)(F.lds + RING_OFF + F.wave * 16384);
    const int gw = F.vcu * NWAVES + F.wave, NGW = F.G * NWAVES;
    constexpr int C0 = 32 * 192, C1 = 32 * 64, C2 = 32 * 16, C3 = 32 * 18, C4 = 8 * 96, C5 = 8 * 64, C6 = 8 * 64, C7 = 32 * 64, C8 = 32 * 352, C9 = 88 * 64, C10 = 192;
    constexpr int NITEMS = 2 * (C0 + C1 + C2 + C3 + C4 + C5 + C6 + C7 + C10) + 4 * (C8 + C9);
    for (int it = gw; it < NITEMS; it += NGW) {
        int r = it;
        if (r < 4 * C8) { const int l = r / C8, item = r % C8, n0 = 32 * (item % 352);
            const int m0 = n0 < DFF ? n0 : n0 - DFF, dst = (m0 >> 7) * 256 + (n0 < DFF ? 0 : 128) + (m0 & 127);
            p0_transpose_item(F.in(21) + (size_t)l * DM * 11264, DM, 11264, wsb(F, WS_W + W_FFN_BASE + l * W_FFN_STRIDE + W_UP), dst - n0, scr, item, F.lane); continue; } r -= 4 * C8;
        if (r < 4 * C9) { const int l = r / C9; p0_transpose_item(F.in(24) + (size_t)l * DFF * DM, DFF, DM, wsb(F, WS_W + W_FFN_BASE + l * W_FFN_STRIDE + W_DOWN), 0, scr, r % C9, F.lane); continue; } r -= 4 * C9;
        if (r < 2 * C0) { const int l = r / C0, item = r % C0, n0 = 32 * (item % 192);
            const int m0 = n0 < 4096 ? n0 - 2048 : n0 - 4096, dst = n0 < 2048 ? n0 : 2048 + (m0 >> 7) * 256 + (n0 < 4096 ? 0 : 128) + (m0 & 127);
            p0_transpose_item(F.in(10) + (size_t)l * DM * 6144, DM, 6144, wsb(F, WS_W + l * W_CONV_STRIDE + W_WIN), dst - n0, scr, item, F.lane); continue; } r -= 2 * C0;
        if (r < 2 * C1) { const int l = r / C1; p0_transpose_item(F.in(12) + (size_t)l * DM * DM, DM, DM, wsb(F, WS_W + l * W_CONV_STRIDE + W_WOUT), 0, scr, r % C1, F.lane); continue; } r -= 2 * C1;
        if (r < 2 * C2) { const int l = r / C2; p0_transpose_item(F.in(13) + (size_t)l * DM * QLR, DM, QLR, wsb(F, WS_W + W_MLA_BASE + l * W_MLA_STRIDE + W_DQKV), 0, scr, r % C2, F.lane); continue; } r -= 2 * C2;
        if (r < 2 * C3) { const int l = r / C3; p0_transpose_item(F.in(16) + (size_t)l * DM * 576, DM, 576, wsb(F, WS_W + W_MLA_BASE + l * W_MLA_STRIDE + W_DQKV), 512, scr, r % C3, F.lane); continue; } r -= 2 * C3;
        if (r < 2 * C4) { const int l = r / C4; p0_transpose_item(F.in(15) + (size_t)l * QLR * 3072, QLR, 3072, wsb(F, WS_W + W_MLA_BASE + l * W_MLA_STRIDE + W_UQ), 0, scr, r % C4, F.lane, F.in(14) + l * QLR); continue; } r -= 2 * C4;
        if (r < 2 * C5) { const int l = r / C5; p0_transpose_item(F.in(18) + (size_t)l * KVLR * 2048, KVLR, 2048, wsb(F, WS_W + W_MLA_BASE + l * W_MLA_STRIDE + W_UKV), 0, scr, r % C5, F.lane, F.in(17) + l * KVLR); continue; } r -= 2 * C5;
        if (r < 2 * C6) { const int l = r / C6; p0_transpose_item(F.in(19) + (size_t)l * KVLR * 2048, KVLR, 2048, wsb(F, WS_W + W_MLA_BASE + l * W_MLA_STRIDE + W_UKV), 2048, scr, r % C6, F.lane, F.in(17) + l * KVLR); continue; } r -= 2 * C6;
        if (r < 2 * C7) { const int l = r / C7; p0_transpose_item(F.in(20) + (size_t)l * DM * DM, DM, DM, wsb(F, WS_W + W_MLA_BASE + l * W_MLA_STRIDE + W_WO), 0, scr, r % C7, F.lane); continue; } r -= 2 * C7;
        { const int l = r / C10, row = 1088 + r % C10; bf16* d = wsb(F, WS_W + W_MLA_BASE + l * W_MLA_STRIDE + W_DQKV) + (size_t)row * DM;
#pragma unroll
          for (int j = 0; j < 4; ++j) *(GAS v4u*)(d + j * 512 + F.lane * 8) = (v4u){0u, 0u, 0u, 0u}; }
    }
}

__device__ __forceinline__ void p1_hx0(Frame& F) {
    const int gw = F.vcu * NWAVES + F.wave, NGW = F.G * NWAVES;
    bf16* HX = wsb(F, WS_ACT); const float* xin = F.in(0); const float* cin = F.in(2);
    constexpr int RPW = 16;
    for (int blk = gw; blk < M_T / RPW; blk += NGW) {
        const int r0 = blk * RPW, rt = r0 < SEQ ? 0 : (r0 < M_X ? 1 : 2);
        const float* mod = wsf(F, WS_MOD) + (size_t)rt * 12288;
        const GAS f32x4* shp = (const GAS f32x4*)mod + F.lane; const GAS f32x4* scp = (const GAS f32x4*)(mod + DM) + F.lane;
        f32x4 A[8], B[8];
#pragma unroll
        for (int j = 0; j < 8; ++j) { A[j] = scp[64 * j]; B[j] = shp[64 * j]; }
        const float* src = r0 < M_X ? xin + (size_t)r0 * DM : cin + (size_t)(r0 - M_X) * DM;
        const GAS f32x4* xr = (const GAS f32x4*)src + F.lane;
        GAS f32x4* xc = (GAS f32x4*)(wsf(F, WS_X32C) + (size_t)(r0 < M_X ? 0 : r0 - M_X) * DM) + F.lane;
        f32x4 va[8], vb[8];
#pragma unroll
        for (int j = 0; j < 8; ++j) va[j] = xr[64 * j];
#define P1_ROW(CUR, NXT, R) do { \
            if ((R) + 1 < RPW) { _Pragma("unroll") for (int j = 0; j < 8; ++j) NXT[j] = xr[(size_t)((R) + 1) * (DM / 4) + 64 * j]; } \
            GAS v2u* o8_ = (GAS v2u*)(HX + (size_t)(r0 + (R)) * DM) + F.lane; \
            _Pragma("unroll") for (int j = 0; j < 8; ++j) { const f32x4 h_ = CUR[j] * A[j] + B[j]; o8_[64 * j] = (v2u){pk2(h_.x, h_.y), pk2(h_.z, h_.w)}; \
                if (r0 >= M_X) xc[(size_t)(R) * (DM / 4) + 64 * j] = CUR[j] * DN_ALPHA; }     \
        } while (0)
        for (int r = 0; r < RPW; r += 2) { P1_ROW(va, vb, r); P1_ROW(vb, va, r + 1); }
#undef P1_ROW
    }
}

__device__ __forceinline__ void ln_phase(Frame& F, int layer, int second, int nrows, int nplanes) {
    const int gw = F.vcu * NWAVES + F.wave, NGW = F.G * NWAVES;
    const float* gam = F.in(second ? 8 : 6) + layer * DM; const float* bet = F.in(second ? 9 : 7) + layer * DM;
    const bool final_out = (second && layer == DEPTH - 1);
    const int modl = second ? (layer + 1 < DEPTH ? layer + 1 : layer) : layer, chunk = second ? 0 : 3;
    bf16* HX = wsb(F, WS_ACT); float* stats = wsf(F, WS_STATS) + (size_t)second * 2 * M_T;
    const GAS f32x4* gp = (const GAS f32x4*)gam + F.lane; const GAS f32x4* bp = (const GAS f32x4*)bet + F.lane;
    constexpr int RPW = 16;
    const _Float16* T16 = (const _Float16*)(F.ws + WS_T16);
    for (int blk = gw; blk < M_X / RPW; blk += NGW) {
        const int r0 = blk * RPW, rt = r0 < SEQ ? 0 : 1;
        f32x4 A[8], B[8];
        { const float* mod = wsf(F, WS_MOD) + (size_t)(modl * 3 + rt) * 12288 + chunk * DM;
          const GAS f32x4* g4 = (const GAS f32x4*)gam + 2 * F.lane; const GAS f32x4* b4 = (const GAS f32x4*)bet + 2 * F.lane;
          const GAS f32x4* shp = (const GAS f32x4*)mod + 2 * F.lane; const GAS f32x4* scp = (const GAS f32x4*)(mod + DM) + 2 * F.lane;
#pragma unroll
          for (int j = 0; j < 4; ++j)
#pragma unroll
              for (int h = 0; h < 2; ++h) { const int q = 128 * j + h; const f32x4 g = g4[q], b = b4[q]; if (final_out) { A[2 * j + h] = g; B[2 * j + h] = b; } else { const f32x4 sc = scp[q], sh = shp[q]; A[2 * j + h] = g * sc; B[2 * j + h] = b * sc + sh; } } }
        const GAS f16x8* xr = (const GAS f16x8*)(T16 + (size_t)r0 * DM) + F.lane;
        f16x8 ta[4], tb[4], tc[4];
#pragma unroll
        for (int j = 0; j < 4; ++j) { ta[j] = xr[64 * j]; tb[j] = xr[(size_t)(DM / 8) + 64 * j]; }
#define LN_ROW(CUR, NXT, R) do { \
            if ((R) + 2 < RPW) { _Pragma("unroll") for (int j = 0; j < 4; ++j) NXT[j] = xr[(size_t)((R) + 2) * (DM / 8) + 64 * j]; } \
            f32x4 v_[8]; float s_ = 0.f; \
            _Pragma("unroll") for (int j = 0; j < 4; ++j) { v_[2 * j] = (f32x4){(float)CUR[j][0], (float)CUR[j][1], (float)CUR[j][2], (float)CUR[j][3]}; v_[2 * j + 1] = (f32x4){(float)CUR[j][4], (float)CUR[j][5], (float)CUR[j][6], (float)CUR[j][7]}; } \
            _Pragma("unroll") for (int j = 0; j < 8; ++j) s_ += (v_[j].x + v_[j].y) + (v_[j].z + v_[j].w); \
            const float mean_ = wave_sum(s_, F.lane) * (1.f / DM); float q_ = 0.f; \
            _Pragma("unroll") for (int j = 0; j < 8; ++j) { v_[j] = v_[j] - mean_; q_ += (v_[j].x * v_[j].x + v_[j].y * v_[j].y) + (v_[j].z * v_[j].z + v_[j].w * v_[j].w); } \
            const float rstd_ = 1.f / sqrtf(wave_sum(q_, F.lane) * (1.f / DM) + LN_EPS); \
            if (final_out) { GAS f32x4* o4_ = (GAS f32x4*)(F.out + (size_t)(r0 + (R)) * DM) + 2 * F.lane; \
                   _Pragma("unroll") for (int j = 0; j < 4; ++j) { o4_[128 * j] = v_[2 * j] * rstd_ * A[2 * j] + B[2 * j]; o4_[128 * j + 1] = v_[2 * j + 1] * rstd_ * A[2 * j + 1] + B[2 * j + 1]; } } \
            else { if (F.lane == 0) *(GAS f32x2*)(stats + 2 * (size_t)(r0 + (R))) = (f32x2){mean_, rstd_}; \
                   GAS v4u* o8_ = (GAS v4u*)(HX + (size_t)(r0 + (R)) * DM) + F.lane; \
                   _Pragma("unroll") for (int j = 0; j < 4; ++j) { const f32x4 h0_ = v_[2 * j] * rstd_ * A[2 * j] + B[2 * j], h1_ = v_[2 * j + 1] * rstd_ * A[2 * j + 1] + B[2 * j + 1]; \
                       o8_[64 * j] = (v4u){pk2(h0_.x, h0_.y), pk2(h0_.z, h0_.w), pk2(h1_.x, h1_.y), pk2(h1_.z, h1_.w)}; } } \
        } while (0)
        for (int r = 0; r < RPW - 1; r += 3) { LN_ROW(ta, tc, r); LN_ROW(tb, ta, r + 1); LN_ROW(tc, tb, r + 2); }
        LN_ROW(ta, tc, RPW - 1);
#undef LN_ROW
    }
    for (int row = M_X + F.wave * F.G + F.vcu; row < nrows; row += NGW) {
        float* xrow = wsf(F, WS_X32C) + (size_t)(row - M_X) * DM;
        GAS f32x4* xr = (GAS f32x4*)xrow + F.lane;
        f32x4 v[8]; float s = 0.f;
#pragma unroll
        for (int j = 0; j < 8; ++j) v[j] = xr[64 * j];
        { const GAS f32x4* pp = (const GAS f32x4*)(wsf(F, WS_BIG + BIG_CPART) + (size_t)(row - M_X) * DM) + F.lane;
          int p = 0;
          for (; p + 4 <= nplanes; p += 4) {
              f32x4 t[4][8];
#pragma unroll
              for (int q = 0; q < 4; ++q)
#pragma unroll
                  for (int j = 0; j < 8; ++j) t[q][j] = pp[(size_t)(p + q) * (M_C * DM / 4) + 64 * j];
#pragma unroll
              for (int j = 0; j < 8; ++j) v[j] += (t[0][j] + t[1][j]) + (t[2][j] + t[3][j]); }
          for (; p < nplanes; ++p) {
#pragma unroll
              for (int j = 0; j < 8; ++j) v[j] += pp[(size_t)p * (M_C * DM / 4) + 64 * j]; } }
#pragma unroll
        for (int j = 0; j < 8; ++j) s += (v[j].x + v[j].y) + (v[j].z + v[j].w);
        const float mean = wave_sum(s, F.lane) * (1.f / DM); float s2 = 0.f;
#pragma unroll
        for (int j = 0; j < 8; ++j) { v[j] = v[j] - mean; s2 += (v[j].x * v[j].x + v[j].y * v[j].y) + (v[j].z * v[j].z + v[j].w * v[j].w); }
        const float rstd = 1.f / sqrtf(wave_sum(s2, F.lane) * (1.f / DM) + LN_EPS);
#pragma unroll
        for (int j = 0; j < 8; ++j) v[j] = v[j] * rstd * gp[64 * j] + bp[64 * j];
        if (F.lane == 0) *(GAS f32x2*)(stats + 2 * (size_t)row) = (f32x2){mean, rstd};
        const float* mod = wsf(F, WS_MOD) + (size_t)(modl * 3 + 2) * 12288 + chunk * DM;
        const GAS f32x4* shp = (const GAS f32x4*)mod + F.lane; const GAS f32x4* scp = (const GAS f32x4*)(mod + DM) + F.lane;
        GAS v2u* o8 = (GAS v2u*)(HX + (size_t)row * DM) + F.lane;
#pragma unroll
        for (int j = 0; j < 8; ++j) { const f32x4 h = v[j] * scp[64 * j] + shp[64 * j]; o8[64 * j] = (v2u){pk2(h.x, h.y), pk2(h.z, h.w)}; xr[64 * j] = v[j] * DN_ALPHA; }
    }
}

__device__ __forceinline__ void ln_cluster(Frame& F, int layer, int second, int nrows, int nplanes, const pg8::ClusterCtxOrder& S, unsigned* rel, unsigned* bar) {
    const int gw = F.vcu * NWAVES + F.wave, NGW = F.G * NWAVES;
    const float* gam = F.in(second ? 8 : 6) + layer * DM; const float* bet = F.in(second ? 9 : 7) + layer * DM;
    const bool final_out = (second && layer == DEPTH - 1);
    const int modl = second ? (layer + 1 < DEPTH ? layer + 1 : layer) : layer, chunk = second ? 0 : 3;
    bf16* HX = wsb(F, WS_ACT); float* stats = wsf(F, WS_STATS) + (size_t)second * 2 * M_T;
    const GAS f32x4* gp = (const GAS f32x4*)gam + F.lane; const GAS f32x4* bp = (const GAS f32x4*)bet + F.lane;
    const _Float16* T16 = (const _Float16*)(F.ws + WS_T16);
    pg8::Unit u0; S.map(S.c, u0);
    bool fast = (S.nxu == 4 * S.G) && S.c < S.nxu;
    if (fast) { for (int i = 1; i < 4; ++i) { pg8::Unit ui; S.map(i * S.G + S.c, ui); fast = fast && ui.pm == u0.pm + 4 * i && ui.pn == u0.pn; }
                const int ra = u0.pm * 256, rb = (u0.pm + 12) * 256 + 255; fast = fast && ((ra < SEQ) == (rb < SEQ)); }
    if (fast) {
        constexpr int RPWF = 16;
        if (F.wave == 0) { unsigned sp = 0u;
            for (int i = 0; i < 4; ++i) { unsigned* fl = rel + S.owner(u0.pm + 4 * i, F.lane & 7);
                while (!__all(__hip_atomic_load(fl, __ATOMIC_RELAXED, __HIP_MEMORY_SCOPE_AGENT) >= 1u)) { __builtin_amdgcn_s_sleep(2);
                    if ((++sp & 255u) == 0u) { if (xb_ld(&bar[XB_TMO])) break; if (sp > XB_SPIN_CAP) { atomicAdd(&bar[XB_TMO], 1u); break; } } } }
            __builtin_amdgcn_fence(__ATOMIC_ACQUIRE, "agent"); asm volatile("s_waitcnt vmcnt(0)" ::: "memory"); }
        __syncthreads();
        const int r0 = u0.pm * 256 + u0.pn * 32 + F.wave * 4, rt = r0 < SEQ ? 0 : 1;
        f32x4 A[8], B[8];
        { const float* mod = wsf(F, WS_MOD) + (size_t)(modl * 3 + rt) * 12288 + chunk * DM;
          const GAS f32x4* g4 = (const GAS f32x4*)gam + 2 * F.lane; const GAS f32x4* b4 = (const GAS f32x4*)bet + 2 * F.lane;
          const GAS f32x4* shp = (const GAS f32x4*)mod + 2 * F.lane; const GAS f32x4* scp = (const GAS f32x4*)(mod + DM) + 2 * F.lane;
#pragma unroll
          for (int j = 0; j < 4; ++j)
#pragma unroll
              for (int h = 0; h < 2; ++h) { const int q = 128 * j + h; const f32x4 g = g4[q], b = b4[q]; if (final_out) { A[2 * j + h] = g; B[2 * j + h] = b; } else { const f32x4 sc = scp[q], sh = shp[q]; A[2 * j + h] = g * sc; B[2 * j + h] = b * sc + sh; } } }
        #define ROWI(R) (r0 + ((R) >> 2) * 1024 + ((R) & 3))
#define XRP(R) ((const GAS f16x8*)(T16 + (size_t)ROWI(R) * DM) + F.lane)
        f16x8 ta[4], tb[4], tc[4];
#pragma unroll
        for (int j = 0; j < 4; ++j) { ta[j] = XRP(0)[64 * j]; tb[j] = XRP(1)[64 * j]; }
#define LN_ROW(CUR, NXT, R) do { \
            if ((R) + 2 < RPWF) { _Pragma("unroll") for (int j = 0; j < 4; ++j) NXT[j] = XRP((R) + 2)[64 * j]; } \
            f32x4 v_[8]; float s_ = 0.f; \
            _Pragma("unroll") for (int j = 0; j < 4; ++j) { v_[2 * j] = (f32x4){(float)CUR[j][0], (float)CUR[j][1], (float)CUR[j][2], (float)CUR[j][3]}; v_[2 * j + 1] = (f32x4){(float)CUR[j][4], (float)CUR[j][5], (float)CUR[j][6], (float)CUR[j][7]}; } \
            _Pragma("unroll") for (int j = 0; j < 8; ++j) s_ += (v_[j].x + v_[j].y) + (v_[j].z + v_[j].w); \
            const float mean_ = wave_sum(s_, F.lane) * (1.f / DM); float q_ = 0.f; \
            _Pragma("unroll") for (int j = 0; j < 8; ++j) { v_[j] = v_[j] - mean_; q_ += (v_[j].x * v_[j].x + v_[j].y * v_[j].y) + (v_[j].z * v_[j].z + v_[j].w * v_[j].w); } \
            const float rstd_ = 1.f / sqrtf(wave_sum(q_, F.lane) * (1.f / DM) + LN_EPS); \
            if (final_out) { GAS f32x4* o4_ = (GAS f32x4*)(F.out + (size_t)ROWI(R) * DM) + 2 * F.lane; \
                   _Pragma("unroll") for (int j = 0; j < 4; ++j) { o4_[128 * j] = v_[2 * j] * rstd_ * A[2 * j] + B[2 * j]; o4_[128 * j + 1] = v_[2 * j + 1] * rstd_ * A[2 * j + 1] + B[2 * j + 1]; } } \
            else { if (F.lane == 0) *(GAS f32x2*)(stats + 2 * (size_t)ROWI(R)) = (f32x2){mean_, rstd_}; \
                   GAS v4u* o8_ = (GAS v4u*)(HX + (size_t)ROWI(R) * DM) + F.lane; \
                   _Pragma("unroll") for (int j = 0; j < 4; ++j) { const f32x4 h0_ = v_[2 * j] * rstd_ * A[2 * j] + B[2 * j], h1_ = v_[2 * j + 1] * rstd_ * A[2 * j + 1] + B[2 * j + 1]; \
                       o8_[64 * j] = (v4u){pk2(h0_.x, h0_.y), pk2(h0_.z, h0_.w), pk2(h1_.x, h1_.y), pk2(h1_.z, h1_.w)}; } } \
        } while (0)
        for (int r = 0; r < RPWF - 1; r += 3) { LN_ROW(ta, tc, r); LN_ROW(tb, ta, r + 1); LN_ROW(tc, tb, r + 2); }
        LN_ROW(ta, tc, RPWF - 1);
#undef LN_ROW
#undef XRP
#undef ROWI
    } else {
    constexpr int RPW = 4;
    for (int i = 0;; ++i) {
        const long L = (long)i * S.G + S.c; if (L >= S.nxu) break;
        pg8::Unit u; S.map((int)L, u);
        if (F.wave == 0) { unsigned* fl = rel + S.owner(u.pm, F.lane & 7); unsigned sp = 0u;
            while (!__all(__hip_atomic_load(fl, __ATOMIC_RELAXED, __HIP_MEMORY_SCOPE_AGENT) >= 1u)) { __builtin_amdgcn_s_sleep(2);
                if ((++sp & 255u) == 0u) { if (xb_ld(&bar[XB_TMO])) break; if (sp > XB_SPIN_CAP) { atomicAdd(&bar[XB_TMO], 1u); break; } } }
            __builtin_amdgcn_fence(__ATOMIC_ACQUIRE, "agent"); asm volatile("s_waitcnt vmcnt(0)" ::: "memory"); }
        __syncthreads();
        const int r0 = u.pm * 256 + u.pn * 32 + F.wave * RPW, rt = r0 < SEQ ? 0 : 1;
        f32x4 A[8], B[8];
        { const float* mod = wsf(F, WS_MOD) + (size_t)(modl * 3 + rt) * 12288 + chunk * DM;
          const GAS f32x4* g4 = (const GAS f32x4*)gam + 2 * F.lane; const GAS f32x4* b4 = (const GAS f32x4*)bet + 2 * F.lane;
          const GAS f32x4* shp = (const GAS f32x4*)mod + 2 * F.lane; const GAS f32x4* scp = (const GAS f32x4*)(mod + DM) + 2 * F.lane;
#pragma unroll
          for (int j = 0; j < 4; ++j)
#pragma unroll
              for (int h = 0; h < 2; ++h) { const int q = 128 * j + h; const f32x4 g = g4[q], b = b4[q]; if (final_out) { A[2 * j + h] = g; B[2 * j + h] = b; } else { const f32x4 sc = scp[q], sh = shp[q]; A[2 * j + h] = g * sc; B[2 * j + h] = b * sc + sh; } } }
        const GAS f16x8* xr = (const GAS f16x8*)(T16 + (size_t)r0 * DM) + F.lane;
        f16x8 ta[4], tb[4], tc[4];
#pragma unroll
        for (int j = 0; j < 4; ++j) { ta[j] = xr[64 * j]; tb[j] = xr[(size_t)(DM / 8) + 64 * j]; }
#define LN_ROW(CUR, NXT, R) do { \
            if ((R) + 2 < RPW) { _Pragma("unroll") for (int j = 0; j < 4; ++j) NXT[j] = xr[(size_t)((R) + 2) * (DM / 8) + 64 * j]; } \
            f32x4 v_[8]; float s_ = 0.f; \
            _Pragma("unroll") for (int j = 0; j < 4; ++j) { v_[2 * j] = (f32x4){(float)CUR[j][0], (float)CUR[j][1], (float)CUR[j][2], (float)CUR[j][3]}; v_[2 * j + 1] = (f32x4){(float)CUR[j][4], (float)CUR[j][5], (float)CUR[j][6], (float)CUR[j][7]}; } \
            _Pragma("unroll") for (int j = 0; j < 8; ++j) s_ += (v_[j].x + v_[j].y) + (v_[j].z + v_[j].w); \
            const float mean_ = wave_sum(s_, F.lane) * (1.f / DM); float q_ = 0.f; \
            _Pragma("unroll") for (int j = 0; j < 8; ++j) { v_[j] = v_[j] - mean_; q_ += (v_[j].x * v_[j].x + v_[j].y * v_[j].y) + (v_[j].z * v_[j].z + v_[j].w * v_[j].w); } \
            const float rstd_ = 1.f / sqrtf(wave_sum(q_, F.lane) * (1.f / DM) + LN_EPS); \
            if (final_out) { GAS f32x4* o4_ = (GAS f32x4*)(F.out + (size_t)(r0 + (R)) * DM) + 2 * F.lane; \
                   _Pragma("unroll") for (int j = 0; j < 4; ++j) { o4_[128 * j] = v_[2 * j] * rstd_ * A[2 * j] + B[2 * j]; o4_[128 * j + 1] = v_[2 * j + 1] * rstd_ * A[2 * j + 1] + B[2 * j + 1]; } } \
            else { if (F.lane == 0) *(GAS f32x2*)(stats + 2 * (size_t)(r0 + (R))) = (f32x2){mean_, rstd_}; \
                   GAS v4u* o8_ = (GAS v4u*)(HX + (size_t)(r0 + (R)) * DM) + F.lane; \
                   _Pragma("unroll") for (int j = 0; j < 4; ++j) { const f32x4 h0_ = v_[2 * j] * rstd_ * A[2 * j] + B[2 * j], h1_ = v_[2 * j + 1] * rstd_ * A[2 * j + 1] + B[2 * j + 1]; \
                       o8_[64 * j] = (v4u){pk2(h0_.x, h0_.y), pk2(h0_.z, h0_.w), pk2(h1_.x, h1_.y), pk2(h1_.z, h1_.w)}; } } \
        } while (0)
        for (int r = 0; r < RPW - 1; r += 3) { LN_ROW(ta, tc, r); LN_ROW(tb, ta, r + 1); LN_ROW(tc, tb, r + 2); }
        LN_ROW(ta, tc, RPW - 1);
#undef LN_ROW
    }
    }
    if (nrows > M_X) {
        if (F.wave == 0) { unsigned sp = 0u;
            while ((unsigned)__builtin_amdgcn_readfirstlane((int)xb_ld(rel + 256)) < (unsigned)F.G) { __builtin_amdgcn_s_sleep(2);
                if ((++sp & 255u) == 0u) { if (xb_ld(&bar[XB_TMO])) break; if (sp > XB_SPIN_CAP) { atomicAdd(&bar[XB_TMO], 1u); break; } } }
            __builtin_amdgcn_fence(__ATOMIC_ACQUIRE, "agent"); asm volatile("s_waitcnt vmcnt(0)" ::: "memory"); }
        __syncthreads();
    }
    for (int row = M_X + F.wave * F.G + F.vcu; row < nrows; row += NGW) {
        float* xrow = wsf(F, WS_X32C) + (size_t)(row - M_X) * DM;
        GAS f32x4* xr = (GAS f32x4*)xrow + F.lane;
        f32x4 v[8]; float s = 0.f;
#pragma unroll
        for (int j = 0; j < 8; ++j) v[j] = xr[64 * j];
        { const GAS f32x4* pp = (const GAS f32x4*)(wsf(F, WS_BIG + BIG_CPART) + (size_t)(row - M_X) * DM) + F.lane;
          int p = 0;
          for (; p + 4 <= nplanes; p += 4) {
              f32x4 t[4][8];
#pragma unroll
              for (int q = 0; q < 4; ++q)
#pragma unroll
                  for (int j = 0; j < 8; ++j) t[q][j] = pp[(size_t)(p + q) * (M_C * DM / 4) + 64 * j];
#pragma unroll
              for (int j = 0; j < 8; ++j) v[j] += (t[0][j] + t[1][j]) + (t[2][j] + t[3][j]); }
          for (; p < nplanes; ++p) {
#pragma unroll
              for (int j = 0; j < 8; ++j) v[j] += pp[(size_t)p * (M_C * DM / 4) + 64 * j]; } }
#pragma unroll
        for (int j = 0; j < 8; ++j) s += (v[j].x + v[j].y) + (v[j].z + v[j].w);
        const float mean = wave_sum(s, F.lane) * (1.f / DM); float s2 = 0.f;
#pragma unroll
        for (int j = 0; j < 8; ++j) { v[j] = v[j] - mean; s2 += (v[j].x * v[j].x + v[j].y * v[j].y) + (v[j].z * v[j].z + v[j].w * v[j].w); }
        const float rstd = 1.f / sqrtf(wave_sum(s2, F.lane) * (1.f / DM) + LN_EPS);
#pragma unroll
        for (int j = 0; j < 8; ++j) v[j] = v[j] * rstd * gp[64 * j] + bp[64 * j];
        if (F.lane == 0) *(GAS f32x2*)(stats + 2 * (size_t)row) = (f32x2){mean, rstd};
        const float* mod = wsf(F, WS_MOD) + (size_t)(modl * 3 + 2) * 12288 + chunk * DM;
        const GAS f32x4* shp = (const GAS f32x4*)mod + F.lane; const GAS f32x4* scp = (const GAS f32x4*)(mod + DM) + F.lane;
        GAS v2u* o8 = (GAS v2u*)(HX + (size_t)row * DM) + F.lane;
#pragma unroll
        for (int j = 0; j < 8; ++j) { const f32x4 h = v[j] * scp[64 * j] + shp[64 * j]; o8[64 * j] = (v2u){pk2(h.x, h.y), pk2(h.z, h.w)}; xr[64 * j] = v[j] * DN_ALPHA; }
    }
}

__device__ __forceinline__ bool seq_start(int r) { return r >= M_T ? true : (r < M_X ? ((r & (SEQ - 1)) == 0) : (((r - M_X) & (CTXL - 1)) == 0)); }
__device__ __forceinline__ void unpack8(const v4u w, float (&f)[8]) { f[0] = bflo(w.x); f[1] = bfhi(w.x); f[2] = bflo(w.y); f[3] = bfhi(w.y); f[4] = bflo(w.z); f[5] = bfhi(w.z); f[6] = bflo(w.w); f[7] = bfhi(w.w); }

__device__ __forceinline__ void load8f(const float* p, float (&f)[8]) { const f32x4 a = *(const GAS f32x4*)p, b = *(const GAS f32x4*)(p + 4); f[0] = a.x; f[1] = a.y; f[2] = a.z; f[3] = a.w; f[4] = b.x; f[5] = b.y; f[6] = b.z; f[7] = b.w; }
__device__ __forceinline__ void convfix_phase(Frame& F, int j) {
    const int gw = F.vcu * NWAVES + F.wave, NGW = F.G * NWAVES;
    const float* HALO = wsf(F, WS_BIG + BIG_HALOC); const bf16* Bb = wsb(F, WS_BIG + BIG_BB); bf16* OUT = wsb(F, WS_BIG + BIG_GATED);
    const float* cw = F.in(11) + (size_t)j * 3 * DM;
    constexpr int NCG = DM / 512, NSEG = M_T / 64;
    for (int item = gw; item < NSEG * 2 * NCG; item += NGW) {
        const int cg = item % NCG, sw = item / NCG, seg = sw >> 1, bot = sw & 1, f0 = cg * 512 + F.lane * 8;
        const int row = 64 * seg + (bot ? 63 : 0);
        const bool missing = bot ? seq_start(row + 1) : seq_start(row);
        const float* P = HALO + ((size_t)seg * 512 + (f0 >> 2)) * 16 + (bot ? 12 : 4);
        const f32x4 p0 = *(const GAS f32x4*)P, p1 = *(const GAS f32x4*)(P + 16);
        float z[8] = {p0.x, p0.y, p0.z, p0.w, p1.x, p1.y, p1.z, p1.w};
        if (!missing) {
            const float* R = HALO + ((size_t)(bot ? seg + 1 : seg - 1) * 512 + (f0 >> 2)) * 16 + (bot ? 0 : 8);
            const f32x4 r0 = *(const GAS f32x4*)R, r1 = *(const GAS f32x4*)(R + 16); const float rr[8] = {r0.x, r0.y, r0.z, r0.w, r1.x, r1.y, r1.z, r1.w};
            float w[8]; load8f(cw + (bot ? 2 : 0) * DM + f0, w);
#pragma unroll
            for (int e = 0; e < 8; ++e) z[e] += w[e] * rr[e];
        }
        float bb[8]; unpack8(*(const GAS v4u*)(Bb + (size_t)row * DM + f0), bb);
        *(GAS v4u*)(OUT + (size_t)row * DM + f0) = (v4u){pk2(bb[0] * z[0], bb[1] * z[1]), pk2(bb[2] * z[2], bb[3] * z[3]), pk2(bb[4] * z[4], bb[5] * z[5]), pk2(bb[6] * z[6], bb[7] * z[7])};
    }
}

__device__ __forceinline__ void ffnfix_phase(Frame& F, int layer, int nrows) {
    const int gw = F.vcu * NWAVES + F.wave, NGW = F.G * NWAVES;
    const float* HALO = wsf(F, WS_BIG + BIG_HALO); bf16* ACT = wsb(F, WS_BIG + BIG_ACT);
    const float* cw = F.in(22) + (size_t)layer * 3 * 11264;
    constexpr int NCG = DFF / 512;
    const int nseg = nrows / 64;
    for (int item = gw; item < nseg * 2 * NCG; item += NGW) {
        const int cg = item % NCG, sw = item / NCG, seg = sw >> 1, bot = sw & 1, f0 = cg * 512 + F.lane * 8;
        const int row = 64 * seg + (bot ? 63 : 0);
        const bool missing = bot ? seq_start(row + 1) : seq_start(row);
        const float* P = HALO + ((size_t)seg * 2816 + (f0 >> 2)) * 16 + (bot ? 12 : 4);
        float pg[8], pu[8];
        { const f32x4 a = *(const GAS f32x4*)P, b = *(const GAS f32x4*)(P + 16), c = *(const GAS f32x4*)(P + 1408 * 16), d = *(const GAS f32x4*)(P + 1408 * 16 + 16);
          pg[0] = a.x; pg[1] = a.y; pg[2] = a.z; pg[3] = a.w; pg[4] = b.x; pg[5] = b.y; pg[6] = b.z; pg[7] = b.w; pu[0] = c.x; pu[1] = c.y; pu[2] = c.z; pu[3] = c.w; pu[4] = d.x; pu[5] = d.y; pu[6] = d.z; pu[7] = d.w; }
        if (!missing) {
            const float* R = HALO + ((size_t)(bot ? seg + 1 : seg - 1) * 2816 + (f0 >> 2)) * 16 + (bot ? 0 : 8); const float* W = cw + (bot ? 2 : 0) * 11264 + f0;
            float rg[8], ru[8], wg[8], wu[8]; load8f(W, wg); load8f(W + DFF, wu);
            { const f32x4 a = *(const GAS f32x4*)R, b = *(const GAS f32x4*)(R + 16), c = *(const GAS f32x4*)(R + 1408 * 16), d = *(const GAS f32x4*)(R + 1408 * 16 + 16);
              rg[0] = a.x; rg[1] = a.y; rg[2] = a.z; rg[3] = a.w; rg[4] = b.x; rg[5] = b.y; rg[6] = b.z; rg[7] = b.w; ru[0] = c.x; ru[1] = c.y; ru[2] = c.z; ru[3] = c.w; ru[4] = d.x; ru[5] = d.y; ru[6] = d.z; ru[7] = d.w; }
#pragma unroll
            for (int e = 0; e < 8; ++e) { pg[e] += wg[e] * rg[e]; pu[e] += wu[e] * ru[e]; }
        }
        float o[8];
#pragma unroll
        for (int e = 0; e < 8; ++e) o[e] = pg[e] * __builtin_amdgcn_rcpf(1.0f + __builtin_amdgcn_exp2f(-1.4426950408889634f * pg[e])) * pu[e];
        *(GAS v4u*)(ACT + (size_t)row * DFF + f0) = (v4u){pk2(o[0], o[1]), pk2(o[2], o[3]), pk2(o[4], o[5]), pk2(o[6], o[7])};
    }
}

__device__ __forceinline__ void krope_phase(Frame& F) {
    const int gw = F.vcu * NWAVES + F.wave, NGW = F.G * NWAVES;
    const float* KRRAW = wsf(F, WS_BIG + BIG_KRRAW); bf16* KR = wsb(F, WS_BIG + BIG_KR);
    const f32x2* ropeR = (const f32x2*)(F.ws + WS_ROPER); const f32x2* ropeC = (const f32x2*)(F.ws + WS_ROPEC);
    for (int row = gw; row < M_T; row += NGW) {
        float kr = KRRAW[(size_t)row * ROPE_D + F.lane];
        const float partner = lane_xor(kr, F.lane, 16);
        if (row < M_X) { const int pos = row & (SEQ - 1), f = F.lane & 15; const f32x2 cs = F.lane < 32 ? ropeR[(pos >> 6) * 16 + f] : ropeC[(pos & 63) * 16 + f];
            kr = kr * cs.x + ((F.lane & 16) ? partner : -partner) * cs.y; }
        KR[(size_t)row * ROPE_D + F.lane] = (bf16)f2bf(kr);
    }
}

__device__ __forceinline__ void attn_phase(Frame& F, bool last, int i_lo = 0, int i_hi = 1 << 30) {
    const bf16* Q = wsb(F, WS_BIG + BIG_Q); const bf16* K = wsb(F, WS_BIG + BIG_K); const bf16* V = wsb(F, WS_BIG + BIG_V); const bf16* KR = wsb(F, WS_BIG + BIG_KR); bf16* O = wsb(F, WS_BIG + BIG_O);
    const att::f32x2* ropeR = (const att::f32x2*)(F.ws + WS_ROPER); const att::f32x2* ropeC = (const att::f32x2*)(F.ws + WS_ROPEC);
    ATT_LAS char* lds = (ATT_LAS char*)(F.lds + RING_OFF);
    constexpr int NQB = SEQ / 256, NUNIT = BATCH * NH * NQB, NCU = BATCH * NH;
    const int ntot = last ? NUNIT : NUNIT + NCU;
    for (int i = i_lo; i < i_hi; ++i) {
        const int L = i * F.G + F.vcu; if (L >= ntot) break;
        const bool isx = L < NUNIT;
        const int p = isx ? L / NQB : L - NUNIT, qb = isx ? L % NQB : 0, b = p / NH, h = p % NH;
        const size_t qrow = isx ? (size_t)b * SEQ + (size_t)qb * 256 : (size_t)M_X + (size_t)b * CTXL;
        att::attn_unit(Q + qrow * 3072 + h * 192, K + (size_t)h * M_T * 128, V + (size_t)h * M_T * 128, KR, O + qrow * 2048 + h * 128,

                       b * SEQ, isx ? SEQ / 64 : 0, M_X + b * CTXL, isx ? SEQ / 64 + CTXL / 64 : CTXL / 64, isx ? 1 : 0, qb * 256, ropeR, ropeC, lds, F.wave0);
    }
}

#ifndef MK_ONE_LAUNCH
#define MK_ONE_LAUNCH 1
#endif
constexpr bool ONE_LAUNCH = (MK_ONE_LAUNCH != 0);
constexpr int N_PHASE_IDS = 2 + 10 * DEPTH;
struct Args { const float* in[25]; float* out; unsigned char* ws; int ph_lo, ph_hi; };
__global__ void __launch_bounds__(NWAVES * 64, 2) mk_fwd(Args args) {
    extern __shared__ __attribute__((aligned(16))) unsigned char lds[];
    LAS unsigned char* const L0 = (LAS unsigned char*)lds;
    for (int u = threadIdx.x; u < (LDS_BYTES - LDSCTL_OFF) / 4; u += NWAVES * 64) ((LAS unsigned*)(L0 + LDSCTL_OFF))[u] = 0u;
    __syncthreads();
    if (threadIdx.x < 27) { const unsigned long long v = threadIdx.x < 25 ? (unsigned long long)args.in[threadIdx.x] : (threadIdx.x == 25 ? (unsigned long long)args.out : (unsigned long long)args.ws);
        ((LAS unsigned long long*)(L0 + PTAB_OFF))[threadIdx.x] = v; }
    __syncthreads();
    const int lo = args.ph_lo, hi = args.ph_hi;
    const int wave0 = __builtin_amdgcn_readfirstlane((int)threadIdx.x >> 6);
    if (ONE_LAUNCH) { Frame F; make_frame(F, L0, wave0); (void)xcd_barrier_post((unsigned*)((gu32*)(F.ws + WS_CTL) + CW_BAR), (volatile LAS unsigned*)(L0 + MISC_OFF) + 8, F.tid == 0); }
#ifndef MK_SLOT_MASK
#define MK_SLOT_MASK 0xFFFFFFFFu
#endif
#define IN(k) (lo <= (k) && (k) < hi)
#define INS(sl, cv) ((((MK_SLOT_MASK) >> ((sl) + ((cv) ? 16 : 0))) & 1u) && IN(pb + (sl)))
#ifndef PROBE_WAIT
#define PROBE_WAIT 0
#endif
#ifndef PROBE_WAIT_MASK
#define PROBE_WAIT_MASK 0xFFFFFFFFFFFFFFFFull
#endif
#ifndef PROBE_SPAN
#define PROBE_SPAN 0
#endif
#ifndef PROBE_WAIT_AMP
#define PROBE_WAIT_AMP 4
#endif
#define SEAM() do { if (ONE_LAUNCH) { XcdBarrier b_; b_.bar = (unsigned*)((gu32*)(F.ws + WS_CTL) + CW_BAR); b_.x = xb_xcc_id(); b_.st = (volatile LAS unsigned*)(L0 + MISC_OFF) + 8; const bool lead_ = tid_from_wave(wave0) == 0; \
    unsigned long long tw0_ = 0; if (PROBE_WAIT) { __syncthreads(); tw0_ = __builtin_amdgcn_s_memrealtime(); } \
    for (int rb_ = 0; rb_ <= REP_BAR; ++rb_) xcd_barrier(b_, lead_); \
    if (PROBE_WAIT) { const unsigned long long tw1_ = __builtin_amdgcn_s_memrealtime(); if (lead_) { volatile LAS unsigned* pw_ = (volatile LAS unsigned*)(L0 + MISC_OFF + 64); const unsigned idx_ = pw_[2]; pw_[2] = idx_ + 1u; \
        const unsigned prev_ = pw_[4]; pw_[4] = (unsigned)tw1_;     \
        if (((unsigned long long)(PROBE_WAIT_MASK) >> idx_) & 1ull) pw_[0] += PROBE_SPAN ? ((unsigned)tw1_ - prev_) : (unsigned)(tw1_ - tw0_); } } } } while (0)
#ifndef REP_ATTN
#define REP_ATTN 0
#endif
#ifndef REP_UP
#define REP_UP 0
#endif
#ifndef REP_WIN
#define REP_WIN 0
#endif
#ifndef REP_MLAG
#define REP_MLAG 0
#endif
#ifndef REP_ELT
#define REP_ELT 0
#endif
#ifndef REP_RESID
#define REP_RESID 0
#endif
#ifndef REP_BAR
#define REP_BAR 0
#endif
#ifndef REP_LN
#define REP_LN 0
#endif
#ifndef PROBE_ATTN_SPLIT
#define PROBE_ATTN_SPLIT 0
#endif
#ifndef PROBE_UP_TAIL
#define PROBE_UP_TAIL 0
#endif
#ifndef REP_P0
#define REP_P0 0
#endif
#define FRAME() Frame F; make_frame(F, L0, wave0); LAS unsigned char* ring = F.lds + RING_OFF; (void)ring; \
    bf16* HX = wsb(F, WS_ACT); bf16* ACT = wsb(F, WS_BIG + BIG_ACT); bf16* GU = wsb(F, WS_BIG); float* X32C = wsf(F, WS_X32C); const float* MOD = wsf(F, WS_MOD); (void)HX; (void)ACT; (void)GU; (void)X32C; (void)MOD

    if (((MK_SLOT_MASK >> 30) & 1u) && IN(0)) { FRAME(); for (int rep_ = 0; rep_ <= REP_P0; ++rep_) { p0_prologue(F); __syncthreads(); } SEAM(); }
    if (((MK_SLOT_MASK >> 31) & 1u) && IN(1)) { FRAME(); p1_hx0(F); SEAM(); }

    for (int L = 0; L < DEPTH; ++L) {
        const int pb = 2 + 10 * L, j = L >> 1; const bool last = (L == DEPTH - 1); const int Mrows = last ? M_X : M_T;
        const bool is_conv = (L & 1) == 0;
        if (is_conv) {
            if (INS(1, 1)) { FRAME();
                unsigned* cvf = (unsigned*)((gu32*)(F.ws + WS_CTL) + CW_CVF + j * 1024);
                pg8::Gemm g{HX, wsb(F, WS_W + j * W_CONV_STRIDE + W_WIN), M_T, 3 * DM, DM}; pg8::ConvMergedOrder S; S.init(M_T, DM, 2 * DM, F.G, F.bx, cvf);
                pg8::EpiConvBoth E{{wsb(F, WS_BIG + BIG_BB), DM, nullptr, 0, 0, 1.f},
                                   {wsb(F, WS_BIG + BIG_GATED), wsf(F, WS_BIG + BIG_HALOC), wsb(F, WS_BIG + BIG_BB), F.in(11) + (size_t)j * 3 * DM, (unsigned)((M_T / 64) * 512 * 64)},
                                   S.sb, cvf, (unsigned*)((gu32*)(F.ws + WS_CTL) + CW_BAR) + XB_TMO, F.G};
                pg8::gemm_phase<pg8::EpiConvBoth, pg8::ConvMergedOrder, true, true>(ring, g, S, E, F.wave0); SEAM(); }
            if (INS(2, 1)) { FRAME(); convfix_phase(F, j); SEAM(); }
        } else {
            if (INS(0, 0)) { FRAME();
                pg8::Gemm g{HX, wsb(F, WS_W + W_MLA_BASE + j * W_MLA_STRIDE + W_DQKV), M_T, NDQKV, DM}; pg8::StaticOrder S; S.init(M_T, NDQKV, F.G, F.bx);
                pg8::EpiDqkv E{wsb(F, WS_BIG + BIG_CQ), wsb(F, WS_BIG + BIG_CKV), wsf(F, WS_BIG + BIG_KRRAW), wsf(F, WS_BIG + BIG_SSQ), (unsigned)(M_T * 64)};
                for (int rep_ = 0; rep_ <= REP_MLAG; ++rep_) pg8::gemm_phase<pg8::EpiDqkv, pg8::StaticOrder, true, true>(ring, g, S, E, F.wave0); SEAM(); }
            if (INS(2, 0)) { FRAME();
                krope_phase(F);
                for (int rep_ = 0; rep_ <= REP_MLAG; ++rep_) {
                { pg8::Gemm g{wsb(F, WS_BIG + BIG_CQ), wsb(F, WS_W + W_MLA_BASE + j * W_MLA_STRIDE + W_UQ), Mrows, 3072, QLR}; pg8::StaticOrder S; S.init(Mrows, 3072, F.G, F.bx);
                  pg8::EpiBf16Row E{wsb(F, WS_BIG + BIG_Q), 3072, 0, 0, wsf(F, WS_BIG + BIG_SSQ), RMS_EPS, 0};
                  pg8::gemm_phase<pg8::EpiBf16Row, pg8::StaticOrder, true, true>(ring, g, S, E, F.wave0); }
                { pg8::Gemm g{wsb(F, WS_BIG + BIG_CKV), wsb(F, WS_W + W_MLA_BASE + j * W_MLA_STRIDE + W_UKV), M_T, 4096, KVLR}; pg8::StaticOrder S; S.init(M_T, 4096, F.G, F.bx);
                  pg8::EpiBf16Row E{wsb(F, WS_BIG + BIG_K), 2048, 2048, (BIG_V - BIG_K) / 2, wsf(F, WS_BIG + BIG_SSQ) + 8, RMS_EPS, M_T};
                  pg8::gemm_phase<pg8::EpiBf16Row, pg8::StaticOrder, true, true>(ring, g, S, E, F.wave0); }
                }
                SEAM(); }
            if (INS(3, 0)) { FRAME(); if (PROBE_ATTN_SPLIT) { attn_phase(F, last, 0, 4); SEAM(); attn_phase(F, last, 4); } else { for (int rep_ = 0; rep_ <= REP_ATTN; ++rep_) attn_phase(F, last); } SEAM(); }
        }
        if (INS(4, 0)) { FRAME();
            const bf16* A = is_conv ? wsb(F, WS_BIG + BIG_GATED) : wsb(F, WS_BIG + BIG_O);
            const bf16* Bt = is_conv ? wsb(F, WS_W + j * W_CONV_STRIDE + W_WOUT) : wsb(F, WS_W + W_MLA_BASE + j * W_MLA_STRIDE + W_WO);
            pg8::Gemm g{A, Bt, Mrows, DM, DM}; pg8::ClusterCtxOrder S; S.init(M_X, Mrows - M_X, DM, DM, 4, F.G, F.bx);
            pg8::EpiResid E{L == 0 ? F.in(0) : nullptr, (const _Float16*)(F.ws + WS_T16), (_Float16*)(F.ws + WS_T16), wsf(F, WS_BIG + BIG_CPART), MOD + (size_t)L * 3 * 12288 + 2 * DM, DN_ALPHA,
                             L == 0 ? nullptr : wsf(F, WS_STATS) + 2 * M_T, F.in(8) + (L == 0 ? 0 : L - 1) * DM, F.in(9) + (L == 0 ? 0 : L - 1) * DM};
            if (REP_RESID) { pg8::EpiResid E2 = E; E2.dstT = (_Float16*)HX; pg8::SplitCtxOrder S2; S2.init(M_X, 0, DM, DM, 4, F.G, F.bx); pg8::gemm_phase<pg8::EpiResid, pg8::SplitCtxOrder, true, true>(ring, g, S2, E2, F.wave0); }
            pg8::gemm_phase<pg8::EpiResid, pg8::ClusterCtxOrder, true, true>(ring, g, S, E, F.wave0);
            { Frame F2; make_frame(F2, L0, wave0); unsigned* rel = (unsigned*)((gu32*)(F2.ws + WS_CTL) + CW_RLF + (2 * L + 0) * RLF_STRIDE); unsigned* bar2 = (unsigned*)((gu32*)(F2.ws + WS_CTL) + CW_BAR);
              if (F2.tid == 0) { __builtin_amdgcn_fence(__ATOMIC_RELEASE, "agent"); asm volatile("s_waitcnt vmcnt(0)" ::: "memory"); __hip_atomic_store(rel + F2.bx, 1u, __ATOMIC_RELAXED, __HIP_MEMORY_SCOPE_AGENT); (void)xb_add(rel + 256, 1u); }
              pg8::ClusterCtxOrder S2; S2.init(M_X, Mrows - M_X, DM, DM, 4, F2.G, F2.bx);
              ln_cluster(F2, L, 0, Mrows, 4, S2, rel, bar2);
              if (F2.G == 256) {
                  asm volatile("s_waitcnt vmcnt(0)" ::: "memory"); __syncthreads();
                  if (F2.tid == 0) { __builtin_amdgcn_fence(__ATOMIC_RELEASE, "agent"); asm volatile("s_waitcnt vmcnt(0)" ::: "memory"); __hip_atomic_store(rel + 512 + F2.bx, 1u, __ATOMIC_RELAXED, __HIP_MEMORY_SCOPE_AGENT); (void)xb_add(rel + 257, 1u); } } }
            if (F.G != 256) SEAM(); }
        if (INS(6, 0)) { FRAME();
            pg8::Gemm g{HX, wsb(F, WS_W + W_FFN_BASE + L * W_FFN_STRIDE + W_UP), Mrows, 11264, DM};
            pg8::EpiConvAct E{ACT, wsf(F, WS_BIG + BIG_HALO), F.in(22) + (size_t)L * 3 * 11264, F.in(23) + (size_t)L * 11264, (unsigned)((M_T / 64) * 2816 * 64)};
            if (F.G == 256) {
                unsigned* rel = (unsigned*)((gu32*)(F.ws + WS_CTL) + CW_RLF + (2 * L + 0) * RLF_STRIDE);
                if (F.wave == 0) { unsigned* bar2 = (unsigned*)((gu32*)(F.ws + WS_CTL) + CW_BAR); unsigned* fl = rel + 512 + (8 * (8 * (F.bx >> 6) + (F.lane & 7)) + (F.bx & 7)); unsigned sp = 0u;
                    while (!__all(__hip_atomic_load(fl, __ATOMIC_RELAXED, __HIP_MEMORY_SCOPE_AGENT) >= 1u)) { __builtin_amdgcn_s_sleep(2);
                        if ((++sp & 255u) == 0u) { if (xb_ld(&bar2[XB_TMO])) break; if (sp > XB_SPIN_CAP) { atomicAdd(&bar2[XB_TMO], 1u); break; } } }
                    __builtin_amdgcn_fence(__ATOMIC_ACQUIRE, "agent"); asm volatile("s_waitcnt vmcnt(0)" ::: "memory"); }
                __syncthreads();
                pg8::ClusterUpOrder S; S.init(11264, Mrows - M_X, F.G, F.bx, rel + 257);
                pg8::gemm_phase<pg8::EpiConvAct, pg8::ClusterUpOrder, true, true>(ring, g, S, E, F.wave0);
            } else {
                pg8::StaticOrder S; S.init(Mrows, 11264, F.G, F.bx);
                pg8::gemm_phase<pg8::EpiConvAct, pg8::StaticOrder, true, true>(ring, g, S, E, F.wave0);
            }
            SEAM(); }
        if (INS(7, 0)) { FRAME(); for (int rep_ = 0; rep_ <= REP_ELT; ++rep_) ffnfix_phase(F, L, Mrows); SEAM(); }
        if (INS(8, 0)) { FRAME();
            pg8::Gemm g{ACT, wsb(F, WS_W + W_FFN_BASE + L * W_FFN_STRIDE + W_DOWN), Mrows, DM, DFF}; pg8::ClusterCtxOrder S; S.init(M_X, Mrows - M_X, DM, DFF, 11, F.G, F.bx);
            pg8::EpiResid E{nullptr, (const _Float16*)(F.ws + WS_T16), (_Float16*)(F.ws + WS_T16), wsf(F, WS_BIG + BIG_CPART), MOD + (size_t)L * 3 * 12288 + 5 * DM, DN_ALPHA, wsf(F, WS_STATS), F.in(6) + L * DM, F.in(7) + L * DM};
            if (REP_RESID) { pg8::EpiResid E2 = E; E2.dstT = (_Float16*)HX; pg8::SplitCtxOrder S2; S2.init(M_X, 0, DM, DFF, 11, F.G, F.bx); pg8::gemm_phase<pg8::EpiResid, pg8::SplitCtxOrder, true, true>(ring, g, S2, E2, F.wave0); }
            pg8::gemm_phase<pg8::EpiResid, pg8::ClusterCtxOrder, true, true>(ring, g, S, E, F.wave0);
            { Frame F2; make_frame(F2, L0, wave0); unsigned* rel = (unsigned*)((gu32*)(F2.ws + WS_CTL) + CW_RLF + (2 * L + 1) * RLF_STRIDE); unsigned* bar2 = (unsigned*)((gu32*)(F2.ws + WS_CTL) + CW_BAR);
              if (F2.tid == 0) { __builtin_amdgcn_fence(__ATOMIC_RELEASE, "agent"); asm volatile("s_waitcnt vmcnt(0)" ::: "memory"); __hip_atomic_store(rel + F2.bx, 1u, __ATOMIC_RELAXED, __HIP_MEMORY_SCOPE_AGENT); (void)xb_add(rel + 256, 1u); }
              pg8::ClusterCtxOrder S2; S2.init(M_X, Mrows - M_X, DM, DFF, 11, F2.G, F2.bx);
              ln_cluster(F2, L, 1, Mrows, 11, S2, rel, bar2); }
            if (!last) SEAM(); }
    }
#if PROBE_WAIT
    { FRAME(); const bool pl_ = F.tid == 0; unsigned* acc_ = (unsigned*)((gu32*)(F.ws + WS_CTL) + 64);
      if (pl_) (void)xb_add(acc_, *(volatile LAS unsigned*)(L0 + MISC_OFF + 64));
      SEAM();
      if (F.bx == 0 && pl_) { const unsigned sum_ = xb_ld(acc_); const unsigned long long tgt_ = (unsigned long long)(sum_ / (unsigned)F.G) * PROBE_WAIT_AMP; const unsigned long long t0_ = __builtin_amdgcn_s_memrealtime();
          while (__builtin_amdgcn_s_memrealtime() - t0_ < tgt_) __builtin_amdgcn_s_sleep(16); } }
#endif
#undef IN
#undef SEAM
}

extern "C" void kernel_launch(void* const* d_in, const int* in_sizes, int n_in, void* d_out, int out_size, void* d_ws, size_t ws_size, hipStream_t stream) {
    static int grid = 0;
    if (grid == 0) {
        if (n_in != 25 || in_sizes[0] != M_X * DM || out_size != M_X * DM || ws_size < WS_END) {
            fprintf(stderr, "kernel_launch: shape/workspace mismatch: n_in %d in0 %d out %d ws %zu (need %zu); nothing launched\n", n_in, n_in > 0 ? in_sizes[0] : -1, out_size, ws_size, (size_t)WS_END); grid = -1; return; }
        int dev = 0, cus = 0, per_cu = 0;
        if (hipGetDevice(&dev) != hipSuccess || hipDeviceGetAttribute(&cus, hipDeviceAttributeMultiprocessorCount, dev) != hipSuccess) { grid = -1; return; }
        if (hipFuncSetAttribute((const void*)mk_fwd, hipFuncAttributeMaxDynamicSharedMemorySize, LDS_BYTES) != hipSuccess) { fprintf(stderr, "kernel_launch: hipFuncSetAttribute failed\n"); grid = -1; return; }
        if (hipOccupancyMaxActiveBlocksPerMultiprocessor(&per_cu, (const void*)mk_fwd, NWAVES * 64, LDS_BYTES) != hipSuccess || per_cu < 1)
            fprintf(stderr, "kernel_launch: note: occupancy query reports %d workgroups per CU\n", per_cu);
        (void)hipGetLastError();
        grid = cus;
    }
    if (grid < 0) return;
    if (hipMemsetAsync((char*)d_ws + WS_CTL, 0, CTL_ZERO_BYTES, stream) != hipSuccess) return;
    Args a{};
    for (int i = 0; i < 25; ++i) a.in[i] = (const float*)d_in[i];
    a.out = (float*)d_out; a.ws = (unsigned char*)d_ws;
    if (ONE_LAUNCH) {
        a.ph_lo = 0; a.ph_hi = N_PHASE_IDS;
        hipLaunchKernelGGL(mk_fwd, dim3(grid), dim3(NWAVES * 64), LDS_BYTES, stream, a);
    } else {
        for (int p = 0; p < N_PHASE_IDS; ++p) {
            if (p >= 2) { const int L = (p - 2) / 10, s = (p - 2) % 10; if (((L & 1) == 0 && s == 3) || ((L & 1) == 1 && s == 1)) continue; }
            a.ph_lo = p; a.ph_hi = p + 1;
            hipLaunchKernelGGL(mk_fwd, dim3(grid), dim3(NWAVES * 64), LDS_BYTES, stream, a);
        }
    }
    const hipError_t le = hipPeekAtLastError();
    if (le != hipSuccess) fprintf(stderr, "kernel_launch: launch failed: %s\n", hipGetErrorName(le));
}
```

```cpp
#include <hip/hip_runtime.h>
#include <cstdio>
#include <cstdint>
#include <cmath>
#ifndef ATT_SDEPTH
#define ATT_SDEPTH 1
#endif
__device__ __forceinline__ int tid_from_wave(int wave) {
    int w = wave; asm volatile("" : "+s"(w));
    unsigned z = 0u; asm volatile("" : "+v"(z));
    int l = (int)__builtin_amdgcn_mbcnt_hi(~0u, __builtin_amdgcn_mbcnt_lo(~0u, z)); asm volatile("" : "+v"(l));
    return (w << 6) | l;
}
namespace pg8 {
#define PG8_LAS __attribute__((address_space(3)))
typedef unsigned short bf16_t;
typedef short bf16x8 __attribute__((ext_vector_type(8)));
typedef float f32x4 __attribute__((ext_vector_type(4)));
typedef unsigned u32x4 __attribute__((ext_vector_type(4)));
constexpr int BM = 256, BK = 64, HALF = 128, HTB = HALF * BK * 2  , STAGE_BYTES = 8 * HTB, NXCD = 8, WGM = 8;

__host__ __device__ __forceinline__ int lds_byte(int r, int c) { const int st = (r >> 4) * 2 + (c >> 5), rr = r & 15, cc = c & 31, ob = rr * 64 + cc * 2; return st * 1024 + (ob ^ (((ob >> 9) & 1) << 5)); }
__host__ __device__ __forceinline__ void stage_rc(int b, int& R, int& C) { const int st = b / 1024, sb = b % 1024, swz = sb ^ (((sb >> 9) & 1) << 5); R = (st >> 1) * 16 + swz / 64; C = (st & 1) * 32 + (swz % 64) / 2; }
__host__ __device__ __forceinline__ int perm32(int rho) { const int n = rho >> 4, i = rho & 15; return 8 * (i >> 2) + 4 * n + (i & 3); }

struct Unit { int pm, pn, kofs, nt, tag = 0; };
struct Gemm { const bf16_t* A; const bf16_t* Bt; int M, N, K; int a_blocked = 0; };

struct StaticOrder {
    int nM, nN, nwg, G, c, i_off = 0, i_cnt = 1 << 30;
    __host__ __device__ void init(int M, int N, int G_, int c_) { nM = M / BM; nN = N / BM; nwg = nM * nN; G = G_; c = c_; }
    __host__ __device__ bool next(int i_, Unit& u) const {
        if (i_ >= i_cnt) return false; const int i = i_ + i_off;
        const long L = (long)i * G + c; if (L >= nwg) return false;
        map((int)L, u); return true;
    }
    __host__ __device__ void map(int L, Unit& u) const {
        int wgid = L; { const int q = nwg / NXCD, r = nwg % NXCD, xcd = wgid % NXCD, off = wgid / NXCD; wgid = (xcd < r ? xcd * (q + 1) : r * (q + 1) + (xcd - r) * q) + off; }
        const int nig = WGM * nN, gid = wgid / nig, fm = gid * WGM, gsz = (nM - fm) < WGM ? (nM - fm) : WGM;
        u.pm = fm + ((wgid % nig) % gsz); u.pn = (wgid % nig) / gsz; u.kofs = 0; u.nt = 0;
    }
    __host__ __device__ int block_of(int pm, int pn) const {
        const int nig = WGM * nN, gid = pm / WGM, fm = gid * WGM, gsz = (nM - fm) < WGM ? (nM - fm) : WGM, wgid = gid * nig + pn * gsz + (pm - fm);
        const int q = nwg / NXCD, r = nwg % NXCD; int xcd, off;
        if (wgid < r * (q + 1)) { xcd = wgid / (q + 1); off = wgid % (q + 1); } else { const int w2 = wgid - r * (q + 1); xcd = r + w2 / q; off = w2 % q; }
        return off * NXCD + xcd;
    }
    __device__ __forceinline__ void a_ready(const Unit&) const {}
    __device__ __forceinline__ void done(const Unit&) const {}
};

struct TailProbeOrder {
    StaticOrder base;
    __host__ __device__ void init(int M, int N, int G_, int c_) { base.init(M, N, G_, c_); }
    __host__ __device__ bool next(int i, Unit& u) const {
        if (base.next(i, u)) return true;
        const int r0 = (base.nwg - base.c + base.G - 1) / base.G;
        const int rmax = (base.nwg + base.G - 1) / base.G;
        if (i == r0 && r0 == rmax && base.c < 16) return base.next(0, u);
        return false;
    }
    __device__ __forceinline__ void a_ready(const Unit&) const {}
    __device__ __forceinline__ void done(const Unit&) const {}
};
struct SplitCtxOrder {
    StaticOrder base; int nxu, nct, nN, nslice, slice_k, G, c;
    __host__ __device__ void init(int Mx, int Mc, int N, int K, int nslice_, int G_, int c_) { base.init(Mx, N, G_, c_); nxu = base.nwg; nN = N / BM; nct = Mc / BM; nslice = nslice_; slice_k = K / nslice_; G = G_; c = c_; }
    __host__ __device__ bool next(int i, Unit& u) const {
        const long L = (long)i * G + c;
        if (L < nxu) return base.next(i, u);
        const int q = (int)(L - nxu); if (q >= nct * nN * nslice) return false;
        const int t = q / nslice, s = q % nslice; u.pm = base.nM + t / nN; u.pn = t % nN; u.kofs = s * slice_k; u.nt = slice_k / BK; return true;
    }
    __device__ __forceinline__ void a_ready(const Unit&) const {}
    __device__ __forceinline__ void done(const Unit&) const {}
};

struct ClusterCtxOrder {
    static constexpr bool PUBLISH = false;
    int nM, nN, nxu, nct, nslice, slice_k, G, c;
    __host__ __device__ void init(int Mx, int Mc, int N, int K, int nslice_, int G_, int c_) { nM = Mx / BM; nN = N / BM; nxu = nM * nN; nct = Mc / BM; nslice = nslice_; slice_k = K / nslice_; G = G_; c = c_; }
    __host__ __device__ void map(int L, Unit& u) const { int wgid = L; { const int q = nxu / NXCD, r = nxu % NXCD, xcd = wgid % NXCD, off = wgid / NXCD; wgid = (xcd < r ? xcd * (q + 1) : r * (q + 1) + (xcd - r) * q) + off; }
        u.pm = wgid / nN; u.pn = wgid % nN; u.kofs = 0; u.nt = 0; }
    __host__ __device__ int owner(int pm, int pn) const { const int wgid = pm * nN + pn, q = nxu / NXCD, r = nxu % NXCD; int xcd, off;
        if (wgid < r * (q + 1)) { xcd = wgid / (q + 1); off = wgid % (q + 1); } else { const int w2 = wgid - r * (q + 1); xcd = r + w2 / q; off = w2 % q; }
        return (off * NXCD + xcd) % G; }
    __host__ __device__ bool next(int i, Unit& u) const {
        const long L = (long)i * G + c;
        if (L < nxu) { map((int)L, u); return true; }
        const int q = (int)(L - nxu); if (q >= nct * nN * nslice) return false;
        const int t = q / nslice, s = q % nslice; u.pm = nM + t / nN; u.pn = t % nN; u.kofs = s * slice_k; u.nt = slice_k / BK; return true;
    }
    __device__ __forceinline__ void a_ready(const Unit&) const {}
    __device__ __forceinline__ void done(const Unit&) const {}
};

struct ClusterUpOrder {
    static constexpr bool PUBLISH = false;
    int nN, nct, G, c; unsigned* count2;
    __host__ __device__ void init(int N, int Mc, int G_, int c_, unsigned* count2_) { nN = N / BM; nct = Mc / BM; G = G_; c = c_; count2 = count2_; }
    __host__ __device__ bool next(int i, Unit& u) const {
        const int x = c & 7, w = (c >> 3) & 7, k = c >> 6, per = nN / 4, nr = 2 * per;
        if (i < nr) { const int rp = i / per, cgp = i % per; u.pm = 16 * x + 4 * (2 * rp + (w & 1)) + k; u.pn = 4 * cgp + (w >> 1); u.kofs = 0; u.nt = 0; return true; }
        const int q = (i - nr) * G + c; if (q >= nct * nN) return false;
        u.pm = 128 + q / nN; u.pn = q % nN; u.kofs = 0; u.nt = 0; return true;
    }
    __device__ __forceinline__ void a_ready(const Unit& u) const {
        if (u.pm >= 128) { unsigned sp = 0u;
            while ((unsigned)__builtin_amdgcn_readfirstlane((int)__hip_atomic_load(count2, __ATOMIC_RELAXED, __HIP_MEMORY_SCOPE_AGENT)) < (unsigned)G) { __builtin_amdgcn_s_sleep(2); if (++sp > (1u << 20)) break; }
            __builtin_amdgcn_fence(__ATOMIC_ACQUIRE, "agent"); }
    }
    __device__ __forceinline__ void done(const Unit&) const {}
};

struct ConvMergedOrder {
    static constexpr bool PUBLISH = false;
    StaticOrder sb, sc; int nbt, G, c; unsigned* flags;
    __host__ __device__ void init(int M, int NB, int NC, int G_, int c_, unsigned* flags_) { sb.init(M, NB, G_, c_); sc.init(M, NC, G_, c_); nbt = sb.nwg; G = G_; c = c_; flags = flags_; }
    __host__ __device__ bool next(int i, Unit& u) const {
        const long L = (long)i * G + c;
        if (L < nbt) { sb.map((int)L, u); u.tag = (i >= 3 || L + G >= nbt) ? 1 : 0; return true; }
        if (L - nbt >= sc.nwg) return false;
        sc.map((int)(L - nbt), u); u.pn += sb.nN; u.tag = 0; return true;
    }
    __device__ __forceinline__ void a_ready(const Unit&) const {}
    __device__ __forceinline__ void done(const Unit& u) const {
        if (u.tag) {
            asm volatile("s_waitcnt vmcnt(0)" ::: "memory");
            unsigned z = 0u; asm volatile("" : "+v"(z)); unsigned old = 0u;
            if (__builtin_amdgcn_mbcnt_hi(~0u, __builtin_amdgcn_mbcnt_lo(~0u, z)) == 0u) old = __hip_atomic_fetch_add(flags + c, 1u, __ATOMIC_RELAXED, __HIP_MEMORY_SCOPE_AGENT);
            old = (unsigned)__builtin_amdgcn_readfirstlane((int)old);
            if ((old & 7u) == 7u) {
                __builtin_amdgcn_fence(__ATOMIC_RELEASE, "agent"); asm volatile("s_waitcnt vmcnt(0)" ::: "memory");
                __hip_atomic_store(flags + 512 + c, (old + 1u) >> 3, __ATOMIC_RELAXED, __HIP_MEMORY_SCOPE_AGENT); }
        }
    }
};
__device__ __forceinline__ unsigned cvt_pk_bf16(float lo, float hi) { unsigned r; asm volatile("v_cvt_pk_bf16_f32 %0, %1, %2" : "=v"(r) : "v"(lo), "v"(hi)); return r; }
typedef float f32x2 __attribute__((ext_vector_type(2)));
__device__ __forceinline__ f32x2 gelu_pk(f32x2 v) {
    const f32x2 av = __builtin_elementwise_abs(v), d = av * 0.2316418882f + 1.0f;
    f32x2 t; t.x = __builtin_amdgcn_rcpf(d.x); t.y = __builtin_amdgcn_rcpf(d.y);
    f32x2 q = t * 0.5307027145f + (-0.7265760135f); q = q * t + 0.7107068705f; q = q * t + (-0.142248368f); q = q * t + 0.127414796f; q = q * t;
    const f32x2 s = (v * v) * (-0.72134752044f);
    f32x2 e; e.x = __builtin_amdgcn_exp2f(s.x); e.y = __builtin_amdgcn_exp2f(s.y);
    const f32x2 m = v * (q * e), r = v - m;
    f32x2 o; o.x = v.x < 0.f ? m.x : r.x; o.y = v.y < 0.f ? m.y : r.y; return o;
}

template <int ACT  > struct EpiBf16 {
    static constexpr bool PERM = true, AFTER_DRAIN = false; static_assert(ACT == 0 || ACT == 1, "EpiBf16: ACT is 0 (none) or 1 (gelu_pk)");
    bf16_t* O; int ldc; const float* bias; int split_cols; size_t split_stride; float scale0;
    __device__ __forceinline__ void operator()(const f32x4 (&acc)[2][2][4][2], const Unit& u, int wr, int wc, int fr, int fq) const {
        const int row0 = u.pm * BM + wr * 64 + fr; int colt = u.pn * BM; bf16_t* base = O;
        float sc = 1.f; if (split_cols) { const int t = colt / split_cols; base += (size_t)t * split_stride; colt -= t * split_cols; if (t == 0) sc = scale0; }
        const int col0 = colt + wc * 32 + 8 * fq, bcol0 = u.pn * BM + wc * 32 + 8 * fq;
        f32x4 bv[2][2];
#pragma unroll
        for (int bj = 0; bj < 2; ++bj)
#pragma unroll
            for (int n = 0; n < 2; ++n) bv[bj][n] = bias ? *(const f32x4*)(bias + bcol0 + bj * HALF + 4 * n) : (f32x4){0.f, 0.f, 0.f, 0.f};
#pragma unroll
        for (int ai = 0; ai < 2; ++ai)
#pragma unroll
            for (int m = 0; m < 4; ++m) { bf16_t* rowp = base + (size_t)(row0 + ai * HALF + m * 16) * ldc + col0;
#pragma unroll
                for (int bj = 0; bj < 2; ++bj) { f32x4 v0 = acc[ai][bj][m][0] + bv[bj][0], v1 = acc[ai][bj][m][1] + bv[bj][1];
                    if (ACT == 1) { f32x2 a = gelu_pk((f32x2){v0[0], v0[1]}), b = gelu_pk((f32x2){v0[2], v0[3]}), c = gelu_pk((f32x2){v1[0], v1[1]}), d = gelu_pk((f32x2){v1[2], v1[3]});
                        v0 = (f32x4){a.x, a.y, b.x, b.y}; v1 = (f32x4){c.x, c.y, d.x, d.y}; }
                    v0 = v0 * sc; v1 = v1 * sc; u32x4 w; w.x = cvt_pk_bf16(v0[0], v0[1]); w.y = cvt_pk_bf16(v0[2], v0[3]); w.z = cvt_pk_bf16(v1[0], v1[1]); w.w = cvt_pk_bf16(v1[2], v1[3]);
                    *(u32x4*)(rowp + bj * HALF) = w; } }
    }
};

struct EpiF32 {
    static constexpr bool PERM = false, AFTER_DRAIN = false;
    float* C; int ldc;
    __device__ __forceinline__ void operator()(const f32x4 (&acc)[2][2][4][2], const Unit& u, int wr, int wc, int fr, int fq) const {
        const int row0 = u.pm * BM + wr * 64 + fr, col0 = u.pn * BM + wc * 32 + 4 * fq;
#pragma unroll
        for (int ai = 0; ai < 2; ++ai)
#pragma unroll
            for (int m = 0; m < 4; ++m) { float* rowp = C + (size_t)(row0 + ai * HALF + m * 16) * ldc + col0;
#pragma unroll
                for (int bj = 0; bj < 2; ++bj)
#pragma unroll
                    for (int n = 0; n < 2; ++n) *(f32x4*)(rowp + bj * HALF + n * 16) = acc[ai][bj][m][n]; }
    }
};
typedef _Float16 f16x8 __attribute__((ext_vector_type(8)));
typedef _Float16 f16x4 __attribute__((ext_vector_type(4)));
struct EpiResid {
    static constexpr bool PERM = true, AFTER_DRAIN = false;
    const float* src32; const _Float16* srcT; _Float16* dstT; float* dstC; const float* gate; float alpha;
    const float* stats; const float* gam; const float* bet;
    __device__ __forceinline__ void operator()(const f32x4 (&acc)[2][2][4][2], const Unit& u, int wr, int wc, int fr_, int fq_) const {
        int fr = fr_, fq = fq_; asm volatile("" : "+v"(fr), "+v"(fq));
        const int col0 = u.pn * BM + wc * 32 + 8 * fq;
        if (u.pm >= 128) {
            const int rowc = (u.pm - 128) * BM + wr * 64 + fr;
#pragma unroll
            for (int bj = 0; bj < 2; ++bj)
#pragma unroll
                for (int n = 0; n < 2; ++n) { const int c = col0 + bj * HALF + 4 * n; const f32x4 gv = *(const f32x4*)(gate + 2 * 12288 + c);
#pragma unroll
                    for (int ai = 0; ai < 2; ++ai)
#pragma unroll
                        for (int m = 0; m < 4; ++m) { float* dp = dstC + ((size_t)(u.kofs >> 9) * 512 + (size_t)(rowc + ai * HALF + m * 16)) * 2048 + c; *(f32x4*)dp = gv * acc[ai][bj][m][n]; } }
            return;
        }
        const int rt = u.pm < 64 ? 0 : 1;
        const int row0 = u.pm * BM + wr * 64 + fr;
        const float* st = stats ? stats + 2 * (size_t)row0 : nullptr;
#pragma unroll
        for (int bj = 0; bj < 2; ++bj) {
            const int c = col0 + bj * HALF;
            const f32x4 gv0 = *(const f32x4*)(gate + rt * 12288 + c), gv1 = *(const f32x4*)(gate + rt * 12288 + c + 4);
            f32x4 ga0 = {alpha, alpha, alpha, alpha}, ga1 = ga0, ba0 = {0.f, 0.f, 0.f, 0.f}, ba1 = ba0;
            if (st) { ga0 = *(const f32x4*)(gam + c) * alpha; ga1 = *(const f32x4*)(gam + c + 4) * alpha; ba0 = *(const f32x4*)(bet + c) * alpha; ba1 = *(const f32x4*)(bet + c + 4) * alpha; }
#pragma unroll
            for (int ai = 0; ai < 2; ++ai)
#pragma unroll
                for (int m = 0; m < 4; ++m) { const size_t off = (size_t)(row0 + ai * HALF + m * 16) * 2048 + c;
                    f32x4 x0, x1;
                    if (src32) { x0 = *(const f32x4*)(src32 + off); x1 = *(const f32x4*)(src32 + off + 4); }
                    else { const f16x8 t = *(const f16x8*)(srcT + off); x0 = (f32x4){(float)t[0], (float)t[1], (float)t[2], (float)t[3]}; x1 = (f32x4){(float)t[4], (float)t[5], (float)t[6], (float)t[7]}; }
                    if (st) { const f32x2 ms = *(const f32x2*)(st + 2 * (ai * HALF + m * 16)); x0 = (x0 - ms.x) * ms.y; x1 = (x1 - ms.x) * ms.y; }
                    const f32x4 o0 = x0 * ga0 + ba0 + gv0 * acc[ai][bj][m][0], o1 = x1 * ga1 + ba1 + gv1 * acc[ai][bj][m][1];
                    const f16x8 w = {(_Float16)o0[0], (_Float16)o0[1], (_Float16)o0[2], (_Float16)o0[3], (_Float16)o1[0], (_Float16)o1[1], (_Float16)o1[2], (_Float16)o1[3]};
                    *(f16x8*)(dstT + off) = w; }
            asm volatile("" ::: "memory");
        }
    }
};
template <int CTRL> __device__ __forceinline__ float dppf(float old, float src) {
    return __builtin_bit_cast(float, __builtin_amdgcn_update_dpp(__builtin_bit_cast(int, old), __builtin_bit_cast(int, src), CTRL, 0xf, 0xf, false)); }
template <int CTRL> __device__ __forceinline__ float dppz(float src) {
    return __builtin_bit_cast(float, __builtin_amdgcn_update_dpp(0, __builtin_bit_cast(int, src), CTRL, 0xf, 0xf, true)); }
__device__ __forceinline__ float silu_e(float x) { return x * __builtin_amdgcn_rcpf(1.0f + __builtin_amdgcn_exp2f(-1.4426950408889634f * x)); }
struct EpiConvAct {
    static constexpr bool PERM = true, AFTER_DRAIN = false;
    bf16_t* ACT; float* HALO; const float* cw; const float* cb; unsigned halo_bytes;
    __device__ __forceinline__ void operator()(f32x4 (&acc)[2][2][4][2], const Unit& u, int wr, int wc, int fr_, int fq_) const {
        int fr = fr_, fq = fq_; asm volatile("" : "+v"(fr), "+v"(fq));
        constexpr int ROW_SHL1 = 0x101, ROW_SHL15 = 0x10F, ROW_SHR1 = 0x111, ROW_SHR15 = 0x11F;
        const int f0 = u.pn * 128 + wc * 32 + 8 * fq;
#define DPZ4(CTRL, SRC) (f32x4){dppz<CTRL>((SRC)[0]), dppz<CTRL>((SRC)[1]), dppz<CTRL>((SRC)[2]), dppz<CTRL>((SRC)[3])}
#define DPP4(CTRL, OLD, SRC) (f32x4){dppf<CTRL>((OLD)[0], (SRC)[0]), dppf<CTRL>((OLD)[1], (SRC)[1]), dppf<CTRL>((OLD)[2], (SRC)[2]), dppf<CTRL>((OLD)[3], (SRC)[3])}
        const f32x4 z4 = {0.f, 0.f, 0.f, 0.f};
        const __amdgpu_buffer_rsrc_t hrs = __builtin_amdgcn_make_buffer_rsrc(HALO, 0, (int)halo_bytes, 0x00020000);
        const int etop = (fr == 0) ? 0 : -4096, ebot = (fr == 15) ? 0 : -4096;
        f32x4 W0[2][2], W1[2][2], W2[2][2], BB[2][2];
#pragma unroll
        for (int bj = 0; bj < 2; ++bj)
#pragma unroll
            for (int n = 0; n < 2; ++n) { const float* wp = cw + bj * 5632 + f0 + 4 * n;
                W0[bj][n] = *(const f32x4*)(wp); W1[bj][n] = *(const f32x4*)(wp + 11264); W2[bj][n] = *(const f32x4*)(wp + 2 * 11264); BB[bj][n] = *(const f32x4*)(cb + bj * 5632 + f0 + 4 * n); }
#pragma unroll
        for (int bj = 0; bj < 2; ++bj)
#pragma unroll
            for (int n = 0; n < 2; ++n) {
                const f32x4 w0 = W0[bj][n], w1 = W1[bj][n], w2 = W2[bj][n], bb = BB[bj][n];
#pragma unroll
                for (int ai = 0; ai < 2; ++ai) {
                    const int hoff = (((4 * u.pm + 2 * ai + wr) * 2816 + ((bj * 5632 + f0) >> 2) + n) * 64);
                    f32x4 prev = z4;
#pragma unroll
                    for (int m = 0; m < 4; ++m) {
                        const f32x4 raw = acc[ai][bj][m][n];
                        f32x4 edge = bb;
                        if (m > 0) edge = edge + w0 * DPZ4(ROW_SHL15, prev);
                        if (m < 3) { const f32x4 nx = acc[ai][bj][m + 1][n]; edge = edge + w2 * DPZ4(ROW_SHR15, nx); }
                        const f32x4 c = w0 * DPZ4(ROW_SHR1, raw) + (w2 * DPZ4(ROW_SHL1, raw) + (w1 * raw + edge));
                        if (m == 0) { __builtin_amdgcn_raw_buffer_store_b128(__builtin_bit_cast(u32x4, raw), hrs, (hoff | etop), 0, 0); __builtin_amdgcn_raw_buffer_store_b128(__builtin_bit_cast(u32x4, c), hrs, ((hoff + 16) | etop), 0, 0); }
                        if (m == 3) { __builtin_amdgcn_raw_buffer_store_b128(__builtin_bit_cast(u32x4, raw), hrs, ((hoff + 32) | ebot), 0, 0); __builtin_amdgcn_raw_buffer_store_b128(__builtin_bit_cast(u32x4, c), hrs, ((hoff + 48) | ebot), 0, 0); }
                        acc[ai][bj][m][n] = c; prev = raw;
                        __builtin_amdgcn_sched_barrier(0);
                    }
                }
            }
#undef DPP4
#undef DPZ4
        const int row0 = u.pm * BM + wr * 64 + fr;
#pragma unroll
        for (int ai = 0; ai < 2; ++ai)
#pragma unroll
            for (int m = 0; m < 4; ++m) {
                u32x4 w;
                { const f32x4 g = acc[ai][0][m][0], v = acc[ai][1][m][0]; w.x = cvt_pk_bf16(silu_e(g[0]) * v[0], silu_e(g[1]) * v[1]); w.y = cvt_pk_bf16(silu_e(g[2]) * v[2], silu_e(g[3]) * v[3]); }
                { const f32x4 g = acc[ai][0][m][1], v = acc[ai][1][m][1]; w.z = cvt_pk_bf16(silu_e(g[0]) * v[0], silu_e(g[1]) * v[1]); w.w = cvt_pk_bf16(silu_e(g[2]) * v[2], silu_e(g[3]) * v[3]); }
                { const int r_ = row0 + ai * HALF + m * 16; *(u32x4*)(ACT + ((size_t)((r_ >> 8) * 88 + (f0 >> 6)) * 256 + (r_ & 255)) * 64 + (f0 & 63)) = w; }
            }
    }
};

template <bool COH_B = false> struct EpiConvGateT {
    static constexpr bool PERM = true, AFTER_DRAIN = false;
    bf16_t* OUT; float* HALO; const bf16_t* Bb; const float* cw; unsigned halo_bytes;
    __device__ __forceinline__ void operator()(f32x4 (&acc)[2][2][4][2], const Unit& u, int wr, int wc, int fr_, int fq_) const {
        int fr = fr_, fq = fq_; asm volatile("" : "+v"(fr), "+v"(fq));
        constexpr int ROW_SHL1 = 0x101, ROW_SHL15 = 0x10F, ROW_SHR1 = 0x111, ROW_SHR15 = 0x11F;
        const int f0 = u.pn * 128 + wc * 32 + 8 * fq;
#define DPZ4(CTRL, SRC) (f32x4){dppz<CTRL>((SRC)[0]), dppz<CTRL>((SRC)[1]), dppz<CTRL>((SRC)[2]), dppz<CTRL>((SRC)[3])}
        const f32x4 z4 = {0.f, 0.f, 0.f, 0.f};
        const __amdgpu_buffer_rsrc_t hrs = __builtin_amdgcn_make_buffer_rsrc(HALO, 0, (int)halo_bytes, 0x00020000);
        const int etop = (fr == 0) ? 0 : -4096, ebot = (fr == 15) ? 0 : -4096;
        f32x4 W0[2], W1[2], W2[2];
#pragma unroll
        for (int n = 0; n < 2; ++n) { W0[n] = *(const f32x4*)(cw + f0 + 4 * n); W1[n] = *(const f32x4*)(cw + 2048 + f0 + 4 * n); W2[n] = *(const f32x4*)(cw + 4096 + f0 + 4 * n); }
#pragma unroll
        for (int n = 0; n < 2; ++n) {
            const f32x4 w0 = W0[n], w1 = W1[n], w2 = W2[n];
#pragma unroll
            for (int ai = 0; ai < 2; ++ai) {
                const int hoff = (((4 * u.pm + 2 * ai + wr) * 512 + (f0 >> 2) + n) * 64);
#pragma unroll
                for (int m = 0; m < 4; ++m) acc[ai][0][m][n] = acc[ai][0][m][n] * acc[ai][1][m][n];
                f32x4 prev = z4;
#pragma unroll
                for (int m = 0; m < 4; ++m) {
                    const f32x4 raw = acc[ai][0][m][n];
                    f32x4 edge = z4;
                    if (m > 0) edge = edge + w0 * DPZ4(ROW_SHL15, prev);
                    if (m < 3) { const f32x4 nx = acc[ai][0][m + 1][n]; edge = edge + w2 * DPZ4(ROW_SHR15, nx); }
                    const f32x4 c = w0 * DPZ4(ROW_SHR1, raw) + (w2 * DPZ4(ROW_SHL1, raw) + (w1 * raw + edge));
                    if (m == 0) { __builtin_amdgcn_raw_buffer_store_b128(__builtin_bit_cast(u32x4, raw), hrs, (hoff | etop), 0, 0); __builtin_amdgcn_raw_buffer_store_b128(__builtin_bit_cast(u32x4, c), hrs, ((hoff + 16) | etop), 0, 0); }
                    if (m == 3) { __builtin_amdgcn_raw_buffer_store_b128(__builtin_bit_cast(u32x4, raw), hrs, ((hoff + 32) | ebot), 0, 0); __builtin_amdgcn_raw_buffer_store_b128(__builtin_bit_cast(u32x4, c), hrs, ((hoff + 48) | ebot), 0, 0); }
                    acc[ai][1][m][n] = c; prev = raw;
                    __builtin_amdgcn_sched_barrier(0);
                }
            }
        }
#undef DPZ4
        const int row0 = u.pm * BM + wr * 64 + fr;
#pragma unroll
        for (int ai = 0; ai < 2; ++ai)
#pragma unroll
            for (int m = 0; m < 4; ++m) { const size_t off = (size_t)(row0 + ai * HALF + m * 16) * 2048 + f0;
                u32x4 bw;
                if constexpr (COH_B) { const unsigned long long* bp_ = (const unsigned long long*)(Bb + off);
                    const unsigned long long q0 = __hip_atomic_load(bp_, __ATOMIC_RELAXED, __HIP_MEMORY_SCOPE_AGENT), q1 = __hip_atomic_load(bp_ + 1, __ATOMIC_RELAXED, __HIP_MEMORY_SCOPE_AGENT);
                    bw = (u32x4){(unsigned)q0, (unsigned)(q0 >> 32), (unsigned)q1, (unsigned)(q1 >> 32)}; }
                else bw = *(const u32x4*)(Bb + off);
                const f32x4 z0 = acc[ai][1][m][0], z1 = acc[ai][1][m][1];
                u32x4 w;
                w.x = cvt_pk_bf16(__uint_as_float(bw.x << 16) * z0[0], __uint_as_float(bw.x & 0xffff0000u) * z0[1]); w.y = cvt_pk_bf16(__uint_as_float(bw.y << 16) * z0[2], __uint_as_float(bw.y & 0xffff0000u) * z0[3]);
                w.z = cvt_pk_bf16(__uint_as_float(bw.z << 16) * z1[0], __uint_as_float(bw.z & 0xffff0000u) * z1[1]); w.w = cvt_pk_bf16(__uint_as_float(bw.w << 16) * z1[2], __uint_as_float(bw.w & 0xffff0000u) * z1[3]);
                *(u32x4*)(OUT + off) = w; }
    }
};

typedef EpiConvGateT<false> EpiConvGate;
struct EpiConvBoth {
    static constexpr bool PERM = true, AFTER_DRAIN = false;
    EpiBf16<0> eb; EpiConvGateT<true> eg; StaticOrder sb; unsigned* flags; unsigned* tmo; int G;
    __device__ __forceinline__ void operator()(f32x4 (&acc)[2][2][4][2], const Unit& u, int wr, int wc, int fr, int fq) const {
        if (u.pn < 8) { eb(acc, u, wr, wc, fr, fq); return; }
        { const int Lo = sb.block_of(u.pm, (u.pn - 8) >> 1), co = Lo % G, ro = Lo / G, lasto = (sb.nwg - 1 - co) / G;
          const unsigned need = lasto >= 3 ? (unsigned)((ro > 3 ? ro : 3) - 2) : 1u;
          unsigned* f = flags + 512 + co; unsigned sp = 0u;
          while ((unsigned)__builtin_amdgcn_readfirstlane((int)__hip_atomic_load(f, __ATOMIC_RELAXED, __HIP_MEMORY_SCOPE_AGENT)) < need) { __builtin_amdgcn_s_sleep(1);
              if ((++sp & 255u) == 0u) { if (__hip_atomic_load(tmo, __ATOMIC_RELAXED, __HIP_MEMORY_SCOPE_AGENT)) break; if (sp > (1u << 18)) { (void)__hip_atomic_fetch_add(tmo, 1u, __ATOMIC_RELAXED, __HIP_MEMORY_SCOPE_AGENT); break; } } }
        }
        Unit u2 = u; u2.pn = u.pn - 8; eg(acc, u2, wr, wc, fr, fq);
    }
};

struct EpiDqkv {
    static constexpr bool PERM = true, AFTER_DRAIN = false;
    bf16_t* CQ; bf16_t* CKV; float* KRRAW; float* SSQ; unsigned ssq_bytes;
    __device__ __forceinline__ void operator()(const f32x4 (&acc)[2][2][4][2], const Unit& u, int wr, int wc, int fr_, int fq_) const {
        int fr = fr_, fq = fq_; asm volatile("" : "+v"(fr), "+v"(fq));
        const int row0 = u.pm * BM + wr * 64 + fr;
        if (u.pn == 4) {
            if (wc < 2) {
#pragma unroll
                for (int ai = 0; ai < 2; ++ai)
#pragma unroll
                    for (int m = 0; m < 4; ++m) { float* p = KRRAW + (size_t)(row0 + ai * HALF + m * 16) * 64 + wc * 32 + 8 * fq;
                        *(f32x4*)p = acc[ai][0][m][0]; *(f32x4*)(p + 4) = acc[ai][0][m][1]; }
            }
            return;
        }
        bf16_t* base = (u.pn < 2 ? CQ : CKV); const int col0 = (u.pn & 1) * BM + wc * 32 + 8 * fq;
        const __amdgpu_buffer_rsrc_t srs = __builtin_amdgcn_make_buffer_rsrc(SSQ, 0, (int)ssq_bytes, 0x00020000);
        const int slot = (u.pn >> 1) * 8 + (u.pn & 1) * 4 + wc, lane = fr + 16 * fq, keep = (fq == 0) ? 0 : -4096;
#pragma unroll
        for (int ai = 0; ai < 2; ++ai)
#pragma unroll
            for (int m = 0; m < 4; ++m) { const int row = row0 + ai * HALF + m * 16; float s = 0.f;
#pragma unroll
                for (int bj = 0; bj < 2; ++bj) { const f32x4 v0 = acc[ai][bj][m][0], v1 = acc[ai][bj][m][1];
                    s += (v0[0] * v0[0] + v0[1] * v0[1]) + (v0[2] * v0[2] + v0[3] * v0[3]) + (v1[0] * v1[0] + v1[1] * v1[1]) + (v1[2] * v1[2] + v1[3] * v1[3]);
                    u32x4 w; w.x = cvt_pk_bf16(v0[0], v0[1]); w.y = cvt_pk_bf16(v0[2], v0[3]); w.z = cvt_pk_bf16(v1[0], v1[1]); w.w = cvt_pk_bf16(v1[2], v1[3]);
                    *(u32x4*)(base + (size_t)row * 512 + col0 + bj * HALF) = w; }
                s += __builtin_bit_cast(float, __builtin_amdgcn_ds_bpermute((lane ^ 16) << 2, __builtin_bit_cast(int, s)));
                s += __builtin_bit_cast(float, __builtin_amdgcn_ds_bpermute((lane ^ 32) << 2, __builtin_bit_cast(int, s)));
                __builtin_amdgcn_raw_buffer_store_b32(__builtin_bit_cast(unsigned, s), srs, ((row * 16 + slot) * 4) | keep, 0, 0); }
    }
};
struct EpiBf16Row {
    static constexpr bool PERM = true, AFTER_DRAIN = false;
    bf16_t* O; int ldc; int split_cols; size_t split_stride; const float* ssq; float eps; int hm_rows;
    __device__ __forceinline__ void operator()(const f32x4 (&acc)[2][2][4][2], const Unit& u, int wr, int wc, int fr_, int fq_) const {
        int fr = fr_, fq = fq_; asm volatile("" : "+v"(fr), "+v"(fq));
        const int row0 = u.pm * BM + wr * 64 + fr; int colt = u.pn * BM; bf16_t* base = O;
        if (split_cols) { const int t = colt / split_cols; base += (size_t)t * split_stride; colt -= t * split_cols; }
        const int col0 = colt + wc * 32 + 8 * fq;
#pragma unroll
        for (int ai = 0; ai < 2; ++ai)
#pragma unroll
            for (int m = 0; m < 4; ++m) { const int row = row0 + ai * HALF + m * 16;
                const f32x4 a = *(const f32x4*)(ssq + (size_t)row * 16), b = *(const f32x4*)(ssq + (size_t)row * 16 + 4);
                const float sc = 1.0f / sqrtf(((a[0] + a[1]) + (a[2] + a[3]) + (b[0] + b[1]) + (b[2] + b[3])) * (1.0f / 512.0f) + eps);
                bf16_t* rowp = hm_rows ? base + ((size_t)(colt >> 7) * hm_rows + row) * 128 + wc * 32 + 8 * fq : base + (size_t)row * ldc + col0;
                const size_t bstep = hm_rows ? (size_t)hm_rows * 128 : (size_t)HALF;
#pragma unroll
                for (int bj = 0; bj < 2; ++bj) { const f32x4 v0 = acc[ai][bj][m][0] * sc, v1 = acc[ai][bj][m][1] * sc;
                    u32x4 w; w.x = cvt_pk_bf16(v0[0], v0[1]); w.y = cvt_pk_bf16(v0[2], v0[3]); w.z = cvt_pk_bf16(v1[0], v1[1]); w.w = cvt_pk_bf16(v1[2], v1[3]);
                    *(u32x4*)(rowp + bj * bstep) = w; } }
    }
};
template <class Epi, class Sched, bool ALIGN_EPI = false, bool SP2 = false>
__device__ __forceinline__ void gemm_phase(PG8_LAS unsigned char* lds, const Gemm g, const Sched& S, const Epi& E, int wave_sgpr) {
    int tid_ = tid_from_wave(wave_sgpr);
    const int tid = tid_, wid = __builtin_amdgcn_readfirstlane(tid >> 6), lane = tid & 63, wr = wid >> 2, wc = wid & 3, fr = lane & 15, fq = lane >> 4;
    const int K = g.K, nt = K / BK;
    unsigned voffA[2], voffB[2];
#pragma unroll
    for (int i = 0; i < 2; ++i) { int R, C; stage_rc(tid * 16 + i * 8192, R, C); const int Rb = Epi::PERM ? ((R & ~31) + perm32(R & 31)) : R;
        voffA[i] = (unsigned)(R * (g.a_blocked ? BK : K) + C) * 2u; voffB[i] = (unsigned)(Rb * K + C) * 2u; }
    const size_t kstep = (size_t)(BK * 2);
    const size_t hstep = (size_t)HALF * K * 2;
    const size_t tstep = 2 * hstep;
    const size_t kstepA = g.a_blocked ? (size_t)(BM * BK * 2) : kstep, hstepA = g.a_blocked ? (size_t)(HALF * BK * 2) : hstep, tstepA = g.a_blocked ? (size_t)(K / BK) * (BM * BK * 2) : tstep;
#define PG8_AOFS(u_) ((size_t)(u_).pm * tstepA + (g.a_blocked ? (size_t)((u_).kofs / BK) * kstepA : (size_t)(u_).kofs * 2))
    const unsigned ldsw = (unsigned)wid * 1024u;
    const int aoff = lds_byte(wr * 64 + fr, fq * 8), boff = lds_byte(wc * 32 + fr, fq * 8);
#define PG8_SA(b, h) (((b) * 2 + (h)) * HTB)
#define PG8_SB(b, h) ((4 + (b) * 2 + (h)) * HTB)
#define PG8_STAGE(bufoff, gbase, voff) do { _Pragma("unroll") for (int _i = 0; _i < 2; ++_i) \
        __builtin_amdgcn_global_load_lds((const unsigned*)((const char*)(gbase) + (voff)[_i]), (PG8_LAS unsigned*)(lds + (bufoff) + ldsw + _i * 8192), 16, 0, 0); } while (0)
#define PG8_LDA(dst, b, h) do { _Pragma("unroll") for (int m = 0; m < 4; ++m) _Pragma("unroll") for (int k = 0; k < 2; ++k) dst[m][k] = *(const PG8_LAS bf16x8*)(lds + PG8_SA(b, h) + aoff + m * 2048 + k * 1024); } while (0)
#define PG8_LDB(dst, b, h) do { _Pragma("unroll") for (int n = 0; n < 2; ++n) _Pragma("unroll") for (int k = 0; k < 2; ++k) dst[n][k] = *(const PG8_LAS bf16x8*)(lds + PG8_SB(b, h) + boff + n * 2048 + k * 1024); } while (0)
#define PG8_MMA(ai, bj, At, Bt) do { __builtin_amdgcn_s_setprio(1); _Pragma("unroll") for (int m = 0; m < 4; ++m) _Pragma("unroll") for (int n = 0; n < 2; ++n) _Pragma("unroll") for (int k = 0; k < 2; ++k) \
        acc[ai][bj][m][n] = __builtin_amdgcn_mfma_f32_16x16x32_bf16(Bt[n][k], At[m][k], acc[ai][bj][m][n], 0, 0, 0); __builtin_amdgcn_s_setprio(0); } while (0)
#define PG8_WAIT_V(n) asm volatile("s_waitcnt vmcnt(" #n ")" ::: "memory")
#define PG8_WAIT_L(n) asm volatile("s_waitcnt lgkmcnt(" #n ")" ::: "memory")
#define PG8_BAR __builtin_amdgcn_s_barrier()
#define PG8_SCHED __builtin_amdgcn_sched_barrier(0)
    Unit cur, nxt; int ui = 0;
    if (!S.next(0, cur)) return;
    f32x4 acc[2][2][4][2];
#pragma unroll
    for (int a = 0; a < 2; ++a)
#pragma unroll
        for (int b = 0; b < 2; ++b)
#pragma unroll
            for (int m = 0; m < 4; ++m)
#pragma unroll
                for (int n = 0; n < 2; ++n) acc[a][b][m][n] = (f32x4){0.f, 0.f, 0.f, 0.f};
    bf16x8 At[4][2], B0[2][2], B1[2][2];
    const char* cA = (const char*)g.A + PG8_AOFS(cur); const char* cB = (const char*)g.Bt + (size_t)cur.pn * tstep + (size_t)cur.kofs * 2;
    int cnt = cur.nt ? cur.nt : nt;
    S.a_ready(cur);
    if constexpr (SP2) {
        PG8_STAGE(PG8_SB(0, 0), cB, voffB); PG8_STAGE(PG8_SB(0, 1), cB + hstep, voffB); PG8_STAGE(PG8_SA(0, 0), cA, voffA); PG8_STAGE(PG8_SA(0, 1), cA + hstepA, voffA);
        if (wr == 1) PG8_BAR;
        PG8_WAIT_V(2); PG8_BAR;
        PG8_STAGE(PG8_SB(1, 0), cB + kstep, voffB); PG8_STAGE(PG8_SA(1, 0), cA + kstepA, voffA); PG8_STAGE(PG8_SB(1, 1), cB + hstep + kstep, voffB);
        PG8_WAIT_V(6); PG8_BAR;
    } else {
        PG8_STAGE(PG8_SB(0, 0), cB, voffB); PG8_STAGE(PG8_SA(0, 0), cA, voffA); PG8_STAGE(PG8_SB(0, 1), cB + hstep, voffB); PG8_STAGE(PG8_SA(0, 1), cA + hstepA, voffA);
        if (wr == 1) PG8_BAR;
        PG8_WAIT_V(4); PG8_BAR;
        PG8_STAGE(PG8_SB(1, 0), cB + kstep, voffB); PG8_STAGE(PG8_SA(1, 0), cA + kstepA, voffA); PG8_STAGE(PG8_SB(1, 1), cB + hstep + kstep, voffB);
        PG8_WAIT_V(6); PG8_BAR;
    }
    for (;;) {
        const bool has_next = S.next(ui + 1, nxt);
        const char* nA = has_next ? (const char*)g.A + PG8_AOFS(nxt) : cA; const char* nB = has_next ? (const char*)g.Bt + (size_t)nxt.pn * tstep + (size_t)nxt.kofs * 2 : cB;
        for (int t = 0; t < cnt; t += 2) {
            const bool last = (t == cnt - 2);
            const char* a1 = cA + (size_t)(t + 1) * kstepA;
            const char* a2 = last ? nA : cA + (size_t)(t + 2) * kstepA; const char* b2 = last ? nB : cB + (size_t)(t + 2) * kstep;
            const char* a3 = a2 + kstepA; const char* b3 = b2 + kstep;
            if (last && has_next) S.a_ready(nxt);
            if constexpr (SP2) {
            PG8_LDB(B0, 0, 0); PG8_LDB(B1, 0, 1); PG8_SCHED; PG8_LDA(At, 0, 0); PG8_STAGE(PG8_SA(1, 1), a1 + hstepA, voffA);
            PG8_WAIT_V(8); PG8_WAIT_L(0); PG8_BAR; PG8_MMA(0, 0, At, B0); PG8_MMA(0, 1, At, B1); PG8_BAR; PG8_SCHED;
            PG8_LDA(At, 0, 1); PG8_STAGE(PG8_SB(0, 0), b2, voffB); PG8_STAGE(PG8_SB(0, 1), b2 + hstep, voffB); PG8_STAGE(PG8_SA(0, 0), a2, voffA);
            PG8_WAIT_V(8); PG8_WAIT_L(0); PG8_BAR; PG8_MMA(1, 0, At, B0); PG8_MMA(1, 1, At, B1); PG8_BAR; PG8_SCHED;
            PG8_LDB(B0, 1, 0); PG8_LDB(B1, 1, 1); PG8_SCHED; PG8_LDA(At, 1, 0); PG8_STAGE(PG8_SA(0, 1), a2 + hstepA, voffA);
            PG8_WAIT_V(8); PG8_WAIT_L(0); PG8_BAR; PG8_MMA(0, 0, At, B0); PG8_MMA(0, 1, At, B1); PG8_BAR; PG8_SCHED;
            PG8_LDA(At, 1, 1); PG8_STAGE(PG8_SB(1, 0), b3, voffB); PG8_STAGE(PG8_SB(1, 1), b3 + hstep, voffB); PG8_STAGE(PG8_SA(1, 0), a3, voffA);
            PG8_WAIT_V(8); PG8_WAIT_L(0); PG8_BAR; PG8_MMA(1, 0, At, B0); PG8_MMA(1, 1, At, B1); PG8_BAR; PG8_SCHED;
            } else {
            PG8_LDB(B0, 0, 0); PG8_SCHED; PG8_LDA(At, 0, 0); PG8_STAGE(PG8_SA(1, 1), a1 + hstepA, voffA);
            PG8_WAIT_L(8); PG8_BAR; PG8_WAIT_L(0); PG8_MMA(0, 0, At, B0); PG8_BAR; PG8_SCHED;
            PG8_LDB(B1, 0, 1); PG8_STAGE(PG8_SB(0, 0), b2, voffB);
            PG8_BAR; PG8_WAIT_L(0); PG8_MMA(0, 1, At, B1); PG8_BAR;
            PG8_LDA(At, 0, 1); PG8_STAGE(PG8_SA(0, 0), a2, voffA);
            PG8_BAR; PG8_WAIT_L(0); PG8_MMA(1, 0, At, B0); PG8_BAR; PG8_SCHED;
            PG8_STAGE(PG8_SB(0, 1), b2 + hstep, voffB);
            PG8_WAIT_V(6); PG8_BAR; PG8_MMA(1, 1, At, B1); PG8_BAR;
            PG8_LDB(B0, 1, 0); PG8_SCHED; PG8_LDA(At, 1, 0); PG8_STAGE(PG8_SA(0, 1), a2 + hstepA, voffA);
            PG8_WAIT_L(8); PG8_BAR; PG8_WAIT_L(0); PG8_MMA(0, 0, At, B0); PG8_BAR; PG8_SCHED;
            PG8_LDB(B1, 1, 1); PG8_STAGE(PG8_SB(1, 0), b3, voffB);
            PG8_BAR; PG8_WAIT_L(0); PG8_MMA(0, 1, At, B1); PG8_BAR;
            PG8_LDA(At, 1, 1); PG8_STAGE(PG8_SA(1, 0), a3, voffA);
            PG8_BAR; PG8_WAIT_L(0); PG8_MMA(1, 0, At, B0); PG8_BAR; PG8_SCHED;
            PG8_STAGE(PG8_SB(1, 1), b3 + hstep, voffB);
            PG8_WAIT_V(6); PG8_BAR; PG8_MMA(1, 1, At, B1); PG8_BAR;
            }
        }
        if constexpr (ALIGN_EPI) { if (wr == 0) PG8_BAR; }
        if constexpr (!Epi::AFTER_DRAIN) { E(acc, cur, wr, wc, fr, fq); S.done(cur); }
        if (!has_next) break;
#pragma unroll
        for (int a = 0; a < 2; ++a)
#pragma unroll
            for (int b = 0; b < 2; ++b)
#pragma unroll
                for (int m = 0; m < 4; ++m)
#pragma unroll
                    for (int n = 0; n < 2; ++n) acc[a][b][m][n] = (f32x4){0.f, 0.f, 0.f, 0.f};
        cur = nxt; cA = nA; cB = nB; ++ui; cnt = cur.nt ? cur.nt : nt;
        if constexpr (ALIGN_EPI) { if (wr == 1) PG8_BAR; }
    }
    PG8_WAIT_V(0);
    if constexpr (!ALIGN_EPI) { if (wr == 0) PG8_BAR; }
    PG8_BAR;
    if constexpr (Epi::AFTER_DRAIN) { E.fused(acc, cur, wr, wc, fr, fq, lds, wid, lane); S.done(cur); }
#undef PG8_AOFS
#undef PG8_SA
#undef PG8_SB
#undef PG8_STAGE
#undef PG8_LDA
#undef PG8_LDB
#undef PG8_MMA
#undef PG8_WAIT_V
#undef PG8_WAIT_L
#undef PG8_BAR
#undef PG8_SCHED
}
}

namespace att {
#define ATT_LAS __attribute__((address_space(3)))
typedef unsigned short bf16_t;
using bf16x8 = __attribute__((ext_vector_type(8))) short;
using s16x4  = __attribute__((ext_vector_type(4))) short;
using f32x16 = __attribute__((ext_vector_type(16))) float;
using f32x2  = __attribute__((ext_vector_type(2))) float;
using f32x4  = __attribute__((ext_vector_type(4))) float;
using u32x4  = __attribute__((ext_vector_type(4))) unsigned;
constexpr int NW = 8, QBLK = 32, KVBLK = 64;
constexpr float SCALE = 0.07216878364870323f;
constexpr float THR = 8.f;
constexpr int SDEPTH = ATT_SDEPTH;
constexpr int LDQ = 3072, LDK = 128, LDKR = 64, LDO = 2048;
constexpr int SHM_V = KVBLK * 128 * 2, SHM_K = KVBLK * 128 * 2, SHM_KR = KVBLK * 64 * 2;
constexpr int OFF_V = 0, OFF_K = 2 * SHM_V, OFF_KR = OFF_K + 2 * SHM_K, OFF_WS = OFF_KR + 2 * SHM_KR, OFF_QR = OFF_WS + NW * 64 * 4, ATT_LDS_BYTES = OFF_QR + NW * 4096;
#define KSWZ(row, colB) ((row) * 256 + ((colB) ^ (((row) & 7) << 4)))
#define KRSWZ(row, colB) ((row) * 128 + ((colB) ^ ((((row) >> 1) & 7) << 4)))
#define SBAR() __builtin_amdgcn_sched_barrier(0)
__device__ __forceinline__ int crow(int r, int hi) { return (r & 3) + 8 * (r >> 2) + 4 * hi; }
__device__ __forceinline__ unsigned cvtpk(float lo, float hi) { unsigned r; asm volatile("v_cvt_pk_bf16_f32 %0, %1, %2" : "=v"(r) : "v"(lo), "v"(hi)); return r; }
__device__ __forceinline__ float bf2f(unsigned short b) { return __uint_as_float(((unsigned)b) << 16); }

__device__ __forceinline__ void partialSM(f32x16& p0, f32x16& p1, float& m_reg, float& mn, float& alpha) {
  constexpr float C = SCALE * 1.4426950408889634f;
  float pmax = p0[0];
#pragma unroll
  for (int r = 1; r < 16; ++r) pmax = fmaxf(pmax, p0[r]);
#pragma unroll
  for (int r = 0; r < 16; ++r) pmax = fmaxf(pmax, p1[r]);
  { auto rr = __builtin_amdgcn_permlane32_swap(__float_as_uint(pmax), __float_as_uint(pmax), false, false);
    pmax = fmaxf(__uint_as_float(rr[0]), __uint_as_float(rr[1])); }
  if (__builtin_expect(__all(pmax - m_reg <= THR / SCALE), 1)) { mn = m_reg; alpha = 1.f; }
  else { mn = fmaxf(m_reg, pmax); alpha = __builtin_amdgcn_exp2f((m_reg - mn) * C); m_reg = mn; }
  float mnC = -mn * C;
#pragma unroll
  for (int r = 0; r < 16; ++r) p0[r] = fmaf(p0[r], C, mnC);
#pragma unroll
  for (int r = 0; r < 16; ++r) p1[r] = fmaf(p1[r], C, mnC);
#pragma unroll
  for (int r = 0; r < 16; ++r) p0[r] = __builtin_amdgcn_exp2f(p0[r]);
}
__device__ __forceinline__ void finishSM(f32x16& p0, f32x16& p1, float alpha, float& l_reg, bf16x8& pa0, bf16x8& pa1, bf16x8& pa2, bf16x8& pa3) {
#pragma unroll
  for (int r = 0; r < 16; ++r) p1[r] = __builtin_amdgcn_exp2f(p1[r]);
  float ps = 0;
#pragma unroll
  for (int r = 0; r < 16; ++r) ps += p0[r];
#pragma unroll
  for (int r = 0; r < 16; ++r) ps += p1[r];
  { auto rr = __builtin_amdgcn_permlane32_swap(__float_as_uint(ps), __float_as_uint(ps), false, false);
    ps = __uint_as_float(rr[0]) + __uint_as_float(rr[1]); }
  l_reg = l_reg * alpha + ps;
#define PK4(P, BASE, OUT) do { unsigned a0 = cvtpk(P[BASE + 0], P[BASE + 1]), a1 = cvtpk(P[BASE + 2], P[BASE + 3]);   \
    unsigned b0 = cvtpk(P[BASE + 4], P[BASE + 5]), b1 = cvtpk(P[BASE + 6], P[BASE + 7]);                              \
    auto r0 = __builtin_amdgcn_permlane32_swap(a0, b0, false, false); auto r1 = __builtin_amdgcn_permlane32_swap(a1, b1, false, false); \
    u32x4 w = {r0[0], r1[0], r0[1], r1[1]}; OUT = *reinterpret_cast<bf16x8*>(&w); } while (0)
  PK4(p0, 0, pa0); PK4(p0, 8, pa1); PK4(p1, 0, pa2); PK4(p1, 8, pa3);
#undef PK4
}
__device__ __forceinline__ void qkt(f32x16& p0, f32x16& p1, const ATT_LAS char* Ks, const ATT_LAS char* Kr, const ATT_LAS char* Qr, const bf16x8* qr, int r32, int hi) {
  p0 = f32x16{}; p1 = f32x16{};
#pragma unroll
  for (int d0 = 0; d0 < 8; ++d0) { const int cb = (d0 * 16 + hi * 8) * 2;
    bf16x8 b0 = *reinterpret_cast<const ATT_LAS bf16x8*>(Ks + KSWZ(r32, cb));
    bf16x8 b1 = *reinterpret_cast<const ATT_LAS bf16x8*>(Ks + KSWZ(32 + r32, cb));
    p0 = __builtin_amdgcn_mfma_f32_32x32x16_bf16(b0, qr[d0], p0, 0, 0, 0);
    p1 = __builtin_amdgcn_mfma_f32_32x32x16_bf16(b1, qr[d0], p1, 0, 0, 0); }
#pragma unroll
  for (int d1 = 0; d1 < 4; ++d1) { const int cb = (d1 * 16 + hi * 8) * 2;
    bf16x8 b0 = *reinterpret_cast<const ATT_LAS bf16x8*>(Kr + KRSWZ(r32, cb));
    bf16x8 b1 = *reinterpret_cast<const ATT_LAS bf16x8*>(Kr + KRSWZ(32 + r32, cb));
    bf16x8 qq = *reinterpret_cast<const ATT_LAS bf16x8*>(Qr + KRSWZ(r32, cb));
    p0 = __builtin_amdgcn_mfma_f32_32x32x16_bf16(b0, qq, p0, 0, 0, 0);
    p1 = __builtin_amdgcn_mfma_f32_32x32x16_bf16(b1, qq, p1, 0, 0, 0); }
}
__device__ __forceinline__ int v_st(int k, int c) { const int kk = (k & ~0xC) | ((k & 4) << 1) | ((k & 8) >> 1); return ((kk >> 3) * 4 + (c >> 5)) * 512 + ((kk & 7) * 32 + (c & 31)) * 2; }
__device__ __forceinline__ int v_rd_base(int lane) { return ((lane & 3) << 3) | (((lane >> 2) & 3) << 6) | (((lane >> 4) & 1) << 5) | (((lane >> 5) & 1) << 8); }
constexpr int v_rd_off(int d0, int ks, int half) { return d0 * 512 + ks * 4096 + half * 2048; }
template <int OFF> __device__ __forceinline__ s16x4 tr_read(int vb) {
  s16x4 r; asm volatile("ds_read_b64_tr_b16 %0, %1 offset:%2" : "=&v"(r) : "v"(vb), "i"(OFF) : "memory"); return r;
}
template <int D0> __device__ __forceinline__ void pv_one(f32x16& od, int vb, bf16x8 pa0, bf16x8 pa1, bf16x8 pa2, bf16x8 pa3) {
  const s16x4 l0 = tr_read<v_rd_off(D0, 0, 0)>(vb), h0 = tr_read<v_rd_off(D0, 0, 1)>(vb), l1 = tr_read<v_rd_off(D0, 1, 0)>(vb), h1 = tr_read<v_rd_off(D0, 1, 1)>(vb);
  const s16x4 l2 = tr_read<v_rd_off(D0, 2, 0)>(vb), h2 = tr_read<v_rd_off(D0, 2, 1)>(vb), l3 = tr_read<v_rd_off(D0, 3, 0)>(vb), h3 = tr_read<v_rd_off(D0, 3, 1)>(vb);
  asm volatile("s_waitcnt lgkmcnt(0)" ::: "memory"); SBAR();
#define PK(L, H) (bf16x8){L[0], L[1], L[2], L[3], H[0], H[1], H[2], H[3]}
  od = __builtin_amdgcn_mfma_f32_32x32x16_bf16(pa0, PK(l0, h0), od, 0, 0, 0);
  od = __builtin_amdgcn_mfma_f32_32x32x16_bf16(pa1, PK(l1, h1), od, 0, 0, 0);
  od = __builtin_amdgcn_mfma_f32_32x32x16_bf16(pa2, PK(l2, h2), od, 0, 0, 0);
  od = __builtin_amdgcn_mfma_f32_32x32x16_bf16(pa3, PK(l3, h3), od, 0, 0, 0);
#undef PK
}
__device__ __forceinline__ void pv_d0(f32x16* o, int vb, bf16x8 pa0, bf16x8 pa1, bf16x8 pa2, bf16x8 pa3) {
  pv_one<0>(o[0], vb, pa0, pa1, pa2, pa3); pv_one<1>(o[1], vb, pa0, pa1, pa2, pa3); pv_one<2>(o[2], vb, pa0, pa1, pa2, pa3); pv_one<3>(o[3], vb, pa0, pa1, pa2, pa3);
}

__device__ __forceinline__ void attn_unit(const bf16_t* Qb, const bf16_t* Kh, const bf16_t* Vh, const bf16_t* KRb, bf16_t* Ob,
                                          int xrow0, int nx, int crow0, int NT, int rope, int pos0, const f32x2* ropeR, const f32x2* ropeC, ATT_LAS char* lds, int wave_sgpr) {
  int tid_ = tid_from_wave(wave_sgpr);
  const int tid = tid_, wid = tid >> 6, lane = tid & 63, r32 = lane & 31, hi = lane >> 5;
  ATT_LAS char* V_lds = lds + OFF_V; ATT_LAS char* K_lds = lds + OFF_K; ATT_LAS char* KR_lds = lds + OFF_KR;
  ATT_LAS float* ws = (ATT_LAS float*)(lds + OFF_WS) + wid * 64; ATT_LAS float* li_l = ws; ATT_LAS float* al_l = ws + 32;
  float m_reg = -1e30f, l_reg = 0; f32x16 o[4] = {}; bf16x8 qr[8];
  ATT_LAS char* QR_lds = lds + OFF_QR + wid * 4096;
  const bf16_t* Qw = Qb + (long)(wid * QBLK + r32) * LDQ + hi * 8;
#pragma unroll
  for (int d0 = 0; d0 < 8; ++d0) qr[d0] = *reinterpret_cast<const bf16x8*>(Qw + d0 * 16);
  {
  bf16x8 q8 = *reinterpret_cast<const bf16x8*>(Qw + 8 * 16), q9 = *reinterpret_cast<const bf16x8*>(Qw + 9 * 16), q10 = *reinterpret_cast<const bf16x8*>(Qw + 10 * 16), q11 = *reinterpret_cast<const bf16x8*>(Qw + 11 * 16);
  if (rope) {
    const int pos = pos0 + wid * QBLK + r32; const f32x2* tr = ropeR + (pos >> 6) * 16 + hi * 8; const f32x2* tc = ropeC + (pos & 63) * 16 + hi * 8;
    bf16x8 n8, n9, n10, n11;
#pragma unroll
    for (int e = 0; e < 8; ++e) {
      const f32x2 cr = tr[e], cc = tc[e];
      const float a1 = bf2f((unsigned short)q8[e]), a2 = bf2f((unsigned short)q9[e]), b1 = bf2f((unsigned short)q10[e]), b2 = bf2f((unsigned short)q11[e]);
      const unsigned w0 = cvtpk(a1 * cr.x - a2 * cr.y, a2 * cr.x + a1 * cr.y), w1 = cvtpk(b1 * cc.x - b2 * cc.y, b2 * cc.x + b1 * cc.y);
      n8[e] = (short)(w0 & 0xffffu); n9[e] = (short)(w0 >> 16); n10[e] = (short)(w1 & 0xffffu); n11[e] = (short)(w1 >> 16);
    }
    q8 = n8; q9 = n9; q10 = n10; q11 = n11;
  }
  *(ATT_LAS bf16x8*)(QR_lds + KRSWZ(r32, (0 * 16 + hi * 8) * 2)) = q8; *(ATT_LAS bf16x8*)(QR_lds + KRSWZ(r32, (1 * 16 + hi * 8) * 2)) = q9;
  *(ATT_LAS bf16x8*)(QR_lds + KRSWZ(r32, (2 * 16 + hi * 8) * 2)) = q10; *(ATT_LAS bf16x8*)(QR_lds + KRSWZ(r32, (3 * 16 + hi * 8) * 2)) = q11;
  }
  const int sr = tid >> 4, sc = (tid & 15) * 8, vst0 = v_st(sr, sc), vst1 = v_st(32 + sr, sc);
  const int krs = tid >> 3, krc = (tid & 7) * 8, krst = KRSWZ(krs, krc * 2);
  const int vb0 = (int)(uintptr_t)V_lds + v_rd_base(lane);
  struct { bf16x8 vs0, vs1, ks0, ks1, kr; } sr_[SDEPTH];
#define TROW(j) ((j) < nx ? (long)xrow0 + (long)(j) * KVBLK : (long)crow0 + (long)((j) - nx) * KVBLK)
#define SLOAD(i, j) do { const long _k0 = TROW(j); \
    sr_[i].vs0 = *reinterpret_cast<const bf16x8*>(&Vh[(_k0 + sr) * LDK + sc]); sr_[i].vs1 = *reinterpret_cast<const bf16x8*>(&Vh[(_k0 + 32 + sr) * LDK + sc]); \
    sr_[i].ks0 = *reinterpret_cast<const bf16x8*>(&Kh[(_k0 + sr) * LDK + sc]); sr_[i].ks1 = *reinterpret_cast<const bf16x8*>(&Kh[(_k0 + 32 + sr) * LDK + sc]); \
    sr_[i].kr = *reinterpret_cast<const bf16x8*>(&KRb[(_k0 + krs) * LDKR + krc]); } while (0)
#define SWRITE(b, i) do { *(ATT_LAS bf16x8*)(V_lds + (b) * SHM_V + vst0) = sr_[i].vs0;          \
    *(ATT_LAS bf16x8*)(V_lds + (b) * SHM_V + vst1) = sr_[i].vs1; const int kc = sc * 2;               \
    *(ATT_LAS bf16x8*)(K_lds + (b) * SHM_K + KSWZ(sr, kc)) = sr_[i].ks0;                       \
    *(ATT_LAS bf16x8*)(K_lds + (b) * SHM_K + KSWZ(32 + sr, kc)) = sr_[i].ks1;                  \
    *(ATT_LAS bf16x8*)(KR_lds + (b) * SHM_KR + krst) = sr_[i].kr; } while (0)
#define SWAIT() do { if constexpr (SDEPTH == 2) asm volatile("s_waitcnt vmcnt(5)" ::: "memory"); else asm volatile("s_waitcnt vmcnt(0)" ::: "memory"); } while (0)
#define RESC(a) do { if (__any((a) < 1.f)) { if (hi == 0) al_l[r32] = (a); asm volatile("s_waitcnt lgkmcnt(0)" ::: "memory"); \
    _Pragma("unroll") for (int d = 0; d < 4; ++d) _Pragma("unroll") for (int r = 0; r < 16; ++r) o[d][r] *= al_l[crow(r, hi)]; } } while (0)
  f32x16 pA0, pA1, pB0, pB1; float mnA, mnB, alA, alB; bf16x8 pa0, pa1, pa2, pa3;
  constexpr int SE = 0, SO = SDEPTH - 1;
  SLOAD(SE, 0); asm volatile("s_waitcnt vmcnt(0)" ::: "memory"); SWRITE(0, SE); __syncthreads();
  qkt(pA0, pA1, K_lds, KR_lds, QR_lds, qr, r32, hi); partialSM(pA0, pA1, m_reg, mnA, alA);
  SLOAD(SO, 1); if constexpr (SDEPTH == 2) { if (2 < NT) SLOAD(SE, 2); }
  SWAIT(); SWRITE(1, SO); __syncthreads();
  for (int j = 1; j + 1 < NT; j += 2) {
    SBAR(); qkt(pB0, pB1, K_lds + SHM_K, KR_lds + SHM_KR, QR_lds, qr, r32, hi);
    finishSM(pA0, pA1, alA, l_reg, pa0, pa1, pa2, pa3); SBAR();
    SLOAD(SO, j + SDEPTH); SBAR();
    pv_d0(o, vb0, pa0, pa1, pa2, pa3); partialSM(pB0, pB1, m_reg, mnB, alB);
    __syncthreads(); SWAIT(); SWRITE(0, SE);
    RESC(alB); __syncthreads();
    SBAR(); qkt(pA0, pA1, K_lds, KR_lds, QR_lds, qr, r32, hi);
    finishSM(pB0, pB1, alB, l_reg, pa0, pa1, pa2, pa3); SBAR();
    if (SDEPTH == 1 || j + 3 < NT) SLOAD(SE, j + 1 + SDEPTH); SBAR();
    pv_d0(o, vb0 + SHM_V, pa0, pa1, pa2, pa3); partialSM(pA0, pA1, m_reg, mnA, alA);
    __syncthreads(); SWAIT(); SWRITE(1, SO);
    RESC(alA); __syncthreads();
  }
  SBAR(); qkt(pB0, pB1, K_lds + SHM_K, KR_lds + SHM_KR, QR_lds, qr, r32, hi);
  finishSM(pA0, pA1, alA, l_reg, pa0, pa1, pa2, pa3); SBAR();
  pv_d0(o, vb0, pa0, pa1, pa2, pa3); partialSM(pB0, pB1, m_reg, mnB, alB);
  __syncthreads(); RESC(alB);
  finishSM(pB0, pB1, alB, l_reg, pa0, pa1, pa2, pa3); SBAR();
  pv_d0(o, vb0 + SHM_V, pa0, pa1, pa2, pa3);
  {
  int te = tid_from_wave(wave_sgpr);
  const int widE = te >> 6, r32E = te & 31, hiE = (te >> 5) & 1;
  ATT_LAS float* liE = (ATT_LAS float*)(lds + OFF_WS) + widE * 64;
  if (hiE == 0) liE[r32E] = l_reg; asm volatile("s_waitcnt lgkmcnt(0)" ::: "memory");
  float rli[16];
#pragma unroll
  for (int r = 0; r < 16; ++r) rli[r] = __builtin_amdgcn_rcpf(liE[crow(r, hiE)]);
  bf16_t* Ow = Ob + (long)(widE * QBLK) * LDO + r32E;
#pragma unroll
  for (int r = 0; r < 16; ++r) { const int orow = crow(r, hiE);
#pragma unroll
    for (int d0 = 0; d0 < 4; ++d0) { const unsigned w = cvtpk(o[d0][r] * rli[r], 0.f); Ow[(long)orow * LDO + d0 * 32] = (bf16_t)(w & 0xffffu); } }
  }
  __syncthreads();
#undef TROW
#undef SLOAD
#undef SWRITE
#undef SWAIT
#undef RESC
}
#undef KSWZ
#undef KRSWZ
#undef SBAR
}

constexpr int NWAVES = 8;
constexpr int DM = 2048, BATCH = 2, SEQ = 16384, CTXL = 256, DEPTH = 4, DFF = 5632, NH = 16;
constexpr int M_X = BATCH * SEQ;
constexpr int M_C = BATCH * CTXL;
constexpr int M_T = M_X + M_C;
constexpr int QLR = 512, KVLR = 512, ROPE_D = 64, NDQKV = 1280;
constexpr float LN_EPS = 1e-5f, RMS_EPS = 1e-6f;
constexpr float DN_ALPHA = 1.6817928305074290f;

constexpr size_t MiB = 1u << 20;
constexpr size_t WS_CTL = 0, CTL_ZERO_BYTES = 1 * MiB;
constexpr size_t WS_MOD = 1 * MiB;
constexpr size_t WS_ROPER = WS_MOD + 640 * 1024, WS_ROPEC = WS_MOD + 680 * 1024;
constexpr size_t WS_W = 2 * MiB;
constexpr size_t W_CONV_STRIDE = 32 * MiB, W_WIN = 0, W_WOUT = 24 * MiB;
constexpr size_t W_MLA_BASE = 64 * MiB, W_MLA_STRIDE = 20 * MiB, W_DQKV = 0, W_UQ = 5 * MiB, W_UKV = 8 * MiB, W_WO = 12 * MiB;
constexpr size_t W_FFN_BASE = 104 * MiB, W_FFN_STRIDE = 66 * MiB, W_UP = 0, W_DOWN = 44 * MiB;
constexpr size_t WS_X32C = 370 * MiB;
constexpr size_t WS_BIG = 374 * MiB;
constexpr size_t BIG_BB = 585 * MiB, BIG_HALOC = 132 * MiB, BIG_GATED = 0;
constexpr size_t BIG_KRRAW = 130 * MiB, BIG_SSQ = 140 * MiB;
constexpr size_t BIG_QKVC = 0, BIG_CQ = 163 * MiB, BIG_CKV = 196 * MiB, BIG_KR = 229 * MiB, BIG_Q = 234 * MiB, BIG_K = 429 * MiB, BIG_V = 559 * MiB, BIG_O = 0;
constexpr size_t BIG_CPART = 600 * MiB;
constexpr size_t BIG_HALO = 132 * MiB, BIG_ACT = 234 * MiB;
constexpr size_t WS_ACT = 1089 * MiB;
constexpr size_t WS_STATS = 1220 * MiB;
constexpr size_t WS_T16 = 1222 * MiB;
constexpr size_t WS_END = 1447 * MiB;
static_assert(WS_BIG + 715 * MiB <= WS_ACT && WS_ACT + (size_t)M_T * DM * 2 <= WS_END && BIG_HALO + (size_t)(M_T / 64) * 4 * 11264 * 4 <= BIG_ACT && BIG_ACT + (size_t)M_T * DFF * 2 <= 715 * MiB, "d_ws map");
static_assert(BIG_BB + (size_t)M_T * DM * 2 <= 715 * MiB && BIG_GATED + (size_t)M_T * DM * 2 <= BIG_HALOC && BIG_HALO >= BIG_O + (size_t)M_T * DM * 2, "mixer overlay");
static_assert(BIG_CPART >= BIG_ACT + (size_t)M_T * DFF * 2 && BIG_CPART >= BIG_GATED + (size_t)M_T * DM * 2 && BIG_CPART + (size_t)11 * M_C * DM * 4 <= 715 * MiB, "context planes");
static_assert(BIG_V + (size_t)M_T * 2048 * 2 <= 715 * MiB && BIG_KR + (size_t)M_T * 64 * 2 <= BIG_Q && BIG_QKVC + (size_t)M_T * NDQKV * 4 <= BIG_CQ, "MLA overlay");
constexpr int CW_RLF = 32768, RLF_STRIDE = 1024;
constexpr int CW_TMO = 0, CW_CODE = 1, CW_BAR = 4096, CW_CVF = 20480;

constexpr int RING_OFF = 0, RING_BYTES = 131072;
constexpr int LDSCTL_OFF = RING_BYTES, MISC_OFF = LDSCTL_OFF + 320;
constexpr int LDS_BYTES = 147456;
static_assert(att::ATT_LDS_BYTES <= RING_BYTES, "attention LDS");

#define GAS __attribute__((address_space(1)))
#define LAS __attribute__((address_space(3)))
typedef unsigned short bf16;
typedef unsigned v4u __attribute__((ext_vector_type(4)));
typedef unsigned v2u __attribute__((ext_vector_type(2)));
typedef float f32x4 __attribute__((ext_vector_type(4)));
typedef float f32x2 __attribute__((ext_vector_type(2)));
typedef short bf16x8 __attribute__((ext_vector_type(8)));
typedef _Float16 f16x8 __attribute__((ext_vector_type(8)));
typedef GAS unsigned gu32;
#define RLX_AGENT __ATOMIC_RELAXED, __HIP_MEMORY_SCOPE_AGENT
#define LDS_WAIT() asm volatile("s_waitcnt lgkmcnt(0)" ::: "memory")
#define VM_WAIT() asm volatile("s_waitcnt vmcnt(0)" ::: "memory")
__device__ __forceinline__ unsigned f2bf(float f) { unsigned u = __builtin_bit_cast(unsigned, f); return (u + 0x7fffu + ((u >> 16) & 1u)) >> 16; }
__device__ __forceinline__ unsigned pk2(float lo, float hi) { return f2bf(lo) | (f2bf(hi) << 16); }
__device__ __forceinline__ float bflo(unsigned w) { return __uint_as_float(w << 16); }
__device__ __forceinline__ float bfhi(unsigned w) { return __uint_as_float(w & 0xffff0000u); }
__device__ __forceinline__ float lane_xor(float v, int lane, int o) { return __builtin_bit_cast(float, __builtin_amdgcn_ds_bpermute((lane ^ o) << 2, __builtin_bit_cast(int, v))); }
__device__ __forceinline__ float wave_sum(float v, int lane) {
#pragma unroll
    for (int o = 1; o < 64; o <<= 1) v += lane_xor(v, lane, o);
    return v;
}
__device__ __forceinline__ float silu_f(float x) { return x / (1.0f + __expf(-x)); }
#define XB_TMO      128
#define XB_XCNT(j)  (256  + 64 * (j))
#define XB_XSUB(j)  (1280 + 64 * (j))
#define XB_XGEN(j)  (2304 + 64 * (j))
#define XB_TOP      3328
#define XB_TOPGEN   3392
#define XCD_BAR_WORDS 3456
#define XB_SPIN_CAP (1u << 18)

__device__ __forceinline__ unsigned xb_ld(unsigned* p)              { return __hip_atomic_load(p, __ATOMIC_RELAXED, __HIP_MEMORY_SCOPE_AGENT); }
__device__ __forceinline__ unsigned xb_add(unsigned* p, unsigned v) { return __hip_atomic_fetch_add(p, v, __ATOMIC_RELAXED, __HIP_MEMORY_SCOPE_AGENT); }
__device__ __forceinline__ unsigned xb_xcc_id() { return (unsigned)__builtin_amdgcn_s_getreg((3 << 11) | 20) & 0xFu; }
#define XB_SPIN(cond, bar) do { unsigned _sp = 0; while (cond) { __builtin_amdgcn_s_sleep(1); \
    if ((++_sp & 255u) == 0u) { if (xb_ld(&(bar)[XB_TMO])) break; if (_sp > XB_SPIN_CAP) { atomicAdd(&(bar)[XB_TMO], 1u); break; } } } } while (0)

struct XcdBarrier {
    unsigned* bar; unsigned x;
    volatile LAS unsigned* st;
};

__device__ __forceinline__ XcdBarrier xcd_barrier_post(unsigned* bar, volatile LAS unsigned* st, bool leader) {
    XcdBarrier b; b.bar = bar; b.x = xb_xcc_id(); b.st = st;
    if (leader) (void)xb_add(&bar[XB_XCNT(b.x)], 1u);
    return b;
}
__device__ __forceinline__ void xcd_barrier_complete(unsigned* bar, unsigned x, unsigned& nloc, unsigned& nx) {
    const unsigned G = gridDim.x * gridDim.y * gridDim.z;
    unsigned sum, cnt, mine, sp = 0u;
    for (;;) {
        sum = 0u; cnt = 0u; mine = 0u;
#pragma unroll
        for (unsigned j = 0; j < 16; ++j) { const unsigned c = xb_ld(&bar[XB_XCNT(j)]); sum += c; cnt += (c > 0u) ? 1u : 0u; mine = (j == x) ? c : mine; }
        if (sum == G) break;
        __builtin_amdgcn_s_sleep(1);
        if ((++sp & 255u) == 0u) { if (xb_ld(&bar[XB_TMO])) break; if (sp > XB_SPIN_CAP) { atomicAdd(&bar[XB_TMO], 1u); break; } }
    }
    nloc = mine > 0u ? mine : 1u; nx = cnt > 0u ? cnt : 1u;
}

__device__ __forceinline__ void xcd_barrier(const XcdBarrier& b, bool leader) {
    asm volatile("s_waitcnt vmcnt(0)" ::: "memory");
    __syncthreads();
    if (leader) {
        unsigned* bar = b.bar;
        __builtin_amdgcn_s_waitcnt(0);
        unsigned nloc = b.st[0], nx = b.st[1];
        if (nloc == 0u) { xcd_barrier_complete(bar, b.x, nloc, nx); b.st[0] = nloc; b.st[1] = nx; }
        const unsigned old = xb_add(&bar[XB_XSUB(b.x)], 1u);
        const unsigned gen = old / nloc;
        if (old + 1u == (gen + 1u) * nloc) {
            __builtin_amdgcn_fence(__ATOMIC_RELEASE, "agent");
            asm volatile("s_waitcnt vmcnt(0)" ::: "memory");
            const unsigned og = xb_add(&bar[XB_TOP], 1u);
            const unsigned tg = og / nx;
            if (og + 1u == (tg + 1u) * nx) xb_add(&bar[XB_TOPGEN], 1u);
            else XB_SPIN(xb_ld(&bar[XB_TOPGEN]) == tg, bar);
            __builtin_amdgcn_fence(__ATOMIC_ACQUIRE, "agent");
            xb_add(&bar[XB_XGEN(b.x)], 1u);
            asm volatile("s_waitcnt vmcnt(0)" ::: "memory");
        } else {
            XB_SPIN(xb_ld(&bar[XB_XGEN(b.x)]) == gen, bar);
            __builtin_amdgcn_fence(__ATOMIC_ACQUIRE, "agent");
            asm volatile("s_waitcnt vmcnt(0)" ::: "memory");
        }
    }
    __syncthreads();
}

constexpr int PTAB_OFF = MISC_OFF + 128;
struct Frame {
    LAS unsigned char* lds;
    int tid, lane, wave, wave0;
    int vcu, G, bx;
    float* out; unsigned char* ws;
    __device__ __forceinline__ const float* ptr(int i) const {
        const volatile LAS unsigned* t = (const volatile LAS unsigned*)(lds + PTAB_OFF) + 2 * i;
        const unsigned lo = __builtin_amdgcn_readfirstlane(t[0]), hi = __builtin_amdgcn_readfirstlane(t[1]);
        return (const float*)((const GAS float*)(((unsigned long long)hi << 32) | lo)); }
    __device__ __forceinline__ const float* in(int i) const { return ptr(i); }
};
__device__ __forceinline__ void make_frame(Frame& F, LAS unsigned char* lds, int wave_sgpr) {
    const int t = tid_from_wave(wave_sgpr);
    int g = gridDim.x, bx = blockIdx.x; asm volatile("" : "+s"(g), "+s"(bx));
    F.lds = lds; F.tid = t; F.lane = t & 63; F.wave = __builtin_amdgcn_readfirstlane(t >> 6); F.wave0 = wave_sgpr;
    F.G = g; F.bx = bx; F.vcu = (g % 8 == 0) ? (bx % 8) * (g / 8) + bx / 8 : bx;
    F.out = (float*)F.ptr(25); F.ws = (unsigned char*)F.ptr(26);
}
__device__ __forceinline__ bf16* wsb(const Frame& F, size_t off) { return (bf16*)(F.ws + off); }
__device__ __forceinline__ float* wsf(const Frame& F, size_t off) { return (float*)(F.ws + off); }

__device__ __forceinline__ void p0_transpose_item(const float* W, int K, int N, bf16* WT, int row_off, LAS float* scr, int item, int lane, const float* kscale = nullptr) {
    const int nblk = N / 32, kb = item / nblk, nb = item % nblk, k0 = 64 * kb, n0 = 32 * nb;
    float tv[32];
#pragma unroll
    for (int i = 0; i < 32; ++i) { const int kk = 2 * i + (lane >> 5); tv[i] = W[(size_t)(k0 + kk) * N + n0 + (lane & 31)]; }
#pragma unroll
    for (int i = 0; i < 32; ++i) { const int kk = 2 * i + (lane >> 5); scr[kk * 33 + (lane & 31)] = kscale ? tv[i] * kscale[k0 + kk] : tv[i]; }
    LDS_WAIT(); asm volatile("" ::: "memory");
    const int c = lane & 7;
#pragma unroll
    for (int j = 0; j < 4; ++j) { const int n = (lane >> 3) + 8 * j; const LAS float* s = scr + (8 * c) * 33 + n;
        v4u o; o.x = pk2(s[0 * 33], s[1 * 33]); o.y = pk2(s[2 * 33], s[3 * 33]); o.z = pk2(s[4 * 33], s[5 * 33]); o.w = pk2(s[6 * 33], s[7 * 33]);
        *(GAS v4u*)(WT + (size_t)(row_off + n0 + n) * K + k0 + 8 * c) = o; }
    LDS_WAIT(); asm volatile("" ::: "memory");
}

__device__ __forceinline__ void p0_prologue(Frame& F) {
    if (F.vcu < 192) {
        LAS float* sl = (LAS float*)(F.lds);
        LAS float* part = (LAS float*)(F.lds + 32768);
        for (int idx = F.tid; idx < 3 * DM; idx += NWAVES * 64) { const int rt = idx / DM, k = idx % DM; const float v = rt < 2 ? F.in(1)[rt * DM + k] : F.in(3)[k]; sl[idx] = silu_f(v); }
        __syncthreads();
        const int layer = F.vcu / 48, cg = F.vcu % 48;
        const float* Wp = F.in(4) + (size_t)layer * DM * 12288 + cg * 256 + F.lane * 4;
        f32x4 a0 = {0.f, 0.f, 0.f, 0.f}, a1 = a0, a2 = a0;
        const int kb = F.wave * 256;
#pragma unroll 8
        for (int k = kb; k < kb + 256; ++k) { const f32x4 w = *(const GAS f32x4*)(Wp + (size_t)k * 12288); a0 += w * sl[k]; a1 += w * sl[DM + k]; a2 += w * sl[2 * DM + k]; }
        *(LAS f32x4*)(part + (F.wave * 3 + 0) * 256 + F.lane * 4) = a0; *(LAS f32x4*)(part + (F.wave * 3 + 1) * 256 + F.lane * 4) = a1; *(LAS f32x4*)(part + (F.wave * 3 + 2) * 256 + F.lane * 4) = a2;
        __syncthreads();
        for (int idx = F.tid; idx < 768; idx += NWAVES * 64) { const int rt = idx >> 8, cl = idx & 255; float s = 0.f;
#pragma unroll
            for (int w = 0; w < 8; ++w) s += part[(w * 3 + rt) * 256 + cl];
            const int n = cg * 256 + cl, chunk = n / DM; float val = s + F.in(5)[layer * 12288 + n]; if (chunk == 1 || chunk == 4) val += 1.0f;
            wsf(F, WS_MOD)[(layer * 3 + rt) * 12288 + n] = val; }
        __syncthreads();
    } else if (F.vcu == 192) {
        for (int idx = F.tid; idx < 256 * 16 + 64 * 16; idx += NWAVES * 64) {
            const int e = idx < 4096 ? idx : idx - 4096, pos = e >> 4, f = e & 15;
            const float inv = 1.0f / powf(10000.0f, (float)f / 16.0f), ang = (float)pos * inv; float sn, cs; sincosf(ang, &sn, &cs);
            f32x2* t = (f32x2*)(F.ws + (idx < 4096 ? WS_ROPER : WS_ROPEC)); t[e] = (f32x2){cs, sn}; }
    }
    LAS float* scr = (LAS float*)(F.lds + RING_OFF + F.wave * 16384);
    const int gw = F.vcu * NWAVES + F.wave, NGW = F.G * NWAVES;
    constexpr int C0 = 32 * 192, C1 = 32 * 64, C2 = 32 * 16, C3 = 32 * 18, C4 = 8 * 96, C5 = 8 * 64, C6 = 8 * 64, C7 = 32 * 64, C8 = 32 * 352, C9 = 88 * 64, C10 = 192;
    constexpr int NITEMS = 2 * (C0 + C1 + C2 + C3 + C4 + C5 + C6 + C7 + C10) + 4 * (C8 + C9);
    for (int it = gw; it < NITEMS; it += NGW) {
        int r = it;
        if (r < 4 * C8) { const int l = r / C8, item = r % C8, n0 = 32 * (item % 352);
            const int m0 = n0 < DFF ? n0 : n0 - DFF, dst = (m0 >> 7) * 256 + (n0 < DFF ? 0 : 128) + (m0 & 127);
            p0_transpose_item(F.in(21) + (size_t)l * DM * 11264, DM, 11264, wsb(F, WS_W + W_FFN_BASE + l * W_FFN_STRIDE + W_UP), dst - n0, scr, item, F.lane); continue; } r -= 4 * C8;
        if (r < 4 * C9) { const int l = r / C9; p0_transpose_item(F.in(24) + (size_t)l * DFF * DM, DFF, DM, wsb(F, WS_W + W_FFN_BASE + l * W_FFN_STRIDE + W_DOWN), 0, scr, r % C9, F.lane); continue; } r -= 4 * C9;
        if (r < 2 * C0) { const int l = r / C0, item = r % C0, n0 = 32 * (item % 192);
            const int m0 = n0 < 4096 ? n0 - 2048 : n0 - 4096, dst = n0 < 2048 ? n0 : 2048 + (m0 >> 7) * 256 + (n0 < 4096 ? 0 : 128) + (m0 & 127);
            p0_transpose_item(F.in(10) + (size_t)l * DM * 6144, DM, 6144, wsb(F, WS_W + l * W_CONV_STRIDE + W_WIN), dst - n0, scr, item, F.lane); continue; } r -= 2 * C0;
        if (r < 2 * C1) { const int l = r / C1; p0_transpose_item(F.in(12) + (size_t)l * DM * DM, DM, DM, wsb(F, WS_W + l * W_CONV_STRIDE + W_WOUT), 0, scr, r % C1, F.lane); continue; } r -= 2 * C1;
        if (r < 2 * C2) { const int l = r / C2; p0_transpose_item(F.in(13) + (size_t)l * DM * QLR, DM, QLR, wsb(F, WS_W + W_MLA_BASE + l * W_MLA_STRIDE + W_DQKV), 0, scr, r % C2, F.lane); continue; } r -= 2 * C2;
        if (r < 2 * C3) { const int l = r / C3; p0_transpose_item(F.in(16) + (size_t)l * DM * 576, DM, 576, wsb(F, WS_W + W_MLA_BASE + l * W_MLA_STRIDE + W_DQKV), 512, scr, r % C3, F.lane); continue; } r -= 2 * C3;
        if (r < 2 * C4) { const int l = r / C4; p0_transpose_item(F.in(15) + (size_t)l * QLR * 3072, QLR, 3072, wsb(F, WS_W + W_MLA_BASE + l * W_MLA_STRIDE + W_UQ), 0, scr, r % C4, F.lane, F.in(14) + l * QLR); continue; } r -= 2 * C4;
        if (r < 2 * C5) { const int l = r / C5; p0_transpose_item(F.in(18) + (size_t)l * KVLR * 2048, KVLR, 2048, wsb(F, WS_W + W_MLA_BASE + l * W_MLA_STRIDE + W_UKV), 0, scr, r % C5, F.lane, F.in(17) + l * KVLR); continue; } r -= 2 * C5;
        if (r < 2 * C6) { const int l = r / C6; p0_transpose_item(F.in(19) + (size_t)l * KVLR * 2048, KVLR, 2048, wsb(F, WS_W + W_MLA_BASE + l * W_MLA_STRIDE + W_UKV), 2048, scr, r % C6, F.lane, F.in(17) + l * KVLR); continue; } r -= 2 * C6;
        if (r < 2 * C7) { const int l = r / C7; p0_transpose_item(F.in(20) + (size_t)l * DM * DM, DM, DM, wsb(F, WS_W + W_MLA_BASE + l * W_MLA_STRIDE + W_WO), 0, scr, r % C7, F.lane); continue; } r -= 2 * C7;
        { const int l = r / C10, row = 1088 + r % C10; bf16* d = wsb(F, WS_W + W_MLA_BASE + l * W_MLA_STRIDE + W_DQKV) + (size_t)row * DM;
#pragma unroll
          for (int j = 0; j < 4; ++j) *(GAS v4u*)(d + j * 512 + F.lane * 8) = (v4u){0u, 0u, 0u, 0u}; }
    }
}

__device__ __forceinline__ void p1_hx0(Frame& F) {
    const int gw = F.vcu * NWAVES + F.wave, NGW = F.G * NWAVES;
    bf16* HX = wsb(F, WS_ACT); const float* xin = F.in(0); const float* cin = F.in(2);
    constexpr int RPW = 16;
    for (int blk = gw; blk < M_T / RPW; blk += NGW) {
        const int r0 = blk * RPW, rt = r0 < SEQ ? 0 : (r0 < M_X ? 1 : 2);
        const float* mod = wsf(F, WS_MOD) + (size_t)rt * 12288;
        const GAS f32x4* shp = (const GAS f32x4*)mod + F.lane; const GAS f32x4* scp = (const GAS f32x4*)(mod + DM) + F.lane;
        f32x4 A[8], B[8];
#pragma unroll
        for (int j = 0; j < 8; ++j) { A[j] = scp[64 * j]; B[j] = shp[64 * j]; }
        const float* src = r0 < M_X ? xin + (size_t)r0 * DM : cin + (size_t)(r0 - M_X) * DM;
        const GAS f32x4* xr = (const GAS f32x4*)src + F.lane;
        GAS f32x4* xc = (GAS f32x4*)(wsf(F, WS_X32C) + (size_t)(r0 < M_X ? 0 : r0 - M_X) * DM) + F.lane;
        f32x4 va[8], vb[8];
#pragma unroll
        for (int j = 0; j < 8; ++j) va[j] = xr[64 * j];
#define P1_ROW(CUR, NXT, R) do { \
            if ((R) + 1 < RPW) { _Pragma("unroll") for (int j = 0; j < 8; ++j) NXT[j] = xr[(size_t)((R) + 1) * (DM / 4) + 64 * j]; } \
            GAS v2u* o8_ = (GAS v2u*)(HX + (size_t)(r0 + (R)) * DM) + F.lane; \
            _Pragma("unroll") for (int j = 0; j < 8; ++j) { const f32x4 h_ = CUR[j] * A[j] + B[j]; o8_[64 * j] = (v2u){pk2(h_.x, h_.y), pk2(h_.z, h_.w)}; \
                if (r0 >= M_X) xc[(size_t)(R) * (DM / 4) + 64 * j] = CUR[j] * DN_ALPHA; }     \
        } while (0)
        for (int r = 0; r < RPW; r += 2) { P1_ROW(va, vb, r); P1_ROW(vb, va, r + 1); }
#undef P1_ROW
    }
}

__device__ __forceinline__ void ln_phase(Frame& F, int layer, int second, int nrows, int nplanes) {
    const int gw = F.vcu * NWAVES + F.wave, NGW = F.G * NWAVES;
    const float* gam = F.in(second ? 8 : 6) + layer * DM; const float* bet = F.in(second ? 9 : 7) + layer * DM;
    const bool final_out = (second && layer == DEPTH - 1);
    const int modl = second ? (layer + 1 < DEPTH ? layer + 1 : layer) : layer, chunk = second ? 0 : 3;
    bf16* HX = wsb(F, WS_ACT); float* stats = wsf(F, WS_STATS) + (size_t)second * 2 * M_T;
    const GAS f32x4* gp = (const GAS f32x4*)gam + F.lane; const GAS f32x4* bp = (const GAS f32x4*)bet + F.lane;
    constexpr int RPW = 16;
    const _Float16* T16 = (const _Float16*)(F.ws + WS_T16);
    for (int blk = gw; blk < M_X / RPW; blk += NGW) {
        const int r0 = blk * RPW, rt = r0 < SEQ ? 0 : 1;
        f32x4 A[8], B[8];
        { const float* mod = wsf(F, WS_MOD) + (size_t)(modl * 3 + rt) * 12288 + chunk * DM;
          const GAS f32x4* g4 = (const GAS f32x4*)gam + 2 * F.lane; const GAS f32x4* b4 = (const GAS f32x4*)bet + 2 * F.lane;
          const GAS f32x4* shp = (const GAS f32x4*)mod + 2 * F.lane; const GAS f32x4* scp = (const GAS f32x4*)(mod + DM) + 2 * F.lane;
#pragma unroll
          for (int j = 0; j < 4; ++j)
#pragma unroll
              for (int h = 0; h < 2; ++h) { const int q = 128 * j + h; const f32x4 g = g4[q], b = b4[q]; if (final_out) { A[2 * j + h] = g; B[2 * j + h] = b; } else { const f32x4 sc = scp[q], sh = shp[q]; A[2 * j + h] = g * sc; B[2 * j + h] = b * sc + sh; } } }
        const GAS f16x8* xr = (const GAS f16x8*)(T16 + (size_t)r0 * DM) + F.lane;
        f16x8 ta[4], tb[4], tc[4];
#pragma unroll
        for (int j = 0; j < 4; ++j) { ta[j] = xr[64 * j]; tb[j] = xr[(size_t)(DM / 8) + 64 * j]; }
#define LN_ROW(CUR, NXT, R) do { \
            if ((R) + 2 < RPW) { _Pragma("unroll") for (int j = 0; j < 4; ++j) NXT[j] = xr[(size_t)((R) + 2) * (DM / 8) + 64 * j]; } \
            f32x4 v_[8]; float s_ = 0.f; \
            _Pragma("unroll") for (int j = 0; j < 4; ++j) { v_[2 * j] = (f32x4){(float)CUR[j][0], (float)CUR[j][1], (float)CUR[j][2], (float)CUR[j][3]}; v_[2 * j + 1] = (f32x4){(float)CUR[j][4], (float)CUR[j][5], (float)CUR[j][6], (float)CUR[j][7]}; } \
            _Pragma("unroll") for (int j = 0; j < 8; ++j) s_ += (v_[j].x + v_[j].y) + (v_[j].z + v_[j].w); \
            const float mean_ = wave_sum(s_, F.lane) * (1.f / DM); float q_ = 0.f; \
            _Pragma("unroll") for (int j = 0; j < 8; ++j) { v_[j] = v_[j] - mean_; q_ += (v_[j].x * v_[j].x + v_[j].y * v_[j].y) + (v_[j].z * v_[j].z + v_[j].w * v_[j].w); } \
            const float rstd_ = 1.f / sqrtf(wave_sum(q_, F.lane) * (1.f / DM) + LN_EPS); \
            if (final_out) { GAS f32x4* o4_ = (GAS f32x4*)(F.out + (size_t)(r0 + (R)) * DM) + 2 * F.lane; \
                   _Pragma("unroll") for (int j = 0; j < 4; ++j) { o4_[128 * j] = v_[2 * j] * rstd_ * A[2 * j] + B[2 * j]; o4_[128 * j + 1] = v_[2 * j + 1] * rstd_ * A[2 * j + 1] + B[2 * j + 1]; } } \
            else { if (F.lane == 0) *(GAS f32x2*)(stats + 2 * (size_t)(r0 + (R))) = (f32x2){mean_, rstd_}; \
                   GAS v4u* o8_ = (GAS v4u*)(HX + (size_t)(r0 + (R)) * DM) + F.lane; \
                   _Pragma("unroll") for (int j = 0; j < 4; ++j) { const f32x4 h0_ = v_[2 * j] * rstd_ * A[2 * j] + B[2 * j], h1_ = v_[2 * j + 1] * rstd_ * A[2 * j + 1] + B[2 * j + 1]; \
                       o8_[64 * j] = (v4u){pk2(h0_.x, h0_.y), pk2(h0_.z, h0_.w), pk2(h1_.x, h1_.y), pk2(h1_.z, h1_.w)}; } } \
        } while (0)
        for (int r = 0; r < RPW - 1; r += 3) { LN_ROW(ta, tc, r); LN_ROW(tb, ta, r + 1); LN_ROW(tc, tb, r + 2); }
        LN_ROW(ta, tc, RPW - 1);
#undef LN_ROW
    }
    for (int row = M_X + F.wave * F.G + F.vcu; row < nrows; row += NGW) {
        float* xrow = wsf(F, WS_X32C) + (size_t)(row - M_X) * DM;
        GAS f32x4* xr = (GAS f32x4*)xrow + F.lane;
        f32x4 v[8]; float s = 0.f;
#pragma unroll
        for (int j = 0; j < 8; ++j) v[j] = xr[64 * j];
        { const GAS f32x4* pp = (const GAS f32x4*)(wsf(F, WS_BIG + BIG_CPART) + (size_t)(row - M_X) * DM) + F.lane;
          int p = 0;
          for (; p + 4 <= nplanes; p += 4) {
              f32x4 t[4][8];
#pragma unroll
              for (int q = 0; q < 4; ++q)
#pragma unroll
                  for (int j = 0; j < 8; ++j) t[q][j] = pp[(size_t)(p + q) * (M_C * DM / 4) + 64 * j];
#pragma unroll
              for (int j = 0; j < 8; ++j) v[j] += (t[0][j] + t[1][j]) + (t[2][j] + t[3][j]); }
          for (; p < nplanes; ++p) {
#pragma unroll
              for (int j = 0; j < 8; ++j) v[j] += pp[(size_t)p * (M_C * DM / 4) + 64 * j]; } }
#pragma unroll
        for (int j = 0; j < 8; ++j) s += (v[j].x + v[j].y) + (v[j].z + v[j].w);
        const float mean = wave_sum(s, F.lane) * (1.f / DM); float s2 = 0.f;
#pragma unroll
        for (int j = 0; j < 8; ++j) { v[j] = v[j] - mean; s2 += (v[j].x * v[j].x + v[j].y * v[j].y) + (v[j].z * v[j].z + v[j].w * v[j].w); }
        const float rstd = 1.f / sqrtf(wave_sum(s2, F.lane) * (1.f / DM) + LN_EPS);
#pragma unroll
        for (int j = 0; j < 8; ++j) v[j] = v[j] * rstd * gp[64 * j] + bp[64 * j];
        if (F.lane == 0) *(GAS f32x2*)(stats + 2 * (size_t)row) = (f32x2){mean, rstd};
        const float* mod = wsf(F, WS_MOD) + (size_t)(modl * 3 + 2) * 12288 + chunk * DM;
        const GAS f32x4* shp = (const GAS f32x4*)mod + F.lane; const GAS f32x4* scp = (const GAS f32x4*)(mod + DM) + F.lane;
        GAS v2u* o8 = (GAS v2u*)(HX + (size_t)row * DM) + F.lane;
#pragma unroll
        for (int j = 0; j < 8; ++j) { const f32x4 h = v[j] * scp[64 * j] + shp[64 * j]; o8[64 * j] = (v2u){pk2(h.x, h.y), pk2(h.z, h.w)}; xr[64 * j] = v[j] * DN_ALPHA; }
    }
}

__device__ __forceinline__ void ln_cluster(Frame& F, int layer, int second, int nrows, int nplanes, const pg8::ClusterCtxOrder& S, unsigned* rel, unsigned* bar) {
    const int gw = F.vcu * NWAVES + F.wave, NGW = F.G * NWAVES;
    const float* gam = F.in(second ? 8 : 6) + layer * DM; const float* bet = F.in(second ? 9 : 7) + layer * DM;
    const bool final_out = (second && layer == DEPTH - 1);
    const int modl = second ? (layer + 1 < DEPTH ? layer + 1 : layer) : layer, chunk = second ? 0 : 3;
    bf16* HX = wsb(F, WS_ACT); float* stats = wsf(F, WS_STATS) + (size_t)second * 2 * M_T;
    const GAS f32x4* gp = (const GAS f32x4*)gam + F.lane; const GAS f32x4* bp = (const GAS f32x4*)bet + F.lane;
    const _Float16* T16 = (const _Float16*)(F.ws + WS_T16);
    pg8::Unit u0; S.map(S.c, u0);
    bool fast = (S.nxu == 4 * S.G) && S.c < S.nxu;
    if (fast) { for (int i = 1; i < 4; ++i) { pg8::Unit ui; S.map(i * S.G + S.c, ui); fast = fast && ui.pm == u0.pm + 4 * i && ui.pn == u0.pn; }
                const int ra = u0.pm * 256, rb = (u0.pm + 12) * 256 + 255; fast = fast && ((ra < SEQ) == (rb < SEQ)); }
    if (fast) {
        constexpr int RPWF = 16;
        if (F.wave == 0) { unsigned sp = 0u;
            for (int i = 0; i < 4; ++i) { unsigned* fl = rel + S.owner(u0.pm + 4 * i, F.lane & 7);
                while (!__all(__hip_atomic_load(fl, __ATOMIC_RELAXED, __HIP_MEMORY_SCOPE_AGENT) >= 1u)) { __builtin_amdgcn_s_sleep(2);
                    if ((++sp & 255u) == 0u) { if (xb_ld(&bar[XB_TMO])) break; if (sp > XB_SPIN_CAP) { atomicAdd(&bar[XB_TMO], 1u); break; } } } }
            __builtin_amdgcn_fence(__ATOMIC_ACQUIRE, "agent"); asm volatile("s_waitcnt vmcnt(0)" ::: "memory"); }
        __syncthreads();
        const int r0 = u0.pm * 256 + u0.pn * 32 + F.wave * 4, rt = r0 < SEQ ? 0 : 1;
        f32x4 A[8], B[8];
        { const float* mod = wsf(F, WS_MOD) + (size_t)(modl * 3 + rt) * 12288 + chunk * DM;
          const GAS f32x4* g4 = (const GAS f32x4*)gam + 2 * F.lane; const GAS f32x4* b4 = (const GAS f32x4*)bet + 2 * F.lane;
          const GAS f32x4* shp = (const GAS f32x4*)mod + 2 * F.lane; const GAS f32x4* scp = (const GAS f32x4*)(mod + DM) + 2 * F.lane;
#pragma unroll
          for (int j = 0; j < 4; ++j)
#pragma unroll
              for (int h = 0; h < 2; ++h) { const int q = 128 * j + h; const f32x4 g = g4[q], b = b4[q]; if (final_out) { A[2 * j + h] = g; B[2 * j + h] = b; } else { const f32x4 sc = scp[q], sh = shp[q]; A[2 * j + h] = g * sc; B[2 * j + h] = b * sc + sh; } } }
        #define ROWI(R) (r0 + ((R) >> 2) * 1024 + ((R) & 3))
#define XRP(R) ((const GAS f16x8*)(T16 + (size_t)ROWI(R) * DM) + F.lane)
        f16x8 ta[4], tb[4], tc[4];
#pragma unroll
        for (int j = 0; j < 4; ++j) { ta[j] = XRP(0)[64 * j]; tb[j] = XRP(1)[64 * j]; }
#define LN_ROW(CUR, NXT, R) do { \
            if ((R) + 2 < RPWF) { _Pragma("unroll") for (int j = 0; j < 4; ++j) NXT[j] = XRP((R) + 2)[64 * j]; } \
            f32x4 v_[8]; float s_ = 0.f; \
            _Pragma("unroll") for (int j = 0; j < 4; ++j) { v_[2 * j] = (f32x4){(float)CUR[j][0], (float)CUR[j][1], (float)CUR[j][2], (float)CUR[j][3]}; v_[2 * j + 1] = (f32x4){(float)CUR[j][4], (float)CUR[j][5], (float)CUR[j][6], (float)CUR[j][7]}; } \
            _Pragma("unroll") for (int j = 0; j < 8; ++j) s_ += (v_[j].x + v_[j].y) + (v_[j].z + v_[j].w); \
            const float mean_ = wave_sum(s_, F.lane) * (1.f / DM); float q_ = 0.f; \
            _Pragma("unroll") for (int j = 0; j < 8; ++j) { v_[j] = v_[j] - mean_; q_ += (v_[j].x * v_[j].x + v_[j].y * v_[j].y) + (v_[j].z * v_[j].z + v_[j].w * v_[j].w); } \
            const float rstd_ = 1.f / sqrtf(wave_sum(q_, F.lane) * (1.f / DM) + LN_EPS); \
            if (final_out) { GAS f32x4* o4_ = (GAS f32x4*)(F.out + (size_t)ROWI(R) * DM) + 2 * F.lane; \
                   _Pragma("unroll") for (int j = 0; j < 4; ++j) { o4_[128 * j] = v_[2 * j] * rstd_ * A[2 * j] + B[2 * j]; o4_[128 * j + 1] = v_[2 * j + 1] * rstd_ * A[2 * j + 1] + B[2 * j + 1]; } } \
            else { if (F.lane == 0) *(GAS f32x2*)(stats + 2 * (size_t)ROWI(R)) = (f32x2){mean_, rstd_}; \
                   GAS v4u* o8_ = (GAS v4u*)(HX + (size_t)ROWI(R) * DM) + F.lane; \
                   _Pragma("unroll") for (int j = 0; j < 4; ++j) { const f32x4 h0_ = v_[2 * j] * rstd_ * A[2 * j] + B[2 * j], h1_ = v_[2 * j + 1] * rstd_ * A[2 * j + 1] + B[2 * j + 1]; \
                       o8_[64 * j] = (v4u){pk2(h0_.x, h0_.y), pk2(h0_.z, h0_.w), pk2(h1_.x, h1_.y), pk2(h1_.z, h1_.w)}; } } \
        } while (0)
        for (int r = 0; r < RPWF - 1; r += 3) { LN_ROW(ta, tc, r); LN_ROW(tb, ta, r + 1); LN_ROW(tc, tb, r + 2); }
        LN_ROW(ta, tc, RPWF - 1);
#undef LN_ROW
#undef XRP
#undef ROWI
    } else {
    constexpr int RPW = 4;
    for (int i = 0;; ++i) {
        const long L = (long)i * S.G + S.c; if (L >= S.nxu) break;
        pg8::Unit u; S.map((int)L, u);
        if (F.wave == 0) { unsigned* fl = rel + S.owner(u.pm, F.lane & 7); unsigned sp = 0u;
            while (!__all(__hip_atomic_load(fl, __ATOMIC_RELAXED, __HIP_MEMORY_SCOPE_AGENT) >= 1u)) { __builtin_amdgcn_s_sleep(2);
                if ((++sp & 255u) == 0u) { if (xb_ld(&bar[XB_TMO])) break; if (sp > XB_SPIN_CAP) { atomicAdd(&bar[XB_TMO], 1u); break; } } }
            __builtin_amdgcn_fence(__ATOMIC_ACQUIRE, "agent"); asm volatile("s_waitcnt vmcnt(0)" ::: "memory"); }
        __syncthreads();
        const int r0 = u.pm * 256 + u.pn * 32 + F.wave * RPW, rt = r0 < SEQ ? 0 : 1;
        f32x4 A[8], B[8];
        { const float* mod = wsf(F, WS_MOD) + (size_t)(modl * 3 + rt) * 12288 + chunk * DM;
          const GAS f32x4* g4 = (const GAS f32x4*)gam + 2 * F.lane; const GAS f32x4* b4 = (const GAS f32x4*)bet + 2 * F.lane;
          const GAS f32x4* shp = (const GAS f32x4*)mod + 2 * F.lane; const GAS f32x4* scp = (const GAS f32x4*)(mod + DM) + 2 * F.lane;
#pragma unroll
          for (int j = 0; j < 4; ++j)
#pragma unroll
              for (int h = 0; h < 2; ++h) { const int q = 128 * j + h; const f32x4 g = g4[q], b = b4[q]; if (final_out) { A[2 * j + h] = g; B[2 * j + h] = b; } else { const f32x4 sc = scp[q], sh = shp[q]; A[2 * j + h] = g * sc; B[2 * j + h] = b * sc + sh; } } }
        const GAS f16x8* xr = (const GAS f16x8*)(T16 + (size_t)r0 * DM) + F.lane;
        f16x8 ta[4], tb[4], tc[4];
#pragma unroll
        for (int j = 0; j < 4; ++j) { ta[j] = xr[64 * j]; tb[j] = xr[(size_t)(DM / 8) + 64 * j]; }
#define LN_ROW(CUR, NXT, R) do { \
            if ((R) + 2 < RPW) { _Pragma("unroll") for (int j = 0; j < 4; ++j) NXT[j] = xr[(size_t)((R) + 2) * (DM / 8) + 64 * j]; } \
            f32x4 v_[8]; float s_ = 0.f; \
            _Pragma("unroll") for (int j = 0; j < 4; ++j) { v_[2 * j] = (f32x4){(float)CUR[j][0], (float)CUR[j][1], (float)CUR[j][2], (float)CUR[j][3]}; v_[2 * j + 1] = (f32x4){(float)CUR[j][4], (float)CUR[j][5], (float)CUR[j][6], (float)CUR[j][7]}; } \
            _Pragma("unroll") for (int j = 0; j < 8; ++j) s_ += (v_[j].x + v_[j].y) + (v_[j].z + v_[j].w); \
            const float mean_ = wave_sum(s_, F.lane) * (1.f / DM); float q_ = 0.f; \
            _Pragma("unroll") for (int j = 0; j < 8; ++j) { v_[j] = v_[j] - mean_; q_ += (v_[j].x * v_[j].x + v_[j].y * v_[j].y) + (v_[j].z * v_[j].z + v_[j].w * v_[j].w); } \
            const float rstd_ = 1.f / sqrtf(wave_sum(q_, F.lane) * (1.f / DM) + LN_EPS); \
            if (final_out) { GAS f32x4* o4_ = (GAS f32x4*)(F.out + (size_t)(r0 + (R)) * DM) + 2 * F.lane; \
                   _Pragma("unroll") for (int j = 0; j < 4; ++j) { o4_[128 * j] = v_[2 * j] * rstd_ * A[2 * j] + B[2 * j]; o4_[128 * j + 1] = v_[2 * j + 1] * rstd_ * A[2 * j + 1] + B[2 * j + 1]; } } \
            else { if (F.lane == 0) *(GAS f32x2*)(stats + 2 * (size_t)(r0 + (R))) = (f32x2){mean_, rstd_}; \
                   GAS v4u* o8_ = (GAS v4u*)(HX + (size_t)(r0 + (R)) * DM) + F.lane; \
                   _Pragma("unroll") for (int j = 0; j < 4; ++j) { const f32x4 h0_ = v_[2 * j] * rstd_ * A[2 * j] + B[2 * j], h1_ = v_[2 * j + 1] * rstd_ * A[2 * j + 1] + B[2 * j + 1]; \
                       o8_[64 * j] = (v4u){pk2(h0_.x, h0_.y), pk2(h0_.z, h0_.w), pk2(h1_.x, h1_.y), pk2(h1_.z, h1_.w)}; } } \
        } while (0)
        for (int r = 0; r < RPW - 1; r += 3) { LN_ROW(ta, tc, r); LN_ROW(tb, ta, r + 1); LN_ROW(tc, tb, r + 2); }
        LN_ROW(ta, tc, RPW - 1);
#undef LN_ROW
    }
    }
    if (nrows > M_X) {
        if (F.wave == 0) { unsigned sp = 0u;
            while ((unsigned)__builtin_amdgcn_readfirstlane((int)xb_ld(rel + 256)) < (unsigned)F.G) { __builtin_amdgcn_s_sleep(2);
                if ((++sp & 255u) == 0u) { if (xb_ld(&bar[XB_TMO])) break; if (sp > XB_SPIN_CAP) { atomicAdd(&bar[XB_TMO], 1u); break; } } }
            __builtin_amdgcn_fence(__ATOMIC_ACQUIRE, "agent"); asm volatile("s_waitcnt vmcnt(0)" ::: "memory"); }
        __syncthreads();
    }
    for (int row = M_X + F.wave * F.G + F.vcu; row < nrows; row += NGW) {
        float* xrow = wsf(F, WS_X32C) + (size_t)(row - M_X) * DM;
        GAS f32x4* xr = (GAS f32x4*)xrow + F.lane;
        f32x4 v[8]; float s = 0.f;
#pragma unroll
        for (int j = 0; j < 8; ++j) v[j] = xr[64 * j];
        { const GAS f32x4* pp = (const GAS f32x4*)(wsf(F, WS_BIG + BIG_CPART) + (size_t)(row - M_X) * DM) + F.lane;
          int p = 0;
          for (; p + 4 <= nplanes; p += 4) {
              f32x4 t[4][8];
#pragma unroll
              for (int q = 0; q < 4; ++q)
#pragma unroll
                  for (int j = 0; j < 8; ++j) t[q][j] = pp[(size_t)(p + q) * (M_C * DM / 4) + 64 * j];
#pragma unroll
              for (int j = 0; j < 8; ++j) v[j] += (t[0][j] + t[1][j]) + (t[2][j] + t[3][j]); }
          for (; p < nplanes; ++p) {
#pragma unroll
              for (int j = 0; j < 8; ++j) v[j] += pp[(size_t)p * (M_C * DM / 4) + 64 * j]; } }
#pragma unroll
        for (int j = 0; j < 8; ++j) s += (v[j].x + v[j].y) + (v[j].z + v[j].w);
        const float mean = wave_sum(s, F.lane) * (1.f / DM); float s2 = 0.f;
#pragma unroll
        for (int j = 0; j < 8; ++j) { v[j] = v[j] - mean; s2 += (v[j].x * v[j].x + v[j].y * v[j].y) + (v[j].z * v[j].z + v[j].w * v[j].w); }
        const float rstd = 1.f / sqrtf(wave_sum(s2, F.lane) * (1.f / DM) + LN_EPS);
#pragma unroll
        for (int j = 0; j < 8; ++j) v[j] = v[j] * rstd * gp[64 * j] + bp[64 * j];
        if (F.lane == 0) *(GAS f32x2*)(stats + 2 * (size_t)row) = (f32x2){mean, rstd};
        const float* mod = wsf(F, WS_MOD) + (size_t)(modl * 3 + 2) * 12288 + chunk * DM;
        const GAS f32x4* shp = (const GAS f32x4*)mod + F.lane; const GAS f32x4* scp = (const GAS f32x4*)(mod + DM) + F.lane;
        GAS v2u* o8 = (GAS v2u*)(HX + (size_t)row * DM) + F.lane;
#pragma unroll
        for (int j = 0; j < 8; ++j) { const f32x4 h = v[j] * scp[64 * j] + shp[64 * j]; o8[64 * j] = (v2u){pk2(h.x, h.y), pk2(h.z, h.w)}; xr[64 * j] = v[j] * DN_ALPHA; }
    }
}

__device__ __forceinline__ bool seq_start(int r) { return r >= M_T ? true : (r < M_X ? ((r & (SEQ - 1)) == 0) : (((r - M_X) & (CTXL - 1)) == 0)); }
__device__ __forceinline__ void unpack8(const v4u w, float (&f)[8]) { f[0] = bflo(w.x); f[1] = bfhi(w.x); f[2] = bflo(w.y); f[3] = bfhi(w.y); f[4] = bflo(w.z); f[5] = bfhi(w.z); f[6] = bflo(w.w); f[7] = bfhi(w.w); }

__device__ __forceinline__ void load8f(const float* p, float (&f)[8]) { const f32x4 a = *(const GAS f32x4*)p, b = *(const GAS f32x4*)(p + 4); f[0] = a.x; f[1] = a.y; f[2] = a.z; f[3] = a.w; f[4] = b.x; f[5] = b.y; f[6] = b.z; f[7] = b.w; }
__device__ __forceinline__ void convfix_phase(Frame& F, int j) {
    const int gw = F.vcu * NWAVES + F.wave, NGW = F.G * NWAVES;
    const float* HALO = wsf(F, WS_BIG + BIG_HALOC); const bf16* Bb = wsb(F, WS_BIG + BIG_BB); bf16* OUT = wsb(F, WS_BIG + BIG_GATED);
    const float* cw = F.in(11) + (size_t)j * 3 * DM;
    constexpr int NCG = DM / 512, NSEG = M_T / 64;
    for (int item = gw; item < NSEG * 2 * NCG; item += NGW) {
        const int cg = item % NCG, sw = item / NCG, seg = sw >> 1, bot = sw & 1, f0 = cg * 512 + F.lane * 8;
        const int row = 64 * seg + (bot ? 63 : 0);
        const bool missing = bot ? seq_start(row + 1) : seq_start(row);
        const float* P = HALO + ((size_t)seg * 512 + (f0 >> 2)) * 16 + (bot ? 12 : 4);
        const f32x4 p0 = *(const GAS f32x4*)P, p1 = *(const GAS f32x4*)(P + 16);
        float z[8] = {p0.x, p0.y, p0.z, p0.w, p1.x, p1.y, p1.z, p1.w};
        if (!missing) {
            const float* R = HALO + ((size_t)(bot ? seg + 1 : seg - 1) * 512 + (f0 >> 2)) * 16 + (bot ? 0 : 8);
            const f32x4 r0 = *(const GAS f32x4*)R, r1 = *(const GAS f32x4*)(R + 16); const float rr[8] = {r0.x, r0.y, r0.z, r0.w, r1.x, r1.y, r1.z, r1.w};
            float w[8]; load8f(cw + (bot ? 2 : 0) * DM + f0, w);
#pragma unroll
            for (int e = 0; e < 8; ++e) z[e] += w[e] * rr[e];
        }
        float bb[8]; unpack8(*(const GAS v4u*)(Bb + (size_t)row * DM + f0), bb);
        *(GAS v4u*)(OUT + (size_t)row * DM + f0) = (v4u){pk2(bb[0] * z[0], bb[1] * z[1]), pk2(bb[2] * z[2], bb[3] * z[3]), pk2(bb[4] * z[4], bb[5] * z[5]), pk2(bb[6] * z[6], bb[7] * z[7])};
    }
}

__device__ __forceinline__ void ffnfix_phase(Frame& F, int layer, int nrows) {
    const int gw = F.vcu * NWAVES + F.wave, NGW = F.G * NWAVES;
    const float* HALO = wsf(F, WS_BIG + BIG_HALO); bf16* ACT = wsb(F, WS_BIG + BIG_ACT);
    const float* cw = F.in(22) + (size_t)layer * 3 * 11264;
    constexpr int NCG = DFF / 512;
    const int nseg = nrows / 64;
    for (int item = gw; item < nseg * 2 * NCG; item += NGW) {
        const int cg = item % NCG, sw = item / NCG, seg = sw >> 1, bot = sw & 1, f0 = cg * 512 + F.lane * 8;
        const int row = 64 * seg + (bot ? 63 : 0);
        const bool missing = bot ? seq_start(row + 1) : seq_start(row);
        const float* P = HALO + ((size_t)seg * 2816 + (f0 >> 2)) * 16 + (bot ? 12 : 4);
        float pg[8], pu[8];
        { const f32x4 a = *(const GAS f32x4*)P, b = *(const GAS f32x4*)(P + 16), c = *(const GAS f32x4*)(P + 1408 * 16), d = *(const GAS f32x4*)(P + 1408 * 16 + 16);
          pg[0] = a.x; pg[1] = a.y; pg[2] = a.z; pg[3] = a.w; pg[4] = b.x; pg[5] = b.y; pg[6] = b.z; pg[7] = b.w; pu[0] = c.x; pu[1] = c.y; pu[2] = c.z; pu[3] = c.w; pu[4] = d.x; pu[5] = d.y; pu[6] = d.z; pu[7] = d.w; }
        if (!missing) {
            const float* R = HALO + ((size_t)(bot ? seg + 1 : seg - 1) * 2816 + (f0 >> 2)) * 16 + (bot ? 0 : 8); const float* W = cw + (bot ? 2 : 0) * 11264 + f0;
            float rg[8], ru[8], wg[8], wu[8]; load8f(W, wg); load8f(W + DFF, wu);
            { const f32x4 a = *(const GAS f32x4*)R, b = *(const GAS f32x4*)(R + 16), c = *(const GAS f32x4*)(R + 1408 * 16), d = *(const GAS f32x4*)(R + 1408 * 16 + 16);
              rg[0] = a.x; rg[1] = a.y; rg[2] = a.z; rg[3] = a.w; rg[4] = b.x; rg[5] = b.y; rg[6] = b.z; rg[7] = b.w; ru[0] = c.x; ru[1] = c.y; ru[2] = c.z; ru[3] = c.w; ru[4] = d.x; ru[5] = d.y; ru[6] = d.z; ru[7] = d.w; }
#pragma unroll
            for (int e = 0; e < 8; ++e) { pg[e] += wg[e] * rg[e]; pu[e] += wu[e] * ru[e]; }
        }
        float o[8];
#pragma unroll
        for (int e = 0; e < 8; ++e) o[e] = pg[e] * __builtin_amdgcn_rcpf(1.0f + __builtin_amdgcn_exp2f(-1.4426950408889634f * pg[e])) * pu[e];
        *(GAS v4u*)(ACT + ((size_t)((row >> 8) * 88 + (f0 >> 6)) * 256 + (row & 255)) * 64 + (f0 & 63)) = (v4u){pk2(o[0], o[1]), pk2(o[2], o[3]), pk2(o[4], o[5]), pk2(o[6], o[7])};
    }
}

__device__ __forceinline__ void krope_phase(Frame& F) {
    const int gw = F.vcu * NWAVES + F.wave, NGW = F.G * NWAVES;
    const float* KRRAW = wsf(F, WS_BIG + BIG_KRRAW); bf16* KR = wsb(F, WS_BIG + BIG_KR);
    const f32x2* ropeR = (const f32x2*)(F.ws + WS_ROPER); const f32x2* ropeC = (const f32x2*)(F.ws + WS_ROPEC);
    for (int row = gw; row < M_T; row += NGW) {
        float kr = KRRAW[(size_t)row * ROPE_D + F.lane];
        const float partner = lane_xor(kr, F.lane, 16);
        if (row < M_X) { const int pos = row & (SEQ - 1), f = F.lane & 15; const f32x2 cs = F.lane < 32 ? ropeR[(pos >> 6) * 16 + f] : ropeC[(pos & 63) * 16 + f];
            kr = kr * cs.x + ((F.lane & 16) ? partner : -partner) * cs.y; }
        KR[(size_t)row * ROPE_D + F.lane] = (bf16)f2bf(kr);
    }
}

__device__ __forceinline__ void attn_phase(Frame& F, bool last, int i_lo = 0, int i_hi = 1 << 30) {
    const bf16* Q = wsb(F, WS_BIG + BIG_Q); const bf16* K = wsb(F, WS_BIG + BIG_K); const bf16* V = wsb(F, WS_BIG + BIG_V); const bf16* KR = wsb(F, WS_BIG + BIG_KR); bf16* O = wsb(F, WS_BIG + BIG_O);
    const att::f32x2* ropeR = (const att::f32x2*)(F.ws + WS_ROPER); const att::f32x2* ropeC = (const att::f32x2*)(F.ws + WS_ROPEC);
    ATT_LAS char* lds = (ATT_LAS char*)(F.lds + RING_OFF);
    constexpr int NQB = SEQ / 256, NUNIT = BATCH * NH * NQB, NCU = BATCH * NH;
    const int ntot = last ? NUNIT : NUNIT + NCU;
    for (int i = i_lo; i < i_hi; ++i) {
        const int L = i * F.G + F.vcu; if (L >= ntot) break;
        const bool isx = L < NUNIT;
        const int p = isx ? L / NQB : L - NUNIT, qb = isx ? L % NQB : 0, b = p / NH, h = p % NH;
        const size_t qrow = isx ? (size_t)b * SEQ + (size_t)qb * 256 : (size_t)M_X + (size_t)b * CTXL;
        att::attn_unit(Q + qrow * 3072 + h * 192, K + (size_t)h * M_T * 128, V + (size_t)h * M_T * 128, KR, O + qrow * 2048 + h * 128,

                       b * SEQ, isx ? SEQ / 64 : 0, M_X + b * CTXL, isx ? SEQ / 64 + CTXL / 64 : CTXL / 64, isx ? 1 : 0, qb * 256, ropeR, ropeC, lds, F.wave0);
    }
}

#ifndef MK_ONE_LAUNCH
#define MK_ONE_LAUNCH 1
#endif
constexpr bool ONE_LAUNCH = (MK_ONE_LAUNCH != 0);
constexpr int N_PHASE_IDS = 2 + 10 * DEPTH;
struct Args { const float* in[25]; float* out; unsigned char* ws; int ph_lo, ph_hi; };
__global__ void __launch_bounds__(NWAVES * 64, 2) mk_fwd(Args args) {
    extern __shared__ __attribute__((aligned(16))) unsigned char lds[];
    LAS unsigned char* const L0 = (LAS unsigned char*)lds;
    for (int u = threadIdx.x; u < (LDS_BYTES - LDSCTL_OFF) / 4; u += NWAVES * 64) ((LAS unsigned*)(L0 + LDSCTL_OFF))[u] = 0u;
    __syncthreads();
    if (threadIdx.x < 27) { const unsigned long long v = threadIdx.x < 25 ? (unsigned long long)args.in[threadIdx.x] : (threadIdx.x == 25 ? (unsigned long long)args.out : (unsigned long long)args.ws);
        ((LAS unsigned long long*)(L0 + PTAB_OFF))[threadIdx.x] = v; }
    __syncthreads();
    const int lo = args.ph_lo, hi = args.ph_hi;
    const int wave0 = __builtin_amdgcn_readfirstlane((int)threadIdx.x >> 6);
    if (ONE_LAUNCH) { Frame F; make_frame(F, L0, wave0); (void)xcd_barrier_post((unsigned*)((gu32*)(F.ws + WS_CTL) + CW_BAR), (volatile LAS unsigned*)(L0 + MISC_OFF) + 8, F.tid == 0); }
#ifndef MK_SLOT_MASK
#define MK_SLOT_MASK 0xFFFFFFFFu
#endif
#define IN(k) (lo <= (k) && (k) < hi)
#define INS(sl, cv) ((((MK_SLOT_MASK) >> ((sl) + ((cv) ? 16 : 0))) & 1u) && IN(pb + (sl)))
#ifndef PROBE_WAIT
#define PROBE_WAIT 0
#endif
#ifndef PROBE_WAIT_MASK
#define PROBE_WAIT_MASK 0xFFFFFFFFFFFFFFFFull
#endif
#ifndef PROBE_SPAN
#define PROBE_SPAN 0
#endif
#ifndef PROBE_WAIT_AMP
#define PROBE_WAIT_AMP 4
#endif
#define SEAM() do { if (ONE_LAUNCH) { XcdBarrier b_; b_.bar = (unsigned*)((gu32*)(F.ws + WS_CTL) + CW_BAR); b_.x = xb_xcc_id(); b_.st = (volatile LAS unsigned*)(L0 + MISC_OFF) + 8; const bool lead_ = tid_from_wave(wave0) == 0; \
    unsigned long long tw0_ = 0; if (PROBE_WAIT) { __syncthreads(); tw0_ = __builtin_amdgcn_s_memrealtime(); } \
    for (int rb_ = 0; rb_ <= REP_BAR; ++rb_) xcd_barrier(b_, lead_); \
    if (PROBE_WAIT) { const unsigned long long tw1_ = __builtin_amdgcn_s_memrealtime(); if (lead_) { volatile LAS unsigned* pw_ = (volatile LAS unsigned*)(L0 + MISC_OFF + 64); const unsigned idx_ = pw_[2]; pw_[2] = idx_ + 1u; \
        const unsigned prev_ = pw_[4]; pw_[4] = (unsigned)tw1_;     \
        if (((unsigned long long)(PROBE_WAIT_MASK) >> idx_) & 1ull) pw_[0] += PROBE_SPAN ? ((unsigned)tw1_ - prev_) : (unsigned)(tw1_ - tw0_); } } } } while (0)
#ifndef REP_ATTN
#define REP_ATTN 0
#endif
#ifndef REP_UP
#define REP_UP 0
#endif
#ifndef REP_WIN
#define REP_WIN 0
#endif
#ifndef REP_MLAG
#define REP_MLAG 0
#endif
#ifndef REP_ELT
#define REP_ELT 0
#endif
#ifndef REP_RESID
#define REP_RESID 0
#endif
#ifndef REP_BAR
#define REP_BAR 0
#endif
#ifndef REP_LN
#define REP_LN 0
#endif
#ifndef PROBE_ATTN_SPLIT
#define PROBE_ATTN_SPLIT 0
#endif
#ifndef PROBE_UP_TAIL
#define PROBE_UP_TAIL 0
#endif
#ifndef REP_P0
#define REP_P0 0
#endif
#define FRAME() Frame F; make_frame(F, L0, wave0); LAS unsigned char* ring = F.lds + RING_OFF; (void)ring; \
    bf16* HX = wsb(F, WS_ACT); bf16* ACT = wsb(F, WS_BIG + BIG_ACT); bf16* GU = wsb(F, WS_BIG); float* X32C = wsf(F, WS_X32C); const float* MOD = wsf(F, WS_MOD); (void)HX; (void)ACT; (void)GU; (void)X32C; (void)MOD

    if (((MK_SLOT_MASK >> 30) & 1u) && IN(0)) { FRAME(); for (int rep_ = 0; rep_ <= REP_P0; ++rep_) { p0_prologue(F); __syncthreads(); } SEAM(); }
    if (((MK_SLOT_MASK >> 31) & 1u) && IN(1)) { FRAME(); p1_hx0(F); SEAM(); }

    for (int L = 0; L < DEPTH; ++L) {
        const int pb = 2 + 10 * L, j = L >> 1; const bool last = (L == DEPTH - 1); const int Mrows = last ? M_X : M_T;
        const bool is_conv = (L & 1) == 0;
        if (is_conv) {
            if (INS(1, 1)) { FRAME();
                unsigned* cvf = (unsigned*)((gu32*)(F.ws + WS_CTL) + CW_CVF + j * 1024);
                pg8::Gemm g{HX, wsb(F, WS_W + j * W_CONV_STRIDE + W_WIN), M_T, 3 * DM, DM}; pg8::ConvMergedOrder S; S.init(M_T, DM, 2 * DM, F.G, F.bx, cvf);
                pg8::EpiConvBoth E{{wsb(F, WS_BIG + BIG_BB), DM, nullptr, 0, 0, 1.f},
                                   {wsb(F, WS_BIG + BIG_GATED), wsf(F, WS_BIG + BIG_HALOC), wsb(F, WS_BIG + BIG_BB), F.in(11) + (size_t)j * 3 * DM, (unsigned)((M_T / 64) * 512 * 64)},
                                   S.sb, cvf, (unsigned*)((gu32*)(F.ws + WS_CTL) + CW_BAR) + XB_TMO, F.G};
                pg8::gemm_phase<pg8::EpiConvBoth, pg8::ConvMergedOrder, true, true>(ring, g, S, E, F.wave0); SEAM(); }
            if (INS(2, 1)) { FRAME(); convfix_phase(F, j); SEAM(); }
        } else {
            if (INS(0, 0)) { FRAME();
                pg8::Gemm g{HX, wsb(F, WS_W + W_MLA_BASE + j * W_MLA_STRIDE + W_DQKV), M_T, NDQKV, DM}; pg8::StaticOrder S; S.init(M_T, NDQKV, F.G, F.bx);
                pg8::EpiDqkv E{wsb(F, WS_BIG + BIG_CQ), wsb(F, WS_BIG + BIG_CKV), wsf(F, WS_BIG + BIG_KRRAW), wsf(F, WS_BIG + BIG_SSQ), (unsigned)(M_T * 64)};
                for (int rep_ = 0; rep_ <= REP_MLAG; ++rep_) pg8::gemm_phase<pg8::EpiDqkv, pg8::StaticOrder, true, true>(ring, g, S, E, F.wave0); SEAM(); }
            if (INS(2, 0)) { FRAME();
                krope_phase(F);
                for (int rep_ = 0; rep_ <= REP_MLAG; ++rep_) {
                { pg8::Gemm g{wsb(F, WS_BIG + BIG_CQ), wsb(F, WS_W + W_MLA_BASE + j * W_MLA_STRIDE + W_UQ), Mrows, 3072, QLR}; pg8::StaticOrder S; S.init(Mrows, 3072, F.G, F.bx);
                  pg8::EpiBf16Row E{wsb(F, WS_BIG + BIG_Q), 3072, 0, 0, wsf(F, WS_BIG + BIG_SSQ), RMS_EPS, 0};
                  pg8::gemm_phase<pg8::EpiBf16Row, pg8::StaticOrder, true, true>(ring, g, S, E, F.wave0); }
                { pg8::Gemm g{wsb(F, WS_BIG + BIG_CKV), wsb(F, WS_W + W_MLA_BASE + j * W_MLA_STRIDE + W_UKV), M_T, 4096, KVLR}; pg8::StaticOrder S; S.init(M_T, 4096, F.G, (F.bx + F.G / 2) % F.G);
                  pg8::EpiBf16Row E{wsb(F, WS_BIG + BIG_K), 2048, 2048, (BIG_V - BIG_K) / 2, wsf(F, WS_BIG + BIG_SSQ) + 8, RMS_EPS, M_T};
                  pg8::gemm_phase<pg8::EpiBf16Row, pg8::StaticOrder, true, true>(ring, g, S, E, F.wave0); }
                }
                SEAM(); }
            if (INS(3, 0)) { FRAME(); if (PROBE_ATTN_SPLIT) { attn_phase(F, last, 0, 4); SEAM(); attn_phase(F, last, 4); } else { for (int rep_ = 0; rep_ <= REP_ATTN; ++rep_) attn_phase(F, last); } SEAM(); }
        }
        if (INS(4, 0)) { FRAME();
            const bf16* A = is_conv ? wsb(F, WS_BIG + BIG_GATED) : wsb(F, WS_BIG + BIG_O);
            const bf16* Bt = is_conv ? wsb(F, WS_W + j * W_CONV_STRIDE + W_WOUT) : wsb(F, WS_W + W_MLA_BASE + j * W_MLA_STRIDE + W_WO);
            pg8::Gemm g{A, Bt, Mrows, DM, DM}; pg8::ClusterCtxOrder S; S.init(M_X, Mrows - M_X, DM, DM, 4, F.G, F.bx);
            pg8::EpiResid E{L == 0 ? F.in(0) : nullptr, (const _Float16*)(F.ws + WS_T16), (_Float16*)(F.ws + WS_T16), wsf(F, WS_BIG + BIG_CPART), MOD + (size_t)L * 3 * 12288 + 2 * DM, DN_ALPHA,
                             L == 0 ? nullptr : wsf(F, WS_STATS) + 2 * M_T, F.in(8) + (L == 0 ? 0 : L - 1) * DM, F.in(9) + (L == 0 ? 0 : L - 1) * DM};
            if (REP_RESID) { pg8::EpiResid E2 = E; E2.dstT = (_Float16*)HX; pg8::SplitCtxOrder S2; S2.init(M_X, 0, DM, DM, 4, F.G, F.bx); pg8::gemm_phase<pg8::EpiResid, pg8::SplitCtxOrder, true, true>(ring, g, S2, E2, F.wave0); }
            pg8::gemm_phase<pg8::EpiResid, pg8::ClusterCtxOrder, true, true>(ring, g, S, E, F.wave0);
            { Frame F2; make_frame(F2, L0, wave0); unsigned* rel = (unsigned*)((gu32*)(F2.ws + WS_CTL) + CW_RLF + (2 * L + 0) * RLF_STRIDE); unsigned* bar2 = (unsigned*)((gu32*)(F2.ws + WS_CTL) + CW_BAR);
              if (F2.tid == 0) { __builtin_amdgcn_fence(__ATOMIC_RELEASE, "agent"); asm volatile("s_waitcnt vmcnt(0)" ::: "memory"); __hip_atomic_store(rel + F2.bx, 1u, __ATOMIC_RELAXED, __HIP_MEMORY_SCOPE_AGENT); (void)xb_add(rel + 256, 1u); }
              pg8::ClusterCtxOrder S2; S2.init(M_X, Mrows - M_X, DM, DM, 4, F2.G, F2.bx);
              ln_cluster(F2, L, 0, Mrows, 4, S2, rel, bar2);
              if (F2.G == 256) {
                  asm volatile("s_waitcnt vmcnt(0)" ::: "memory"); __syncthreads();
                  if (F2.tid == 0) { __builtin_amdgcn_fence(__ATOMIC_RELEASE, "agent"); asm volatile("s_waitcnt vmcnt(0)" ::: "memory"); __hip_atomic_store(rel + 512 + F2.bx, 1u, __ATOMIC_RELAXED, __HIP_MEMORY_SCOPE_AGENT); (void)xb_add(rel + 257, 1u); } } }
            if (F.G != 256) SEAM(); }
        if (INS(6, 0)) { FRAME();
            pg8::Gemm g{HX, wsb(F, WS_W + W_FFN_BASE + L * W_FFN_STRIDE + W_UP), Mrows, 11264, DM};
            pg8::EpiConvAct E{ACT, wsf(F, WS_BIG + BIG_HALO), F.in(22) + (size_t)L * 3 * 11264, F.in(23) + (size_t)L * 11264, (unsigned)((M_T / 64) * 2816 * 64)};
            if (F.G == 256) {
                unsigned* rel = (unsigned*)((gu32*)(F.ws + WS_CTL) + CW_RLF + (2 * L + 0) * RLF_STRIDE);
                if (F.wave == 0) { unsigned* bar2 = (unsigned*)((gu32*)(F.ws + WS_CTL) + CW_BAR); unsigned* fl = rel + 512 + (8 * (8 * (F.bx >> 6) + (F.lane & 7)) + (F.bx & 7)); unsigned sp = 0u;
                    while (!__all(__hip_atomic_load(fl, __ATOMIC_RELAXED, __HIP_MEMORY_SCOPE_AGENT) >= 1u)) { __builtin_amdgcn_s_sleep(2);
                        if ((++sp & 255u) == 0u) { if (xb_ld(&bar2[XB_TMO])) break; if (sp > XB_SPIN_CAP) { atomicAdd(&bar2[XB_TMO], 1u); break; } } }
                    __builtin_amdgcn_fence(__ATOMIC_ACQUIRE, "agent"); asm volatile("s_waitcnt vmcnt(0)" ::: "memory"); }
                __syncthreads();
                pg8::ClusterUpOrder S; S.init(11264, Mrows - M_X, F.G, F.bx, rel + 257);
                pg8::gemm_phase<pg8::EpiConvAct, pg8::ClusterUpOrder, true, true>(ring, g, S, E, F.wave0);
            } else {
                pg8::StaticOrder S; S.init(Mrows, 11264, F.G, F.bx);
                pg8::gemm_phase<pg8::EpiConvAct, pg8::StaticOrder, true, true>(ring, g, S, E, F.wave0);
            }
            SEAM(); }
        if (INS(7, 0)) { FRAME(); for (int rep_ = 0; rep_ <= REP_ELT; ++rep_) ffnfix_phase(F, L, Mrows); SEAM(); }
        if (INS(8, 0)) { FRAME();
            pg8::Gemm g{ACT, wsb(F, WS_W + W_FFN_BASE + L * W_FFN_STRIDE + W_DOWN), Mrows, DM, DFF, 1}; pg8::ClusterCtxOrder S; S.init(M_X, Mrows - M_X, DM, DFF, 11, F.G, F.bx);
            pg8::EpiResid E{nullptr, (const _Float16*)(F.ws + WS_T16), (_Float16*)(F.ws + WS_T16), wsf(F, WS_BIG + BIG_CPART), MOD + (size_t)L * 3 * 12288 + 5 * DM, DN_ALPHA, wsf(F, WS_STATS), F.in(6) + L * DM, F.in(7) + L * DM};
            if (REP_RESID) { pg8::EpiResid E2 = E; E2.dstT = (_Float16*)HX; pg8::SplitCtxOrder S2; S2.init(M_X, 0, DM, DFF, 11, F.G, F.bx); pg8::gemm_phase<pg8::EpiResid, pg8::SplitCtxOrder, true, true>(ring, g, S2, E2, F.wave0); }
            pg8::gemm_phase<pg8::EpiResid, pg8::ClusterCtxOrder, true, true>(ring, g, S, E, F.wave0);
            { Frame F2; make_frame(F2, L0, wave0); unsigned* rel = (unsigned*)((gu32*)(F2.ws + WS_CTL) + CW_RLF + (2 * L + 1) * RLF_STRIDE); unsigned* bar2 = (unsigned*)((gu32*)(F2.ws + WS_CTL) + CW_BAR);
              if (F2.tid == 0) { __builtin_amdgcn_fence(__ATOMIC_RELEASE, "agent"); asm volatile("s_waitcnt vmcnt(0)" ::: "memory"); __hip_atomic_store(rel + F2.bx, 1u, __ATOMIC_RELAXED, __HIP_MEMORY_SCOPE_AGENT); (void)xb_add(rel + 256, 1u); }
              pg8::ClusterCtxOrder S2; S2.init(M_X, Mrows - M_X, DM, DFF, 11, F2.G, F2.bx);
              ln_cluster(F2, L, 1, Mrows, 11, S2, rel, bar2); }
            if (!last) SEAM(); }
    }
#if PROBE_WAIT
    { FRAME(); const bool pl_ = F.tid == 0; unsigned* acc_ = (unsigned*)((gu32*)(F.ws + WS_CTL) + 64);
      if (pl_) (void)xb_add(acc_, *(volatile LAS unsigned*)(L0 + MISC_OFF + 64));
      SEAM();
      if (F.bx == 0 && pl_) { const unsigned sum_ = xb_ld(acc_); const unsigned long long tgt_ = (unsigned long long)(sum_ / (unsigned)F.G) * PROBE_WAIT_AMP; const unsigned long long t0_ = __builtin_amdgcn_s_memrealtime();
          while (__builtin_amdgcn_s_memrealtime() - t0_ < tgt_) __builtin_amdgcn_s_sleep(16); } }
#endif
#undef IN
#undef SEAM
}

extern "C" void kernel_launch(void* const* d_in, const int* in_sizes, int n_in, void* d_out, int out_size, void* d_ws, size_t ws_size, hipStream_t stream) {
    static int grid = 0;
    if (grid == 0) {
        if (n_in != 25 || in_sizes[0] != M_X * DM || out_size != M_X * DM || ws_size < WS_END) {
            fprintf(stderr, "kernel_launch: shape/workspace mismatch: n_in %d in0 %d out %d ws %zu (need %zu); nothing launched\n", n_in, n_in > 0 ? in_sizes[0] : -1, out_size, ws_size, (size_t)WS_END); grid = -1; return; }
        int dev = 0, cus = 0, per_cu = 0;
        if (hipGetDevice(&dev) != hipSuccess || hipDeviceGetAttribute(&cus, hipDeviceAttributeMultiprocessorCount, dev) != hipSuccess) { grid = -1; return; }
        if (hipFuncSetAttribute((const void*)mk_fwd, hipFuncAttributeMaxDynamicSharedMemorySize, LDS_BYTES) != hipSuccess) { fprintf(stderr, "kernel_launch: hipFuncSetAttribute failed\n"); grid = -1; return; }
        if (hipOccupancyMaxActiveBlocksPerMultiprocessor(&per_cu, (const void*)mk_fwd, NWAVES * 64, LDS_BYTES) != hipSuccess || per_cu < 1)
            fprintf(stderr, "kernel_launch: note: occupancy query reports %d workgroups per CU\n", per_cu);
        (void)hipGetLastError();
        grid = cus;
    }
    if (grid < 0) return;
    if (hipMemsetAsync((char*)d_ws + WS_CTL, 0, CTL_ZERO_BYTES, stream) != hipSuccess) return;
    Args a{};
    for (int i = 0; i < 25; ++i) a.in[i] = (const float*)d_in[i];
    a.out = (float*)d_out; a.ws = (unsigned char*)d_ws;
    if (ONE_LAUNCH) {
        a.ph_lo = 0; a.ph_hi = N_PHASE_IDS;
        hipLaunchKernelGGL(mk_fwd, dim3(grid), dim3(NWAVES * 64), LDS_BYTES, stream, a);
    } else {
        for (int p = 0; p < N_PHASE_IDS; ++p) {
            if (p >= 2) { const int L = (p - 2) / 10, s = (p - 2) % 10; if (((L & 1) == 0 && s == 3) || ((L & 1) == 1 && s == 1)) continue; }
            a.ph_lo = p; a.ph_hi = p + 1;
            hipLaunchKernelGGL(mk_fwd, dim3(grid), dim3(NWAVES * 64), LDS_BYTES, stream, a);
        }
    }
    const hipError_t le = hipPeekAtLastError();
    if (le != hipSuccess) fprintf(stderr, "kernel_launch: launch failed: %s\n", hipGetErrorName(le));
}
```

```cpp
#include <hip/hip_runtime.h>
#include <cstdio>
#include <cstdint>
#include <cmath>
#ifndef ATT_SDEPTH
#define ATT_SDEPTH 1
#endif
__device__ __forceinline__ int tid_from_wave(int wave) {
    int w = wave; asm volatile("" : "+s"(w));
    unsigned z = 0u; asm volatile("" : "+v"(z));
    int l = (int)__builtin_amdgcn_mbcnt_hi(~0u, __builtin_amdgcn_mbcnt_lo(~0u, z)); asm volatile("" : "+v"(l));
    return (w << 6) | l;
}
namespace pg8 {
#define PG8_LAS __attribute__((address_space(3)))
typedef unsigned short bf16_t;
typedef short bf16x8 __attribute__((ext_vector_type(8)));
typedef float f32x4 __attribute__((ext_vector_type(4)));
typedef unsigned u32x4 __attribute__((ext_vector_type(4)));
constexpr int BM = 256, BK = 64, HALF = 128, HTB = HALF * BK * 2  , STAGE_BYTES = 8 * HTB, NXCD = 8, WGM = 8;

__host__ __device__ __forceinline__ int lds_byte(int r, int c) { const int st = (r >> 4) * 2 + (c >> 5), rr = r & 15, cc = c & 31, ob = rr * 64 + cc * 2; return st * 1024 + (ob ^ (((ob >> 9) & 1) << 5)); }
__host__ __device__ __forceinline__ void stage_rc(int b, int& R, int& C) { const int st = b / 1024, sb = b % 1024, swz = sb ^ (((sb >> 9) & 1) << 5); R = (st >> 1) * 16 + swz / 64; C = (st & 1) * 32 + (swz % 64) / 2; }
__host__ __device__ __forceinline__ int perm32(int rho) { const int n = rho >> 4, i = rho & 15; return 8 * (i >> 2) + 4 * n + (i & 3); }

struct Unit { int pm, pn, kofs, nt, tag = 0; };
struct Gemm { const bf16_t* A; const bf16_t* Bt; int M, N, K; int a_blocked = 0, b_blocked = 0; };

struct StaticOrder {
    int nM, nN, nwg, G, c, i_off = 0, i_cnt = 1 << 30;
    __host__ __device__ void init(int M, int N, int G_, int c_) { nM = M / BM; nN = N / BM; nwg = nM * nN; G = G_; c = c_; }
    __host__ __device__ bool next(int i_, Unit& u) const {
        if (i_ >= i_cnt) return false; const int i = i_ + i_off;
        const long L = (long)i * G + c; if (L >= nwg) return false;
        map((int)L, u); return true;
    }
    __host__ __device__ void map(int L, Unit& u) const {
        int wgid = L; { const int q = nwg / NXCD, r = nwg % NXCD, xcd = wgid % NXCD, off = wgid / NXCD; wgid = (xcd < r ? xcd * (q + 1) : r * (q + 1) + (xcd - r) * q) + off; }
        const int nig = WGM * nN, gid = wgid / nig, fm = gid * WGM, gsz = (nM - fm) < WGM ? (nM - fm) : WGM;
        u.pm = fm + ((wgid % nig) % gsz); u.pn = (wgid % nig) / gsz; u.kofs = 0; u.nt = 0;
    }
    __host__ __device__ int block_of(int pm, int pn) const {
        const int nig = WGM * nN, gid = pm / WGM, fm = gid * WGM, gsz = (nM - fm) < WGM ? (nM - fm) : WGM, wgid = gid * nig + pn * gsz + (pm - fm);
        const int q = nwg / NXCD, r = nwg % NXCD; int xcd, off;
        if (wgid < r * (q + 1)) { xcd = wgid / (q + 1); off = wgid % (q + 1); } else { const int w2 = wgid - r * (q + 1); xcd = r + w2 / q; off = w2 % q; }
        return off * NXCD + xcd;
    }
    __device__ __forceinline__ void a_ready(const Unit&) const {}
    __device__ __forceinline__ void done(const Unit&) const {}
};

struct TailProbeOrder {
    StaticOrder base;
    __host__ __device__ void init(int M, int N, int G_, int c_) { base.init(M, N, G_, c_); }
    __host__ __device__ bool next(int i, Unit& u) const {
        if (base.next(i, u)) return true;
        const int r0 = (base.nwg - base.c + base.G - 1) / base.G;
        const int rmax = (base.nwg + base.G - 1) / base.G;
        if (i == r0 && r0 == rmax && base.c < 16) return base.next(0, u);
        return false;
    }
    __device__ __forceinline__ void a_ready(const Unit&) const {}
    __device__ __forceinline__ void done(const Unit&) const {}
};
struct SplitCtxOrder {
    StaticOrder base; int nxu, nct, nN, nslice, slice_k, G, c;
    __host__ __device__ void init(int Mx, int Mc, int N, int K, int nslice_, int G_, int c_) { base.init(Mx, N, G_, c_); nxu = base.nwg; nN = N / BM; nct = Mc / BM; nslice = nslice_; slice_k = K / nslice_; G = G_; c = c_; }
    __host__ __device__ bool next(int i, Unit& u) const {
        const long L = (long)i * G + c;
        if (L < nxu) return base.next(i, u);
        const int q = (int)(L - nxu); if (q >= nct * nN * nslice) return false;
        const int t = q / nslice, s = q % nslice; u.pm = base.nM + t / nN; u.pn = t % nN; u.kofs = s * slice_k; u.nt = slice_k / BK; return true;
    }
    __device__ __forceinline__ void a_ready(const Unit&) const {}
    __device__ __forceinline__ void done(const Unit&) const {}
};

struct ClusterCtxOrder {
    static constexpr bool PUBLISH = false;
    int nM, nN, nxu, nct, nslice, slice_k, G, c;
    __host__ __device__ void init(int Mx, int Mc, int N, int K, int nslice_, int G_, int c_) { nM = Mx / BM; nN = N / BM; nxu = nM * nN; nct = Mc / BM; nslice = nslice_; slice_k = K / nslice_; G = G_; c = c_; }
    __host__ __device__ void map(int L, Unit& u) const { int wgid = L; { const int q = nxu / NXCD, r = nxu % NXCD, xcd = wgid % NXCD, off = wgid / NXCD; wgid = (xcd < r ? xcd * (q + 1) : r * (q + 1) + (xcd - r) * q) + off; }
        u.pm = wgid / nN; u.pn = wgid % nN; u.kofs = 0; u.nt = 0; }
    __host__ __device__ int owner(int pm, int pn) const { const int wgid = pm * nN + pn, q = nxu / NXCD, r = nxu % NXCD; int xcd, off;
        if (wgid < r * (q + 1)) { xcd = wgid / (q + 1); off = wgid % (q + 1); } else { const int w2 = wgid - r * (q + 1); xcd = r + w2 / q; off = w2 % q; }
        return (off * NXCD + xcd) % G; }
    __host__ __device__ bool next(int i, Unit& u) const {
        const long L = (long)i * G + c;
        if (L < nxu) { map((int)L, u); return true; }
        const int q = (int)(L - nxu); if (q >= nct * nN * nslice) return false;
        const int t = q / nslice, s = q % nslice; u.pm = nM + t / nN; u.pn = t % nN; u.kofs = s * slice_k; u.nt = slice_k / BK; return true;
    }
    __device__ __forceinline__ void a_ready(const Unit&) const {}
    __device__ __forceinline__ void done(const Unit&) const {}
};

struct ClusterUpOrder {
    static constexpr bool PUBLISH = false;
    int nN, nct, G, c; unsigned* count2;
    __host__ __device__ void init(int N, int Mc, int G_, int c_, unsigned* count2_) { nN = N / BM; nct = Mc / BM; G = G_; c = c_; count2 = count2_; }
    __host__ __device__ bool next(int i, Unit& u) const {
        const int x = c & 7, w = (c >> 3) & 7, k = c >> 6, per = nN / 4, nr = 2 * per;
        if (i < nr) { const int rp = i / per, cgp = i % per; u.pm = 16 * x + 4 * (2 * rp + (w & 1)) + k; u.pn = 4 * cgp + (w >> 1); u.kofs = 0; u.nt = 0; return true; }
        const int q = (i - nr) * G + c; if (q >= nct * nN) return false;
        u.pm = 128 + q / nN; u.pn = q % nN; u.kofs = 0; u.nt = 0; return true;
    }
    __device__ __forceinline__ void a_ready(const Unit& u) const {
        if (u.pm >= 128) { unsigned sp = 0u;
            while ((unsigned)__builtin_amdgcn_readfirstlane((int)__hip_atomic_load(count2, __ATOMIC_RELAXED, __HIP_MEMORY_SCOPE_AGENT)) < (unsigned)G) { __builtin_amdgcn_s_sleep(2); if (++sp > (1u << 20)) break; }
            __builtin_amdgcn_fence(__ATOMIC_ACQUIRE, "agent"); }
    }
    __device__ __forceinline__ void done(const Unit&) const {}
};

struct ConvMergedOrder {
    static constexpr bool PUBLISH = false;
    StaticOrder sb, sc; int nbt, G, c; unsigned* flags;
    __host__ __device__ void init(int M, int NB, int NC, int G_, int c_, unsigned* flags_) { sb.init(M, NB, G_, c_); sc.init(M, NC, G_, c_); nbt = sb.nwg; G = G_; c = c_; flags = flags_; }
    __host__ __device__ bool next(int i, Unit& u) const {
        const long L = (long)i * G + c;
        if (L < nbt) { sb.map((int)L, u); u.tag = (i >= 3 || L + G >= nbt) ? 1 : 0; return true; }
        if (L - nbt >= sc.nwg) return false;
        sc.map((int)(L - nbt), u); u.pn += sb.nN; u.tag = 0; return true;
    }
    __device__ __forceinline__ void a_ready(const Unit&) const {}
    __device__ __forceinline__ void done(const Unit& u) const {
        if (u.tag) {
            asm volatile("s_waitcnt vmcnt(0)" ::: "memory");
            unsigned z = 0u; asm volatile("" : "+v"(z)); unsigned old = 0u;
            if (__builtin_amdgcn_mbcnt_hi(~0u, __builtin_amdgcn_mbcnt_lo(~0u, z)) == 0u) old = __hip_atomic_fetch_add(flags + c, 1u, __ATOMIC_RELAXED, __HIP_MEMORY_SCOPE_AGENT);
            old = (unsigned)__builtin_amdgcn_readfirstlane((int)old);
            if ((old & 7u) == 7u) {
                __builtin_amdgcn_fence(__ATOMIC_RELEASE, "agent"); asm volatile("s_waitcnt vmcnt(0)" ::: "memory");
                __hip_atomic_store(flags + 512 + c, (old + 1u) >> 3, __ATOMIC_RELAXED, __HIP_MEMORY_SCOPE_AGENT); }
        }
    }
};
__device__ __forceinline__ unsigned cvt_pk_bf16(float lo, float hi) { unsigned r; asm volatile("v_cvt_pk_bf16_f32 %0, %1, %2" : "=v"(r) : "v"(lo), "v"(hi)); return r; }
typedef float f32x2 __attribute__((ext_vector_type(2)));
__device__ __forceinline__ f32x2 gelu_pk(f32x2 v) {
    const f32x2 av = __builtin_elementwise_abs(v), d = av * 0.2316418882f + 1.0f;
    f32x2 t; t.x = __builtin_amdgcn_rcpf(d.x); t.y = __builtin_amdgcn_rcpf(d.y);
    f32x2 q = t * 0.5307027145f + (-0.7265760135f); q = q * t + 0.7107068705f; q = q * t + (-0.142248368f); q = q * t + 0.127414796f; q = q * t;
    const f32x2 s = (v * v) * (-0.72134752044f);
    f32x2 e; e.x = __builtin_amdgcn_exp2f(s.x); e.y = __builtin_amdgcn_exp2f(s.y);
    const f32x2 m = v * (q * e), r = v - m;
    f32x2 o; o.x = v.x < 0.f ? m.x : r.x; o.y = v.y < 0.f ? m.y : r.y; return o;
}

template <int ACT  > struct EpiBf16 {
    static constexpr bool PERM = true, AFTER_DRAIN = false; static_assert(ACT == 0 || ACT == 1, "EpiBf16: ACT is 0 (none) or 1 (gelu_pk)");
    bf16_t* O; int ldc; const float* bias; int split_cols; size_t split_stride; float scale0;
    __device__ __forceinline__ void operator()(const f32x4 (&acc)[2][2][4][2], const Unit& u, int wr, int wc, int fr, int fq) const {
        const int row0 = u.pm * BM + wr * 64 + fr; int colt = u.pn * BM; bf16_t* base = O;
        float sc = 1.f; if (split_cols) { const int t = colt / split_cols; base += (size_t)t * split_stride; colt -= t * split_cols; if (t == 0) sc = scale0; }
        const int col0 = colt + wc * 32 + 8 * fq, bcol0 = u.pn * BM + wc * 32 + 8 * fq;
        f32x4 bv[2][2];
#pragma unroll
        for (int bj = 0; bj < 2; ++bj)
#pragma unroll
            for (int n = 0; n < 2; ++n) bv[bj][n] = bias ? *(const f32x4*)(bias + bcol0 + bj * HALF + 4 * n) : (f32x4){0.f, 0.f, 0.f, 0.f};
#pragma unroll
        for (int ai = 0; ai < 2; ++ai)
#pragma unroll
            for (int m = 0; m < 4; ++m) { bf16_t* rowp = base + (size_t)(row0 + ai * HALF + m * 16) * ldc + col0;
#pragma unroll
                for (int bj = 0; bj < 2; ++bj) { f32x4 v0 = acc[ai][bj][m][0] + bv[bj][0], v1 = acc[ai][bj][m][1] + bv[bj][1];
                    if (ACT == 1) { f32x2 a = gelu_pk((f32x2){v0[0], v0[1]}), b = gelu_pk((f32x2){v0[2], v0[3]}), c = gelu_pk((f32x2){v1[0], v1[1]}), d = gelu_pk((f32x2){v1[2], v1[3]});
                        v0 = (f32x4){a.x, a.y, b.x, b.y}; v1 = (f32x4){c.x, c.y, d.x, d.y}; }
                    v0 = v0 * sc; v1 = v1 * sc; u32x4 w; w.x = cvt_pk_bf16(v0[0], v0[1]); w.y = cvt_pk_bf16(v0[2], v0[3]); w.z = cvt_pk_bf16(v1[0], v1[1]); w.w = cvt_pk_bf16(v1[2], v1[3]);
                    *(u32x4*)(rowp + bj * HALF) = w; } }
    }
};

struct EpiF32 {
    static constexpr bool PERM = false, AFTER_DRAIN = false;
    float* C; int ldc;
    __device__ __forceinline__ void operator()(const f32x4 (&acc)[2][2][4][2], const Unit& u, int wr, int wc, int fr, int fq) const {
        const int row0 = u.pm * BM + wr * 64 + fr, col0 = u.pn * BM + wc * 32 + 4 * fq;
#pragma unroll
        for (int ai = 0; ai < 2; ++ai)
#pragma unroll
            for (int m = 0; m < 4; ++m) { float* rowp = C + (size_t)(row0 + ai * HALF + m * 16) * ldc + col0;
#pragma unroll
                for (int bj = 0; bj < 2; ++bj)
#pragma unroll
                    for (int n = 0; n < 2; ++n) *(f32x4*)(rowp + bj * HALF + n * 16) = acc[ai][bj][m][n]; }
    }
};
typedef _Float16 f16x8 __attribute__((ext_vector_type(8)));
typedef _Float16 f16x4 __attribute__((ext_vector_type(4)));
struct EpiResid {
    static constexpr bool PERM = true, AFTER_DRAIN = false;
    const float* src32; const _Float16* srcT; _Float16* dstT; float* dstC; const float* gate; float alpha;
    const float* stats; const float* gam; const float* bet;
    __device__ __forceinline__ void operator()(const f32x4 (&acc)[2][2][4][2], const Unit& u, int wr, int wc, int fr_, int fq_) const {
        int fr = fr_, fq = fq_; asm volatile("" : "+v"(fr), "+v"(fq));
        const int col0 = u.pn * BM + wc * 32 + 8 * fq;
        if (u.pm >= 128) {
            const int rowc = (u.pm - 128) * BM + wr * 64 + fr;
#pragma unroll
            for (int bj = 0; bj < 2; ++bj)
#pragma unroll
                for (int n = 0; n < 2; ++n) { const int c = col0 + bj * HALF + 4 * n; const f32x4 gv = *(const f32x4*)(gate + 2 * 12288 + c);
#pragma unroll
                    for (int ai = 0; ai < 2; ++ai)
#pragma unroll
                        for (int m = 0; m < 4; ++m) { float* dp = dstC + ((size_t)(u.kofs >> 9) * 512 + (size_t)(rowc + ai * HALF + m * 16)) * 2048 + c; *(f32x4*)dp = gv * acc[ai][bj][m][n]; } }
            return;
        }
        const int rt = u.pm < 64 ? 0 : 1;
        const int row0 = u.pm * BM + wr * 64 + fr;
        const float* st = stats ? stats + 2 * (size_t)row0 : nullptr;
#pragma unroll
        for (int bj = 0; bj < 2; ++bj) {
            const int c = col0 + bj * HALF;
            const f32x4 gv0 = *(const f32x4*)(gate + rt * 12288 + c), gv1 = *(const f32x4*)(gate + rt * 12288 + c + 4);
            f32x4 ga0 = {alpha, alpha, alpha, alpha}, ga1 = ga0, ba0 = {0.f, 0.f, 0.f, 0.f}, ba1 = ba0;
            if (st) { ga0 = *(const f32x4*)(gam + c) * alpha; ga1 = *(const f32x4*)(gam + c + 4) * alpha; ba0 = *(const f32x4*)(bet + c) * alpha; ba1 = *(const f32x4*)(bet + c + 4) * alpha; }
#pragma unroll
            for (int ai = 0; ai < 2; ++ai)
#pragma unroll
                for (int m = 0; m < 4; ++m) { const size_t off = (size_t)(row0 + ai * HALF + m * 16) * 2048 + c;
                    f32x4 x0, x1;
                    if (src32) { x0 = *(const f32x4*)(src32 + off); x1 = *(const f32x4*)(src32 + off + 4); }
                    else { const f16x8 t = *(const f16x8*)(srcT + off); x0 = (f32x4){(float)t[0], (float)t[1], (float)t[2], (float)t[3]}; x1 = (f32x4){(float)t[4], (float)t[5], (float)t[6], (float)t[7]}; }
                    if (st) { const f32x2 ms = *(const f32x2*)(st + 2 * (ai * HALF + m * 16)); x0 = (x0 - ms.x) * ms.y; x1 = (x1 - ms.x) * ms.y; }
                    const f32x4 o0 = x0 * ga0 + ba0 + gv0 * acc[ai][bj][m][0], o1 = x1 * ga1 + ba1 + gv1 * acc[ai][bj][m][1];
                    const f16x8 w = {(_Float16)o0[0], (_Float16)o0[1], (_Float16)o0[2], (_Float16)o0[3], (_Float16)o1[0], (_Float16)o1[1], (_Float16)o1[2], (_Float16)o1[3]};
                    *(f16x8*)(dstT + off) = w; }
            asm volatile("" ::: "memory");
        }
    }
};
template <int CTRL> __device__ __forceinline__ float dppf(float old, float src) {
    return __builtin_bit_cast(float, __builtin_amdgcn_update_dpp(__builtin_bit_cast(int, old), __builtin_bit_cast(int, src), CTRL, 0xf, 0xf, false)); }
template <int CTRL> __device__ __forceinline__ float dppz(float src) {
    return __builtin_bit_cast(float, __builtin_amdgcn_update_dpp(0, __builtin_bit_cast(int, src), CTRL, 0xf, 0xf, true)); }
__device__ __forceinline__ float silu_e(float x) { return x * __builtin_amdgcn_rcpf(1.0f + __builtin_amdgcn_exp2f(-1.4426950408889634f * x)); }
struct EpiConvAct {
    static constexpr bool PERM = true, AFTER_DRAIN = false;
    bf16_t* ACT; float* HALO; const float* cw; const float* cb; unsigned halo_bytes;
    __device__ __forceinline__ void operator()(f32x4 (&acc)[2][2][4][2], const Unit& u, int wr, int wc, int fr_, int fq_) const {
        int fr = fr_, fq = fq_; asm volatile("" : "+v"(fr), "+v"(fq));
        constexpr int ROW_SHL1 = 0x101, ROW_SHL15 = 0x10F, ROW_SHR1 = 0x111, ROW_SHR15 = 0x11F;
        const int f0 = u.pn * 128 + wc * 32 + 8 * fq;
#define DPZ4(CTRL, SRC) (f32x4){dppz<CTRL>((SRC)[0]), dppz<CTRL>((SRC)[1]), dppz<CTRL>((SRC)[2]), dppz<CTRL>((SRC)[3])}
#define DPP4(CTRL, OLD, SRC) (f32x4){dppf<CTRL>((OLD)[0], (SRC)[0]), dppf<CTRL>((OLD)[1], (SRC)[1]), dppf<CTRL>((OLD)[2], (SRC)[2]), dppf<CTRL>((OLD)[3], (SRC)[3])}
        const f32x4 z4 = {0.f, 0.f, 0.f, 0.f};
        const __amdgpu_buffer_rsrc_t hrs = __builtin_amdgcn_make_buffer_rsrc(HALO, 0, (int)halo_bytes, 0x00020000);
        const int etop = (fr == 0) ? 0 : -4096, ebot = (fr == 15) ? 0 : -4096;
        f32x4 W0[2][2], W1[2][2], W2[2][2], BB[2][2];
#pragma unroll
        for (int bj = 0; bj < 2; ++bj)
#pragma unroll
            for (int n = 0; n < 2; ++n) { const float* wp = cw + bj * 5632 + f0 + 4 * n;
                W0[bj][n] = *(const f32x4*)(wp); W1[bj][n] = *(const f32x4*)(wp + 11264); W2[bj][n] = *(const f32x4*)(wp + 2 * 11264); BB[bj][n] = *(const f32x4*)(cb + bj * 5632 + f0 + 4 * n); }
#pragma unroll
        for (int bj = 0; bj < 2; ++bj)
#pragma unroll
            for (int n = 0; n < 2; ++n) {
                const f32x4 w0 = W0[bj][n], w1 = W1[bj][n], w2 = W2[bj][n], bb = BB[bj][n];
#pragma unroll
                for (int ai = 0; ai < 2; ++ai) {
                    const int hoff = (((4 * u.pm + 2 * ai + wr) * 2816 + ((bj * 5632 + f0) >> 2) + n) * 64);
                    f32x4 prev = z4;
#pragma unroll
                    for (int m = 0; m < 4; ++m) {
                        const f32x4 raw = acc[ai][bj][m][n];
                        f32x4 edge = bb;
                        if (m > 0) edge = edge + w0 * DPZ4(ROW_SHL15, prev);
                        if (m < 3) { const f32x4 nx = acc[ai][bj][m + 1][n]; edge = edge + w2 * DPZ4(ROW_SHR15, nx); }
                        const f32x4 c = w0 * DPZ4(ROW_SHR1, raw) + (w2 * DPZ4(ROW_SHL1, raw) + (w1 * raw + edge));
                        if (m == 0) { __builtin_amdgcn_raw_buffer_store_b128(__builtin_bit_cast(u32x4, raw), hrs, (hoff | etop), 0, 0); __builtin_amdgcn_raw_buffer_store_b128(__builtin_bit_cast(u32x4, c), hrs, ((hoff + 16) | etop), 0, 0); }
                        if (m == 3) { __builtin_amdgcn_raw_buffer_store_b128(__builtin_bit_cast(u32x4, raw), hrs, ((hoff + 32) | ebot), 0, 0); __builtin_amdgcn_raw_buffer_store_b128(__builtin_bit_cast(u32x4, c), hrs, ((hoff + 48) | ebot), 0, 0); }
                        acc[ai][bj][m][n] = c; prev = raw;
                        __builtin_amdgcn_sched_barrier(0);
                    }
                }
            }
#undef DPP4
#undef DPZ4
        const int row0 = u.pm * BM + wr * 64 + fr;
#pragma unroll
        for (int ai = 0; ai < 2; ++ai)
#pragma unroll
            for (int m = 0; m < 4; ++m) {
                u32x4 w;
                { const f32x4 g = acc[ai][0][m][0], v = acc[ai][1][m][0]; w.x = cvt_pk_bf16(silu_e(g[0]) * v[0], silu_e(g[1]) * v[1]); w.y = cvt_pk_bf16(silu_e(g[2]) * v[2], silu_e(g[3]) * v[3]); }
                { const f32x4 g = acc[ai][0][m][1], v = acc[ai][1][m][1]; w.z = cvt_pk_bf16(silu_e(g[0]) * v[0], silu_e(g[1]) * v[1]); w.w = cvt_pk_bf16(silu_e(g[2]) * v[2], silu_e(g[3]) * v[3]); }
                { const int r_ = row0 + ai * HALF + m * 16; *(u32x4*)(ACT + ((size_t)((r_ >> 8) * 88 + (f0 >> 6)) * 256 + (r_ & 255)) * 64 + (f0 & 63)) = w; }
            }
    }
};

template <bool COH_B = false> struct EpiConvGateT {
    static constexpr bool PERM = true, AFTER_DRAIN = false;
    bf16_t* OUT; float* HALO; const bf16_t* Bb; const float* cw; unsigned halo_bytes;
    __device__ __forceinline__ void operator()(f32x4 (&acc)[2][2][4][2], const Unit& u, int wr, int wc, int fr_, int fq_) const {
        int fr = fr_, fq = fq_; asm volatile("" : "+v"(fr), "+v"(fq));
        constexpr int ROW_SHL1 = 0x101, ROW_SHL15 = 0x10F, ROW_SHR1 = 0x111, ROW_SHR15 = 0x11F;
        const int f0 = u.pn * 128 + wc * 32 + 8 * fq;
#define DPZ4(CTRL, SRC) (f32x4){dppz<CTRL>((SRC)[0]), dppz<CTRL>((SRC)[1]), dppz<CTRL>((SRC)[2]), dppz<CTRL>((SRC)[3])}
        const f32x4 z4 = {0.f, 0.f, 0.f, 0.f};
        const __amdgpu_buffer_rsrc_t hrs = __builtin_amdgcn_make_buffer_rsrc(HALO, 0, (int)halo_bytes, 0x00020000);
        const int etop = (fr == 0) ? 0 : -4096, ebot = (fr == 15) ? 0 : -4096;
        f32x4 W0[2], W1[2], W2[2];
#pragma unroll
        for (int n = 0; n < 2; ++n) { W0[n] = *(const f32x4*)(cw + f0 + 4 * n); W1[n] = *(const f32x4*)(cw + 2048 + f0 + 4 * n); W2[n] = *(const f32x4*)(cw + 4096 + f0 + 4 * n); }
#pragma unroll
        for (int n = 0; n < 2; ++n) {
            const f32x4 w0 = W0[n], w1 = W1[n], w2 = W2[n];
#pragma unroll
            for (int ai = 0; ai < 2; ++ai) {
                const int hoff = (((4 * u.pm + 2 * ai + wr) * 512 + (f0 >> 2) + n) * 64);
#pragma unroll
                for (int m = 0; m < 4; ++m) acc[ai][0][m][n] = acc[ai][0][m][n] * acc[ai][1][m][n];
                f32x4 prev = z4;
#pragma unroll
                for (int m = 0; m < 4; ++m) {
                    const f32x4 raw = acc[ai][0][m][n];
                    f32x4 edge = z4;
                    if (m > 0) edge = edge + w0 * DPZ4(ROW_SHL15, prev);
                    if (m < 3) { const f32x4 nx = acc[ai][0][m + 1][n]; edge = edge + w2 * DPZ4(ROW_SHR15, nx); }
                    const f32x4 c = w0 * DPZ4(ROW_SHR1, raw) + (w2 * DPZ4(ROW_SHL1, raw) + (w1 * raw + edge));
                    if (m == 0) { __builtin_amdgcn_raw_buffer_store_b128(__builtin_bit_cast(u32x4, raw), hrs, (hoff | etop), 0, 0); __builtin_amdgcn_raw_buffer_store_b128(__builtin_bit_cast(u32x4, c), hrs, ((hoff + 16) | etop), 0, 0); }
                    if (m == 3) { __builtin_amdgcn_raw_buffer_store_b128(__builtin_bit_cast(u32x4, raw), hrs, ((hoff + 32) | ebot), 0, 0); __builtin_amdgcn_raw_buffer_store_b128(__builtin_bit_cast(u32x4, c), hrs, ((hoff + 48) | ebot), 0, 0); }
                    acc[ai][1][m][n] = c; prev = raw;
                    __builtin_amdgcn_sched_barrier(0);
                }
            }
        }
#undef DPZ4
        const int row0 = u.pm * BM + wr * 64 + fr;
#pragma unroll
        for (int ai = 0; ai < 2; ++ai)
#pragma unroll
            for (int m = 0; m < 4; ++m) { const size_t off = (size_t)(row0 + ai * HALF + m * 16) * 2048 + f0;
                u32x4 bw;
                if constexpr (COH_B) { const unsigned long long* bp_ = (const unsigned long long*)(Bb + off);
                    const unsigned long long q0 = __hip_atomic_load(bp_, __ATOMIC_RELAXED, __HIP_MEMORY_SCOPE_AGENT), q1 = __hip_atomic_load(bp_ + 1, __ATOMIC_RELAXED, __HIP_MEMORY_SCOPE_AGENT);
                    bw = (u32x4){(unsigned)q0, (unsigned)(q0 >> 32), (unsigned)q1, (unsigned)(q1 >> 32)}; }
                else bw = *(const u32x4*)(Bb + off);
                const f32x4 z0 = acc[ai][1][m][0], z1 = acc[ai][1][m][1];
                u32x4 w;
                w.x = cvt_pk_bf16(__uint_as_float(bw.x << 16) * z0[0], __uint_as_float(bw.x & 0xffff0000u) * z0[1]); w.y = cvt_pk_bf16(__uint_as_float(bw.y << 16) * z0[2], __uint_as_float(bw.y & 0xffff0000u) * z0[3]);
                w.z = cvt_pk_bf16(__uint_as_float(bw.z << 16) * z1[0], __uint_as_float(bw.z & 0xffff0000u) * z1[1]); w.w = cvt_pk_bf16(__uint_as_float(bw.w << 16) * z1[2], __uint_as_float(bw.w & 0xffff0000u) * z1[3]);
                *(u32x4*)(OUT + off) = w; }
    }
};

typedef EpiConvGateT<false> EpiConvGate;
struct EpiConvBoth {
    static constexpr bool PERM = true, AFTER_DRAIN = false;
    EpiBf16<0> eb; EpiConvGateT<true> eg; StaticOrder sb; unsigned* flags; unsigned* tmo; int G;
    __device__ __forceinline__ void operator()(f32x4 (&acc)[2][2][4][2], const Unit& u, int wr, int wc, int fr, int fq) const {
        if (u.pn < 8) { eb(acc, u, wr, wc, fr, fq); return; }
        { const int Lo = sb.block_of(u.pm, (u.pn - 8) >> 1), co = Lo % G, ro = Lo / G, lasto = (sb.nwg - 1 - co) / G;
          const unsigned need = lasto >= 3 ? (unsigned)((ro > 3 ? ro : 3) - 2) : 1u;
          unsigned* f = flags + 512 + co; unsigned sp = 0u;
          while ((unsigned)__builtin_amdgcn_readfirstlane((int)__hip_atomic_load(f, __ATOMIC_RELAXED, __HIP_MEMORY_SCOPE_AGENT)) < need) { __builtin_amdgcn_s_sleep(1);
              if ((++sp & 255u) == 0u) { if (__hip_atomic_load(tmo, __ATOMIC_RELAXED, __HIP_MEMORY_SCOPE_AGENT)) break; if (sp > (1u << 18)) { (void)__hip_atomic_fetch_add(tmo, 1u, __ATOMIC_RELAXED, __HIP_MEMORY_SCOPE_AGENT); break; } } }
        }
        Unit u2 = u; u2.pn = u.pn - 8; eg(acc, u2, wr, wc, fr, fq);
    }
};

struct EpiDqkv {
    static constexpr bool PERM = true, AFTER_DRAIN = false;
    bf16_t* CQ; bf16_t* CKV; float* KRRAW; float* SSQ; unsigned ssq_bytes;
    __device__ __forceinline__ void operator()(const f32x4 (&acc)[2][2][4][2], const Unit& u, int wr, int wc, int fr_, int fq_) const {
        int fr = fr_, fq = fq_; asm volatile("" : "+v"(fr), "+v"(fq));
        const int row0 = u.pm * BM + wr * 64 + fr;
        if (u.pn == 4) {
            if (wc < 2) {
#pragma unroll
                for (int ai = 0; ai < 2; ++ai)
#pragma unroll
                    for (int m = 0; m < 4; ++m) { float* p = KRRAW + (size_t)(row0 + ai * HALF + m * 16) * 64 + wc * 32 + 8 * fq;
                        *(f32x4*)p = acc[ai][0][m][0]; *(f32x4*)(p + 4) = acc[ai][0][m][1]; }
            }
            return;
        }
        bf16_t* base = (u.pn < 2 ? CQ : CKV); const int col0 = (u.pn & 1) * BM + wc * 32 + 8 * fq;
        const __amdgpu_buffer_rsrc_t srs = __builtin_amdgcn_make_buffer_rsrc(SSQ, 0, (int)ssq_bytes, 0x00020000);
        const int slot = (u.pn >> 1) * 8 + (u.pn & 1) * 4 + wc, lane = fr + 16 * fq, keep = (fq == 0) ? 0 : -4096;
#pragma unroll
        for (int ai = 0; ai < 2; ++ai)
#pragma unroll
            for (int m = 0; m < 4; ++m) { const int row = row0 + ai * HALF + m * 16; float s = 0.f;
#pragma unroll
                for (int bj = 0; bj < 2; ++bj) { const f32x4 v0 = acc[ai][bj][m][0], v1 = acc[ai][bj][m][1];
                    s += (v0[0] * v0[0] + v0[1] * v0[1]) + (v0[2] * v0[2] + v0[3] * v0[3]) + (v1[0] * v1[0] + v1[1] * v1[1]) + (v1[2] * v1[2] + v1[3] * v1[3]);
                    u32x4 w; w.x = cvt_pk_bf16(v0[0], v0[1]); w.y = cvt_pk_bf16(v0[2], v0[3]); w.z = cvt_pk_bf16(v1[0], v1[1]); w.w = cvt_pk_bf16(v1[2], v1[3]);
                    *(u32x4*)(base + (size_t)row * 512 + col0 + bj * HALF) = w; }
                s += __builtin_bit_cast(float, __builtin_amdgcn_ds_bpermute((lane ^ 16) << 2, __builtin_bit_cast(int, s)));
                s += __builtin_bit_cast(float, __builtin_amdgcn_ds_bpermute((lane ^ 32) << 2, __builtin_bit_cast(int, s)));
                __builtin_amdgcn_raw_buffer_store_b32(__builtin_bit_cast(unsigned, s), srs, ((row * 16 + slot) * 4) | keep, 0, 0); }
    }
};
struct EpiBf16Row {
    static constexpr bool PERM = true, AFTER_DRAIN = false;
    bf16_t* O; int ldc; int split_cols; size_t split_stride; const float* ssq; float eps; int hm_rows;
    __device__ __forceinline__ void operator()(const f32x4 (&acc)[2][2][4][2], const Unit& u, int wr, int wc, int fr_, int fq_) const {
        int fr = fr_, fq = fq_; asm volatile("" : "+v"(fr), "+v"(fq));
        const int row0 = u.pm * BM + wr * 64 + fr; int colt = u.pn * BM; bf16_t* base = O;
        if (split_cols) { const int t = colt / split_cols; base += (size_t)t * split_stride; colt -= t * split_cols; }
        const int col0 = colt + wc * 32 + 8 * fq;
#pragma unroll
        for (int ai = 0; ai < 2; ++ai)
#pragma unroll
            for (int m = 0; m < 4; ++m) { const int row = row0 + ai * HALF + m * 16;
                const f32x4 a = *(const f32x4*)(ssq + (size_t)row * 16), b = *(const f32x4*)(ssq + (size_t)row * 16 + 4);
                const float sc = 1.0f / sqrtf(((a[0] + a[1]) + (a[2] + a[3]) + (b[0] + b[1]) + (b[2] + b[3])) * (1.0f / 512.0f) + eps);
                bf16_t* rowp = hm_rows ? base + ((size_t)(colt >> 7) * hm_rows + row) * 128 + wc * 32 + 8 * fq : base + (size_t)row * ldc + col0;
                const size_t bstep = hm_rows ? (size_t)hm_rows * 128 : (size_t)HALF;
#pragma unroll
                for (int bj = 0; bj < 2; ++bj) { const f32x4 v0 = acc[ai][bj][m][0] * sc, v1 = acc[ai][bj][m][1] * sc;
                    u32x4 w; w.x = cvt_pk_bf16(v0[0], v0[1]); w.y = cvt_pk_bf16(v0[2], v0[3]); w.z = cvt_pk_bf16(v1[0], v1[1]); w.w = cvt_pk_bf16(v1[2], v1[3]);
                    *(u32x4*)(rowp + bj * bstep) = w; } }
    }
};
template <class Epi, class Sched, bool ALIGN_EPI = false, bool SP2 = false>
__device__ __forceinline__ void gemm_phase(PG8_LAS unsigned char* lds, const Gemm g, const Sched& S, const Epi& E, int wave_sgpr) {
    int tid_ = tid_from_wave(wave_sgpr);
    const int tid = tid_, wid = __builtin_amdgcn_readfirstlane(tid >> 6), lane = tid & 63, wr = wid >> 2, wc = wid & 3, fr = lane & 15, fq = lane >> 4;
    const int K = g.K, nt = K / BK;
    unsigned voffA[2], voffB[2];
#pragma unroll
    for (int i = 0; i < 2; ++i) { int R, C; stage_rc(tid * 16 + i * 8192, R, C); const int Rb = Epi::PERM ? ((R & ~31) + perm32(R & 31)) : R;
        voffA[i] = (unsigned)(R * (g.a_blocked ? BK : K) + C) * 2u; voffB[i] = (unsigned)(Rb * (g.b_blocked ? BK : K) + C) * 2u; }
    const size_t kstep = (size_t)(BK * 2);
    const size_t hstep = (size_t)HALF * K * 2;
    const size_t tstep = 2 * hstep;
    const size_t kstepA = g.a_blocked ? (size_t)(BM * BK * 2) : kstep, hstepA = g.a_blocked ? (size_t)(HALF * BK * 2) : hstep, tstepA = g.a_blocked ? (size_t)(K / BK) * (BM * BK * 2) : tstep;
    const size_t kstepB = g.b_blocked ? (size_t)(BM * BK * 2) : kstep, hstepB = g.b_blocked ? (size_t)(HALF * BK * 2) : hstep, tstepB = g.b_blocked ? (size_t)(K / BK) * (BM * BK * 2) : tstep;
#define PG8_BOFS(u_) ((size_t)(u_).pn * tstepB + (g.b_blocked ? (size_t)((u_).kofs / BK) * kstepB : (size_t)(u_).kofs * 2))
#define PG8_AOFS(u_) ((size_t)(u_).pm * tstepA + (g.a_blocked ? (size_t)((u_).kofs / BK) * kstepA : (size_t)(u_).kofs * 2))
    const unsigned ldsw = (unsigned)wid * 1024u;
    const int aoff = lds_byte(wr * 64 + fr, fq * 8), boff = lds_byte(wc * 32 + fr, fq * 8);
#define PG8_SA(b, h) (((b) * 2 + (h)) * HTB)
#define PG8_SB(b, h) ((4 + (b) * 2 + (h)) * HTB)
#define PG8_STAGE(bufoff, gbase, voff) do { _Pragma("unroll") for (int _i = 0; _i < 2; ++_i) \
        __builtin_amdgcn_global_load_lds((const unsigned*)((const char*)(gbase) + (voff)[_i]), (PG8_LAS unsigned*)(lds + (bufoff) + ldsw + _i * 8192), 16, 0, 0); } while (0)
#define PG8_LDA(dst, b, h) do { _Pragma("unroll") for (int m = 0; m < 4; ++m) _Pragma("unroll") for (int k = 0; k < 2; ++k) dst[m][k] = *(const PG8_LAS bf16x8*)(lds + PG8_SA(b, h) + aoff + m * 2048 + k * 1024); } while (0)
#define PG8_LDB(dst, b, h) do { _Pragma("unroll") for (int n = 0; n < 2; ++n) _Pragma("unroll") for (int k = 0; k < 2; ++k) dst[n][k] = *(const PG8_LAS bf16x8*)(lds + PG8_SB(b, h) + boff + n * 2048 + k * 1024); } while (0)
#define PG8_MMA(ai, bj, At, Bt) do { __builtin_amdgcn_s_setprio(1); _Pragma("unroll") for (int m = 0; m < 4; ++m) _Pragma("unroll") for (int n = 0; n < 2; ++n) _Pragma("unroll") for (int k = 0; k < 2; ++k) \
        acc[ai][bj][m][n] = __builtin_amdgcn_mfma_f32_16x16x32_bf16(Bt[n][k], At[m][k], acc[ai][bj][m][n], 0, 0, 0); __builtin_amdgcn_s_setprio(0); } while (0)
#define PG8_WAIT_V(n) asm volatile("s_waitcnt vmcnt(" #n ")" ::: "memory")
#define PG8_WAIT_L(n) asm volatile("s_waitcnt lgkmcnt(" #n ")" ::: "memory")
#define PG8_BAR __builtin_amdgcn_s_barrier()
#define PG8_SCHED __builtin_amdgcn_sched_barrier(0)
    Unit cur, nxt; int ui = 0;
    if (!S.next(0, cur)) return;
    f32x4 acc[2][2][4][2];
#pragma unroll
    for (int a = 0; a < 2; ++a)
#pragma unroll
        for (int b = 0; b < 2; ++b)
#pragma unroll
            for (int m = 0; m < 4; ++m)
#pragma unroll
                for (int n = 0; n < 2; ++n) acc[a][b][m][n] = (f32x4){0.f, 0.f, 0.f, 0.f};
    bf16x8 At[4][2], B0[2][2], B1[2][2];
    const char* cA = (const char*)g.A + PG8_AOFS(cur); const char* cB = (const char*)g.Bt + PG8_BOFS(cur);
    int cnt = cur.nt ? cur.nt : nt;
    S.a_ready(cur);
    if constexpr (SP2) {
        PG8_STAGE(PG8_SB(0, 0), cB, voffB); PG8_STAGE(PG8_SB(0, 1), cB + hstepB, voffB); PG8_STAGE(PG8_SA(0, 0), cA, voffA); PG8_STAGE(PG8_SA(0, 1), cA + hstepA, voffA);
        if (wr == 1) PG8_BAR;
        PG8_WAIT_V(2); PG8_BAR;
        PG8_STAGE(PG8_SB(1, 0), cB + kstepB, voffB); PG8_STAGE(PG8_SA(1, 0), cA + kstepA, voffA); PG8_STAGE(PG8_SB(1, 1), cB + hstepB + kstepB, voffB);
        PG8_WAIT_V(6); PG8_BAR;
    } else {
        PG8_STAGE(PG8_SB(0, 0), cB, voffB); PG8_STAGE(PG8_SA(0, 0), cA, voffA); PG8_STAGE(PG8_SB(0, 1), cB + hstepB, voffB); PG8_STAGE(PG8_SA(0, 1), cA + hstepA, voffA);
        if (wr == 1) PG8_BAR;
        PG8_WAIT_V(4); PG8_BAR;
        PG8_STAGE(PG8_SB(1, 0), cB + kstepB, voffB); PG8_STAGE(PG8_SA(1, 0), cA + kstepA, voffA); PG8_STAGE(PG8_SB(1, 1), cB + hstepB + kstepB, voffB);
        PG8_WAIT_V(6); PG8_BAR;
    }
    for (;;) {
        const bool has_next = S.next(ui + 1, nxt);
        const char* nA = has_next ? (const char*)g.A + PG8_AOFS(nxt) : cA; const char* nB = has_next ? (const char*)g.Bt + PG8_BOFS(nxt) : cB;
        for (int t = 0; t < cnt; t += 2) {
            const bool last = (t == cnt - 2);
            const char* a1 = cA + (size_t)(t + 1) * kstepA;
            const char* a2 = last ? nA : cA + (size_t)(t + 2) * kstepA; const char* b2 = last ? nB : cB + (size_t)(t + 2) * kstepB;
            const char* a3 = a2 + kstepA; const char* b3 = b2 + kstepB;
            if (last && has_next) S.a_ready(nxt);
            if constexpr (SP2) {
            PG8_LDB(B0, 0, 0); PG8_LDB(B1, 0, 1); PG8_SCHED; PG8_LDA(At, 0, 0); PG8_STAGE(PG8_SA(1, 1), a1 + hstepA, voffA);
            PG8_WAIT_V(8); PG8_WAIT_L(0); PG8_BAR; PG8_MMA(0, 0, At, B0); PG8_MMA(0, 1, At, B1); PG8_BAR; PG8_SCHED;
            PG8_LDA(At, 0, 1); PG8_STAGE(PG8_SB(0, 0), b2, voffB); PG8_STAGE(PG8_SB(0, 1), b2 + hstepB, voffB); PG8_STAGE(PG8_SA(0, 0), a2, voffA);
            PG8_WAIT_V(8); PG8_WAIT_L(0); PG8_BAR; PG8_MMA(1, 0, At, B0); PG8_MMA(1, 1, At, B1); PG8_BAR; PG8_SCHED;
            PG8_LDB(B0, 1, 0); PG8_LDB(B1, 1, 1); PG8_SCHED; PG8_LDA(At, 1, 0); PG8_STAGE(PG8_SA(0, 1), a2 + hstepA, voffA);
            PG8_WAIT_V(8); PG8_WAIT_L(0); PG8_BAR; PG8_MMA(0, 0, At, B0); PG8_MMA(0, 1, At, B1); PG8_BAR; PG8_SCHED;
            PG8_LDA(At, 1, 1); PG8_STAGE(PG8_SB(1, 0), b3, voffB); PG8_STAGE(PG8_SB(1, 1), b3 + hstepB, voffB); PG8_STAGE(PG8_SA(1, 0), a3, voffA);
            PG8_WAIT_V(8); PG8_WAIT_L(0); PG8_BAR; PG8_MMA(1, 0, At, B0); PG8_MMA(1, 1, At, B1); PG8_BAR; PG8_SCHED;
            } else {
            PG8_LDB(B0, 0, 0); PG8_SCHED; PG8_LDA(At, 0, 0); PG8_STAGE(PG8_SA(1, 1), a1 + hstepA, voffA);
            PG8_WAIT_L(8); PG8_BAR; PG8_WAIT_L(0); PG8_MMA(0, 0, At, B0); PG8_BAR; PG8_SCHED;
            PG8_LDB(B1, 0, 1); PG8_STAGE(PG8_SB(0, 0), b2, voffB);
            PG8_BAR; PG8_WAIT_L(0); PG8_MMA(0, 1, At, B1); PG8_BAR;
            PG8_LDA(At, 0, 1); PG8_STAGE(PG8_SA(0, 0), a2, voffA);
            PG8_BAR; PG8_WAIT_L(0); PG8_MMA(1, 0, At, B0); PG8_BAR; PG8_SCHED;
            PG8_STAGE(PG8_SB(0, 1), b2 + hstepB, voffB);
            PG8_WAIT_V(6); PG8_BAR; PG8_MMA(1, 1, At, B1); PG8_BAR;
            PG8_LDB(B0, 1, 0); PG8_SCHED; PG8_LDA(At, 1, 0); PG8_STAGE(PG8_SA(0, 1), a2 + hstepA, voffA);
            PG8_WAIT_L(8); PG8_BAR; PG8_WAIT_L(0); PG8_MMA(0, 0, At, B0); PG8_BAR; PG8_SCHED;
            PG8_LDB(B1, 1, 1); PG8_STAGE(PG8_SB(1, 0), b3, voffB);
            PG8_BAR; PG8_WAIT_L(0); PG8_MMA(0, 1, At, B1); PG8_BAR;
            PG8_LDA(At, 1, 1); PG8_STAGE(PG8_SA(1, 0), a3, voffA);
            PG8_BAR; PG8_WAIT_L(0); PG8_MMA(1, 0, At, B0); PG8_BAR; PG8_SCHED;
            PG8_STAGE(PG8_SB(1, 1), b3 + hstepB, voffB);
            PG8_WAIT_V(6); PG8_BAR; PG8_MMA(1, 1, At, B1); PG8_BAR;
            }
        }
        if constexpr (ALIGN_EPI) { if (wr == 0) PG8_BAR; }
        if constexpr (!Epi::AFTER_DRAIN) { E(acc, cur, wr, wc, fr, fq); S.done(cur); }
        if (!has_next) break;
#pragma unroll
        for (int a = 0; a < 2; ++a)
#pragma unroll
            for (int b = 0; b < 2; ++b)
#pragma unroll
                for (int m = 0; m < 4; ++m)
#pragma unroll
                    for (int n = 0; n < 2; ++n) acc[a][b][m][n] = (f32x4){0.f, 0.f, 0.f, 0.f};
        cur = nxt; cA = nA; cB = nB; ++ui; cnt = cur.nt ? cur.nt : nt;
        if constexpr (ALIGN_EPI) { if (wr == 1) PG8_BAR; }
    }
    PG8_WAIT_V(0);
    if constexpr (!ALIGN_EPI) { if (wr == 0) PG8_BAR; }
    PG8_BAR;
    if constexpr (Epi::AFTER_DRAIN) { E.fused(acc, cur, wr, wc, fr, fq, lds, wid, lane); S.done(cur); }
#undef PG8_AOFS
#undef PG8_BOFS
#undef PG8_SA
#undef PG8_SB
#undef PG8_STAGE
#undef PG8_LDA
#undef PG8_LDB
#undef PG8_MMA
#undef PG8_WAIT_V
#undef PG8_WAIT_L
#undef PG8_BAR
#undef PG8_SCHED
}
}

namespace att {
#define ATT_LAS __attribute__((address_space(3)))
typedef unsigned short bf16_t;
using bf16x8 = __attribute__((ext_vector_type(8))) short;
using s16x4  = __attribute__((ext_vector_type(4))) short;
using f32x16 = __attribute__((ext_vector_type(16))) float;
using f32x2  = __attribute__((ext_vector_type(2))) float;
using f32x4  = __attribute__((ext_vector_type(4))) float;
using u32x4  = __attribute__((ext_vector_type(4))) unsigned;
constexpr int NW = 8, QBLK = 32, KVBLK = 64;
constexpr float SCALE = 0.07216878364870323f;
constexpr float THR = 8.f;
constexpr int SDEPTH = ATT_SDEPTH;
constexpr int LDQ = 3072, LDK = 128, LDKR = 64, LDO = 2048;
constexpr int SHM_V = KVBLK * 128 * 2, SHM_K = KVBLK * 128 * 2, SHM_KR = KVBLK * 64 * 2;
constexpr int OFF_V = 0, OFF_K = 2 * SHM_V, OFF_KR = OFF_K + 2 * SHM_K, OFF_WS = OFF_KR + 2 * SHM_KR, OFF_QR = OFF_WS + NW * 64 * 4, ATT_LDS_BYTES = OFF_QR + NW * 4096;
#define KSWZ(row, colB) ((row) * 256 + ((colB) ^ (((row) & 7) << 4)))
#define KRSWZ(row, colB) ((row) * 128 + ((colB) ^ ((((row) >> 1) & 7) << 4)))
#define SBAR() __builtin_amdgcn_sched_barrier(0)
__device__ __forceinline__ int crow(int r, int hi) { return (r & 3) + 8 * (r >> 2) + 4 * hi; }
__device__ __forceinline__ unsigned cvtpk(float lo, float hi) { unsigned r; asm volatile("v_cvt_pk_bf16_f32 %0, %1, %2" : "=v"(r) : "v"(lo), "v"(hi)); return r; }
__device__ __forceinline__ float bf2f(unsigned short b) { return __uint_as_float(((unsigned)b) << 16); }

__device__ __forceinline__ void partialSM(f32x16& p0, f32x16& p1, float& m_reg, float& mn, float& alpha) {
  constexpr float C = SCALE * 1.4426950408889634f;
  float pmax = p0[0];
#pragma unroll
  for (int r = 1; r < 16; ++r) pmax = fmaxf(pmax, p0[r]);
#pragma unroll
  for (int r = 0; r < 16; ++r) pmax = fmaxf(pmax, p1[r]);
  { auto rr = __builtin_amdgcn_permlane32_swap(__float_as_uint(pmax), __float_as_uint(pmax), false, false);
    pmax = fmaxf(__uint_as_float(rr[0]), __uint_as_float(rr[1])); }
  if (__builtin_expect(__all(pmax - m_reg <= THR / SCALE), 1)) { mn = m_reg; alpha = 1.f; }
  else { mn = fmaxf(m_reg, pmax); alpha = __builtin_amdgcn_exp2f((m_reg - mn) * C); m_reg = mn; }
  float mnC = -mn * C;
#pragma unroll
  for (int r = 0; r < 16; ++r) p0[r] = fmaf(p0[r], C, mnC);
#pragma unroll
  for (int r = 0; r < 16; ++r) p1[r] = fmaf(p1[r], C, mnC);
#pragma unroll
  for (int r = 0; r < 16; ++r) p0[r] = __builtin_amdgcn_exp2f(p0[r]);
}
__device__ __forceinline__ void finishSM(f32x16& p0, f32x16& p1, float alpha, float& l_reg, bf16x8& pa0, bf16x8& pa1, bf16x8& pa2, bf16x8& pa3) {
#pragma unroll
  for (int r = 0; r < 16; ++r) p1[r] = __builtin_amdgcn_exp2f(p1[r]);
  float ps = 0;
#pragma unroll
  for (int r = 0; r < 16; ++r) ps += p0[r];
#pragma unroll
  for (int r = 0; r < 16; ++r) ps += p1[r];
  { auto rr = __builtin_amdgcn_permlane32_swap(__float_as_uint(ps), __float_as_uint(ps), false, false);
    ps = __uint_as_float(rr[0]) + __uint_as_float(rr[1]); }
  l_reg = l_reg * alpha + ps;
#define PK4(P, BASE, OUT) do { unsigned a0 = cvtpk(P[BASE + 0], P[BASE + 1]), a1 = cvtpk(P[BASE + 2], P[BASE + 3]);   \
    unsigned b0 = cvtpk(P[BASE + 4], P[BASE + 5]), b1 = cvtpk(P[BASE + 6], P[BASE + 7]);                              \
    auto r0 = __builtin_amdgcn_permlane32_swap(a0, b0, false, false); auto r1 = __builtin_amdgcn_permlane32_swap(a1, b1, false, false); \
    u32x4 w = {r0[0], r1[0], r0[1], r1[1]}; OUT = *reinterpret_cast<bf16x8*>(&w); } while (0)
  PK4(p0, 0, pa0); PK4(p0, 8, pa1); PK4(p1, 0, pa2); PK4(p1, 8, pa3);
#undef PK4
}
__device__ __forceinline__ void qkt(f32x16& p0, f32x16& p1, const ATT_LAS char* Ks, const ATT_LAS char* Kr, const ATT_LAS char* Qr, const bf16x8* qr, int r32, int hi) {
  p0 = f32x16{}; p1 = f32x16{};
#pragma unroll
  for (int d0 = 0; d0 < 8; ++d0) { const int cb = (d0 * 16 + hi * 8) * 2;
    bf16x8 b0 = *reinterpret_cast<const ATT_LAS bf16x8*>(Ks + KSWZ(r32, cb));
    bf16x8 b1 = *reinterpret_cast<const ATT_LAS bf16x8*>(Ks + KSWZ(32 + r32, cb));
    p0 = __builtin_amdgcn_mfma_f32_32x32x16_bf16(b0, qr[d0], p0, 0, 0, 0);
    p1 = __builtin_amdgcn_mfma_f32_32x32x16_bf16(b1, qr[d0], p1, 0, 0, 0); }
#pragma unroll
  for (int d1 = 0; d1 < 4; ++d1) { const int cb = (d1 * 16 + hi * 8) * 2;
    bf16x8 b0 = *reinterpret_cast<const ATT_LAS bf16x8*>(Kr + KRSWZ(r32, cb));
    bf16x8 b1 = *reinterpret_cast<const ATT_LAS bf16x8*>(Kr + KRSWZ(32 + r32, cb));
    bf16x8 qq = *reinterpret_cast<const ATT_LAS bf16x8*>(Qr + KRSWZ(r32, cb));
    p0 = __builtin_amdgcn_mfma_f32_32x32x16_bf16(b0, qq, p0, 0, 0, 0);
    p1 = __builtin_amdgcn_mfma_f32_32x32x16_bf16(b1, qq, p1, 0, 0, 0); }
}
__device__ __forceinline__ int v_st(int k, int c) { const int kk = (k & ~0xC) | ((k & 4) << 1) | ((k & 8) >> 1); return ((kk >> 3) * 4 + (c >> 5)) * 512 + ((kk & 7) * 32 + (c & 31)) * 2; }
__device__ __forceinline__ int v_rd_base(int lane) { return ((lane & 3) << 3) | (((lane >> 2) & 3) << 6) | (((lane >> 4) & 1) << 5) | (((lane >> 5) & 1) << 8); }
constexpr int v_rd_off(int d0, int ks, int half) { return d0 * 512 + ks * 4096 + half * 2048; }
template <int OFF> __device__ __forceinline__ s16x4 tr_read(int vb) {
  s16x4 r; asm volatile("ds_read_b64_tr_b16 %0, %1 offset:%2" : "=&v"(r) : "v"(vb), "i"(OFF) : "memory"); return r;
}
template <int D0> __device__ __forceinline__ void pv_one(f32x16& od, int vb, bf16x8 pa0, bf16x8 pa1, bf16x8 pa2, bf16x8 pa3) {
  const s16x4 l0 = tr_read<v_rd_off(D0, 0, 0)>(vb), h0 = tr_read<v_rd_off(D0, 0, 1)>(vb), l1 = tr_read<v_rd_off(D0, 1, 0)>(vb), h1 = tr_read<v_rd_off(D0, 1, 1)>(vb);
  const s16x4 l2 = tr_read<v_rd_off(D0, 2, 0)>(vb), h2 = tr_read<v_rd_off(D0, 2, 1)>(vb), l3 = tr_read<v_rd_off(D0, 3, 0)>(vb), h3 = tr_read<v_rd_off(D0, 3, 1)>(vb);
  asm volatile("s_waitcnt lgkmcnt(0)" ::: "memory"); SBAR();
#define PK(L, H) (bf16x8){L[0], L[1], L[2], L[3], H[0], H[1], H[2], H[3]}
  od = __builtin_amdgcn_mfma_f32_32x32x16_bf16(pa0, PK(l0, h0), od, 0, 0, 0);
  od = __builtin_amdgcn_mfma_f32_32x32x16_bf16(pa1, PK(l1, h1), od, 0, 0, 0);
  od = __builtin_amdgcn_mfma_f32_32x32x16_bf16(pa2, PK(l2, h2), od, 0, 0, 0);
  od = __builtin_amdgcn_mfma_f32_32x32x16_bf16(pa3, PK(l3, h3), od, 0, 0, 0);
#undef PK
}
__device__ __forceinline__ void pv_d0(f32x16* o, int vb, bf16x8 pa0, bf16x8 pa1, bf16x8 pa2, bf16x8 pa3) {
  pv_one<0>(o[0], vb, pa0, pa1, pa2, pa3); pv_one<1>(o[1], vb, pa0, pa1, pa2, pa3); pv_one<2>(o[2], vb, pa0, pa1, pa2, pa3); pv_one<3>(o[3], vb, pa0, pa1, pa2, pa3);
}

__device__ __forceinline__ void attn_unit(const bf16_t* Qb, const bf16_t* Kh, const bf16_t* Vh, const bf16_t* KRb, bf16_t* Ob,
                                          int xrow0, int nx, int crow0, int NT, int rope, int pos0, const f32x2* ropeR, const f32x2* ropeC, ATT_LAS char* lds, int wave_sgpr) {
  int tid_ = tid_from_wave(wave_sgpr);
  const int tid = tid_, wid = tid >> 6, lane = tid & 63, r32 = lane & 31, hi = lane >> 5;
  ATT_LAS char* V_lds = lds + OFF_V; ATT_LAS char* K_lds = lds + OFF_K; ATT_LAS char* KR_lds = lds + OFF_KR;
  ATT_LAS float* ws = (ATT_LAS float*)(lds + OFF_WS) + wid * 64; ATT_LAS float* li_l = ws; ATT_LAS float* al_l = ws + 32;
  float m_reg = -1e30f, l_reg = 0; f32x16 o[4] = {}; bf16x8 qr[8];
  ATT_LAS char* QR_lds = lds + OFF_QR + wid * 4096;
  const bf16_t* Qw = Qb + (long)(wid * QBLK + r32) * LDQ + hi * 8;
#pragma unroll
  for (int d0 = 0; d0 < 8; ++d0) qr[d0] = *reinterpret_cast<const bf16x8*>(Qw + d0 * 16);
  {
  bf16x8 q8 = *reinterpret_cast<const bf16x8*>(Qw + 8 * 16), q9 = *reinterpret_cast<const bf16x8*>(Qw + 9 * 16), q10 = *reinterpret_cast<const bf16x8*>(Qw + 10 * 16), q11 = *reinterpret_cast<const bf16x8*>(Qw + 11 * 16);
  if (rope) {
    const int pos = pos0 + wid * QBLK + r32; const f32x2* tr = ropeR + (pos >> 6) * 16 + hi * 8; const f32x2* tc = ropeC + (pos & 63) * 16 + hi * 8;
    bf16x8 n8, n9, n10, n11;
#pragma unroll
    for (int e = 0; e < 8; ++e) {
      const f32x2 cr = tr[e], cc = tc[e];
      const float a1 = bf2f((unsigned short)q8[e]), a2 = bf2f((unsigned short)q9[e]), b1 = bf2f((unsigned short)q10[e]), b2 = bf2f((unsigned short)q11[e]);
      const unsigned w0 = cvtpk(a1 * cr.x - a2 * cr.y, a2 * cr.x + a1 * cr.y), w1 = cvtpk(b1 * cc.x - b2 * cc.y, b2 * cc.x + b1 * cc.y);
      n8[e] = (short)(w0 & 0xffffu); n9[e] = (short)(w0 >> 16); n10[e] = (short)(w1 & 0xffffu); n11[e] = (short)(w1 >> 16);
    }
    q8 = n8; q9 = n9; q10 = n10; q11 = n11;
  }
  *(ATT_LAS bf16x8*)(QR_lds + KRSWZ(r32, (0 * 16 + hi * 8) * 2)) = q8; *(ATT_LAS bf16x8*)(QR_lds + KRSWZ(r32, (1 * 16 + hi * 8) * 2)) = q9;
  *(ATT_LAS bf16x8*)(QR_lds + KRSWZ(r32, (2 * 16 + hi * 8) * 2)) = q10; *(ATT_LAS bf16x8*)(QR_lds + KRSWZ(r32, (3 * 16 + hi * 8) * 2)) = q11;
  }
  const int sr = tid >> 4, sc = (tid & 15) * 8, vst0 = v_st(sr, sc), vst1 = v_st(32 + sr, sc);
  const int krs = tid >> 3, krc = (tid & 7) * 8, krst = KRSWZ(krs, krc * 2);
  const int vb0 = (int)(uintptr_t)V_lds + v_rd_base(lane);
  struct { bf16x8 vs0, vs1, ks0, ks1, kr; } sr_[SDEPTH];
#define TROW(j) ((j) < nx ? (long)xrow0 + (long)(j) * KVBLK : (long)crow0 + (long)((j) - nx) * KVBLK)
#define SLOAD(i, j) do { const long _k0 = TROW(j); \
    sr_[i].vs0 = *reinterpret_cast<const bf16x8*>(&Vh[(_k0 + sr) * LDK + sc]); sr_[i].vs1 = *reinterpret_cast<const bf16x8*>(&Vh[(_k0 + 32 + sr) * LDK + sc]); \
    sr_[i].ks0 = *reinterpret_cast<const bf16x8*>(&Kh[(_k0 + sr) * LDK + sc]); sr_[i].ks1 = *reinterpret_cast<const bf16x8*>(&Kh[(_k0 + 32 + sr) * LDK + sc]); \
    sr_[i].kr = *reinterpret_cast<const bf16x8*>(&KRb[(_k0 + krs) * LDKR + krc]); } while (0)
#define SWRITE(b, i) do { *(ATT_LAS bf16x8*)(V_lds + (b) * SHM_V + vst0) = sr_[i].vs0;          \
    *(ATT_LAS bf16x8*)(V_lds + (b) * SHM_V + vst1) = sr_[i].vs1; const int kc = sc * 2;               \
    *(ATT_LAS bf16x8*)(K_lds + (b) * SHM_K + KSWZ(sr, kc)) = sr_[i].ks0;                       \
    *(ATT_LAS bf16x8*)(K_lds + (b) * SHM_K + KSWZ(32 + sr, kc)) = sr_[i].ks1;                  \
    *(ATT_LAS bf16x8*)(KR_lds + (b) * SHM_KR + krst) = sr_[i].kr; } while (0)
#define SWAIT() do { if constexpr (SDEPTH == 2) asm volatile("s_waitcnt vmcnt(5)" ::: "memory"); else asm volatile("s_waitcnt vmcnt(0)" ::: "memory"); } while (0)
#define RESC(a) do { if (__any((a) < 1.f)) { if (hi == 0) al_l[r32] = (a); asm volatile("s_waitcnt lgkmcnt(0)" ::: "memory"); \
    _Pragma("unroll") for (int d = 0; d < 4; ++d) _Pragma("unroll") for (int r = 0; r < 16; ++r) o[d][r] *= al_l[crow(r, hi)]; } } while (0)
  f32x16 pA0, pA1, pB0, pB1; float mnA, mnB, alA, alB; bf16x8 pa0, pa1, pa2, pa3;
  constexpr int SE = 0, SO = SDEPTH - 1;
  SLOAD(SE, 0); asm volatile("s_waitcnt vmcnt(0)" ::: "memory"); SWRITE(0, SE); __syncthreads();
  qkt(pA0, pA1, K_lds, KR_lds, QR_lds, qr, r32, hi); partialSM(pA0, pA1, m_reg, mnA, alA);
  SLOAD(SO, 1); if constexpr (SDEPTH == 2) { if (2 < NT) SLOAD(SE, 2); }
  SWAIT(); SWRITE(1, SO); __syncthreads();
  for (int j = 1; j + 1 < NT; j += 2) {
    SBAR(); qkt(pB0, pB1, K_lds + SHM_K, KR_lds + SHM_KR, QR_lds, qr, r32, hi);
    finishSM(pA0, pA1, alA, l_reg, pa0, pa1, pa2, pa3); SBAR();
    SLOAD(SO, j + SDEPTH); SBAR();
    pv_d0(o, vb0, pa0, pa1, pa2, pa3); partialSM(pB0, pB1, m_reg, mnB, alB);
    __syncthreads(); SWAIT(); SWRITE(0, SE);
    RESC(alB); __syncthreads();
    SBAR(); qkt(pA0, pA1, K_lds, KR_lds, QR_lds, qr, r32, hi);
    finishSM(pB0, pB1, alB, l_reg, pa0, pa1, pa2, pa3); SBAR();
    if (SDEPTH == 1 || j + 3 < NT) SLOAD(SE, j + 1 + SDEPTH); SBAR();
    pv_d0(o, vb0 + SHM_V, pa0, pa1, pa2, pa3); partialSM(pA0, pA1, m_reg, mnA, alA);
    __syncthreads(); SWAIT(); SWRITE(1, SO);
    RESC(alA); __syncthreads();
  }
  SBAR(); qkt(pB0, pB1, K_lds + SHM_K, KR_lds + SHM_KR, QR_lds, qr, r32, hi);
  finishSM(pA0, pA1, alA, l_reg, pa0, pa1, pa2, pa3); SBAR();
  pv_d0(o, vb0, pa0, pa1, pa2, pa3); partialSM(pB0, pB1, m_reg, mnB, alB);
  __syncthreads(); RESC(alB);
  finishSM(pB0, pB1, alB, l_reg, pa0, pa1, pa2, pa3); SBAR();
  pv_d0(o, vb0 + SHM_V, pa0, pa1, pa2, pa3);
  {
  int te = tid_from_wave(wave_sgpr);
  const int widE = te >> 6, r32E = te & 31, hiE = (te >> 5) & 1;
  ATT_LAS float* liE = (ATT_LAS float*)(lds + OFF_WS) + widE * 64;
  if (hiE == 0) liE[r32E] = l_reg; asm volatile("s_waitcnt lgkmcnt(0)" ::: "memory");
  float rli[16];
#pragma unroll
  for (int r = 0; r < 16; ++r) rli[r] = __builtin_amdgcn_rcpf(liE[crow(r, hiE)]);
  bf16_t* Ow = Ob + (long)(widE * QBLK) * LDO + r32E;
#pragma unroll
  for (int r = 0; r < 16; ++r) { const int orow = crow(r, hiE);
#pragma unroll
    for (int d0 = 0; d0 < 4; ++d0) { const unsigned w = cvtpk(o[d0][r] * rli[r], 0.f); Ow[(long)orow * LDO + d0 * 32] = (bf16_t)(w & 0xffffu); } }
  }
  __syncthreads();
#undef TROW
#undef SLOAD
#undef SWRITE
#undef SWAIT
#undef RESC
}
#undef KSWZ
#undef KRSWZ
#undef SBAR
}

constexpr int NWAVES = 8;
constexpr int DM = 2048, BATCH = 2, SEQ = 16384, CTXL = 256, DEPTH = 4, DFF = 5632, NH = 16;
constexpr int M_X = BATCH * SEQ;
constexpr int M_C = BATCH * CTXL;
constexpr int M_T = M_X + M_C;
constexpr int QLR = 512, KVLR = 512, ROPE_D = 64, NDQKV = 1280;
constexpr float LN_EPS = 1e-5f, RMS_EPS = 1e-6f;
constexpr float DN_ALPHA = 1.6817928305074290f;

constexpr size_t MiB = 1u << 20;
constexpr size_t WS_CTL = 0, CTL_ZERO_BYTES = 1 * MiB;
constexpr size_t WS_MOD = 1 * MiB;
constexpr size_t WS_ROPER = WS_MOD + 640 * 1024, WS_ROPEC = WS_MOD + 680 * 1024;
constexpr size_t WS_W = 2 * MiB;
constexpr size_t W_CONV_STRIDE = 32 * MiB, W_WIN = 0, W_WOUT = 24 * MiB;
constexpr size_t W_MLA_BASE = 64 * MiB, W_MLA_STRIDE = 20 * MiB, W_DQKV = 0, W_UQ = 5 * MiB, W_UKV = 8 * MiB, W_WO = 12 * MiB;
constexpr size_t W_FFN_BASE = 104 * MiB, W_FFN_STRIDE = 66 * MiB, W_UP = 0, W_DOWN = 44 * MiB;
constexpr size_t WS_X32C = 370 * MiB;
constexpr size_t WS_BIG = 374 * MiB;
constexpr size_t BIG_BB = 585 * MiB, BIG_HALOC = 132 * MiB, BIG_GATED = 0;
constexpr size_t BIG_KRRAW = 130 * MiB, BIG_SSQ = 140 * MiB;
constexpr size_t BIG_QKVC = 0, BIG_CQ = 163 * MiB, BIG_CKV = 196 * MiB, BIG_KR = 229 * MiB, BIG_Q = 234 * MiB, BIG_K = 429 * MiB, BIG_V = 559 * MiB, BIG_O = 0;
constexpr size_t BIG_CPART = 600 * MiB;
constexpr size_t BIG_HALO = 132 * MiB, BIG_ACT = 234 * MiB;
constexpr size_t WS_ACT = 1089 * MiB;
constexpr size_t WS_STATS = 1220 * MiB;
constexpr size_t WS_T16 = 1222 * MiB;
constexpr size_t WS_END = 1447 * MiB;
static_assert(WS_BIG + 715 * MiB <= WS_ACT && WS_ACT + (size_t)M_T * DM * 2 <= WS_END && BIG_HALO + (size_t)(M_T / 64) * 4 * 11264 * 4 <= BIG_ACT && BIG_ACT + (size_t)M_T * DFF * 2 <= 715 * MiB, "d_ws map");
static_assert(BIG_BB + (size_t)M_T * DM * 2 <= 715 * MiB && BIG_GATED + (size_t)M_T * DM * 2 <= BIG_HALOC && BIG_HALO >= BIG_O + (size_t)M_T * DM * 2, "mixer overlay");
static_assert(BIG_CPART >= BIG_ACT + (size_t)M_T * DFF * 2 && BIG_CPART >= BIG_GATED + (size_t)M_T * DM * 2 && BIG_CPART + (size_t)11 * M_C * DM * 4 <= 715 * MiB, "context planes");
static_assert(BIG_V + (size_t)M_T * 2048 * 2 <= 715 * MiB && BIG_KR + (size_t)M_T * 64 * 2 <= BIG_Q && BIG_QKVC + (size_t)M_T * NDQKV * 4 <= BIG_CQ, "MLA overlay");
constexpr int CW_RLF = 32768, RLF_STRIDE = 1024;
constexpr int CW_TMO = 0, CW_CODE = 1, CW_BAR = 4096, CW_CVF = 20480;

constexpr int RING_OFF = 0, RING_BYTES = 131072;
constexpr int LDSCTL_OFF = RING_BYTES, MISC_OFF = LDSCTL_OFF + 320;
constexpr int LDS_BYTES = 147456;
static_assert(att::ATT_LDS_BYTES <= RING_BYTES, "attention LDS");

#define GAS __attribute__((address_space(1)))
#define LAS __attribute__((address_space(3)))
typedef unsigned short bf16;
typedef unsigned v4u __attribute__((ext_vector_type(4)));
typedef unsigned v2u __attribute__((ext_vector_type(2)));
typedef float f32x4 __attribute__((ext_vector_type(4)));
typedef float f32x2 __attribute__((ext_vector_type(2)));
typedef short bf16x8 __attribute__((ext_vector_type(8)));
typedef _Float16 f16x8 __attribute__((ext_vector_type(8)));
typedef GAS unsigned gu32;
#define RLX_AGENT __ATOMIC_RELAXED, __HIP_MEMORY_SCOPE_AGENT
#define LDS_WAIT() asm volatile("s_waitcnt lgkmcnt(0)" ::: "memory")
#define VM_WAIT() asm volatile("s_waitcnt vmcnt(0)" ::: "memory")
__device__ __forceinline__ unsigned f2bf(float f) { unsigned u = __builtin_bit_cast(unsigned, f); return (u + 0x7fffu + ((u >> 16) & 1u)) >> 16; }
__device__ __forceinline__ unsigned pk2(float lo, float hi) { return f2bf(lo) | (f2bf(hi) << 16); }
__device__ __forceinline__ float bflo(unsigned w) { return __uint_as_float(w << 16); }
__device__ __forceinline__ float bfhi(unsigned w) { return __uint_as_float(w & 0xffff0000u); }
__device__ __forceinline__ float lane_xor(float v, int lane, int o) { return __builtin_bit_cast(float, __builtin_amdgcn_ds_bpermute((lane ^ o) << 2, __builtin_bit_cast(int, v))); }
__device__ __forceinline__ float wave_sum(float v, int lane) {
#pragma unroll
    for (int o = 1; o < 64; o <<= 1) v += lane_xor(v, lane, o);
    return v;
}
__device__ __forceinline__ float silu_f(float x) { return x / (1.0f + __expf(-x)); }
#define XB_TMO      128
#define XB_XCNT(j)  (256  + 64 * (j))
#define XB_XSUB(j)  (1280 + 64 * (j))
#define XB_XGEN(j)  (2304 + 64 * (j))
#define XB_TOP      3328
#define XB_TOPGEN   3392
#define XCD_BAR_WORDS 3456
#define XB_SPIN_CAP (1u << 18)

__device__ __forceinline__ unsigned xb_ld(unsigned* p)              { return __hip_atomic_load(p, __ATOMIC_RELAXED, __HIP_MEMORY_SCOPE_AGENT); }
__device__ __forceinline__ unsigned xb_add(unsigned* p, unsigned v) { return __hip_atomic_fetch_add(p, v, __ATOMIC_RELAXED, __HIP_MEMORY_SCOPE_AGENT); }
__device__ __forceinline__ unsigned xb_xcc_id() { return (unsigned)__builtin_amdgcn_s_getreg((3 << 11) | 20) & 0xFu; }
#define XB_SPIN(cond, bar) do { unsigned _sp = 0; while (cond) { __builtin_amdgcn_s_sleep(1); \
    if ((++_sp & 255u) == 0u) { if (xb_ld(&(bar)[XB_TMO])) break; if (_sp > XB_SPIN_CAP) { atomicAdd(&(bar)[XB_TMO], 1u); break; } } } } while (0)

struct XcdBarrier {
    unsigned* bar; unsigned x;
    volatile LAS unsigned* st;
};

__device__ __forceinline__ XcdBarrier xcd_barrier_post(unsigned* bar, volatile LAS unsigned* st, bool leader) {
    XcdBarrier b; b.bar = bar; b.x = xb_xcc_id(); b.st = st;
    if (leader) (void)xb_add(&bar[XB_XCNT(b.x)], 1u);
    return b;
}
__device__ __forceinline__ void xcd_barrier_complete(unsigned* bar, unsigned x, unsigned& nloc, unsigned& nx) {
    const unsigned G = gridDim.x * gridDim.y * gridDim.z;
    unsigned sum, cnt, mine, sp = 0u;
    for (;;) {
        sum = 0u; cnt = 0u; mine = 0u;
#pragma unroll
        for (unsigned j = 0; j < 16; ++j) { const unsigned c = xb_ld(&bar[XB_XCNT(j)]); sum += c; cnt += (c > 0u) ? 1u : 0u; mine = (j == x) ? c : mine; }
        if (sum == G) break;
        __builtin_amdgcn_s_sleep(1);
        if ((++sp & 255u) == 0u) { if (xb_ld(&bar[XB_TMO])) break; if (sp > XB_SPIN_CAP) { atomicAdd(&bar[XB_TMO], 1u); break; } }
    }
    nloc = mine > 0u ? mine : 1u; nx = cnt > 0u ? cnt : 1u;
}

__device__ __forceinline__ void xcd_barrier(const XcdBarrier& b, bool leader) {
    asm volatile("s_waitcnt vmcnt(0)" ::: "memory");
    __syncthreads();
    if (leader) {
        unsigned* bar = b.bar;
        __builtin_amdgcn_s_waitcnt(0);
        unsigned nloc = b.st[0], nx = b.st[1];
        if (nloc == 0u) { xcd_barrier_complete(bar, b.x, nloc, nx); b.st[0] = nloc; b.st[1] = nx; }
        const unsigned old = xb_add(&bar[XB_XSUB(b.x)], 1u);
        const unsigned gen = old / nloc;
        if (old + 1u == (gen + 1u) * nloc) {
            __builtin_amdgcn_fence(__ATOMIC_RELEASE, "agent");
            asm volatile("s_waitcnt vmcnt(0)" ::: "memory");
            const unsigned og = xb_add(&bar[XB_TOP], 1u);
            const unsigned tg = og / nx;
            if (og + 1u == (tg + 1u) * nx) xb_add(&bar[XB_TOPGEN], 1u);
            else XB_SPIN(xb_ld(&bar[XB_TOPGEN]) == tg, bar);
            __builtin_amdgcn_fence(__ATOMIC_ACQUIRE, "agent");
            xb_add(&bar[XB_XGEN(b.x)], 1u);
            asm volatile("s_waitcnt vmcnt(0)" ::: "memory");
        } else {
            XB_SPIN(xb_ld(&bar[XB_XGEN(b.x)]) == gen, bar);
            __builtin_amdgcn_fence(__ATOMIC_ACQUIRE, "agent");
            asm volatile("s_waitcnt vmcnt(0)" ::: "memory");
        }
    }
    __syncthreads();
}

constexpr int PTAB_OFF = MISC_OFF + 128;
struct Frame {
    LAS unsigned char* lds;
    int tid, lane, wave, wave0;
    int vcu, G, bx;
    float* out; unsigned char* ws;
    __device__ __forceinline__ const float* ptr(int i) const {
        const volatile LAS unsigned* t = (const volatile LAS unsigned*)(lds + PTAB_OFF) + 2 * i;
        const unsigned lo = __builtin_amdgcn_readfirstlane(t[0]), hi = __builtin_amdgcn_readfirstlane(t[1]);
        return (const float*)((const GAS float*)(((unsigned long long)hi << 32) | lo)); }
    __device__ __forceinline__ const float* in(int i) const { return ptr(i); }
};
__device__ __forceinline__ void make_frame(Frame& F, LAS unsigned char* lds, int wave_sgpr) {
    const int t = tid_from_wave(wave_sgpr);
    int g = gridDim.x, bx = blockIdx.x; asm volatile("" : "+s"(g), "+s"(bx));
    F.lds = lds; F.tid = t; F.lane = t & 63; F.wave = __builtin_amdgcn_readfirstlane(t >> 6); F.wave0 = wave_sgpr;
    F.G = g; F.bx = bx; F.vcu = (g % 8 == 0) ? (bx % 8) * (g / 8) + bx / 8 : bx;
    F.out = (float*)F.ptr(25); F.ws = (unsigned char*)F.ptr(26);
}
__device__ __forceinline__ bf16* wsb(const Frame& F, size_t off) { return (bf16*)(F.ws + off); }
__device__ __forceinline__ float* wsf(const Frame& F, size_t off) { return (float*)(F.ws + off); }

__device__ __forceinline__ void p0_transpose_item(const float* W, int K, int N, bf16* WT, int row_off, LAS float* scr, int item, int lane, const float* kscale = nullptr, bool blocked = false) {
    const int nblk = N / 32, kb = item / nblk, nb = item % nblk, k0 = 64 * kb, n0 = 32 * nb;
    float tv[32];
#pragma unroll
    for (int i = 0; i < 32; ++i) { const int kk = 2 * i + (lane >> 5); tv[i] = W[(size_t)(k0 + kk) * N + n0 + (lane & 31)]; }
#pragma unroll
    for (int i = 0; i < 32; ++i) { const int kk = 2 * i + (lane >> 5); scr[kk * 33 + (lane & 31)] = kscale ? tv[i] * kscale[k0 + kk] : tv[i]; }
    LDS_WAIT(); asm volatile("" ::: "memory");
    const int c = lane & 7;
#pragma unroll
    for (int j = 0; j < 4; ++j) { const int n = (lane >> 3) + 8 * j; const LAS float* s = scr + (8 * c) * 33 + n;
        v4u o; o.x = pk2(s[0 * 33], s[1 * 33]); o.y = pk2(s[2 * 33], s[3 * 33]); o.z = pk2(s[4 * 33], s[5 * 33]); o.w = pk2(s[6 * 33], s[7 * 33]);
        const int nn = row_off + n0 + n;
        *(GAS v4u*)(WT + (blocked ? ((size_t)((nn >> 8) * (K / 64) + kb) * 256 + (nn & 255)) * 64 + 8 * c : (size_t)nn * K + k0 + 8 * c)) = o; }
    LDS_WAIT(); asm volatile("" ::: "memory");
}

__device__ __forceinline__ void p0_prologue(Frame& F) {
    if (F.vcu < 192) {
        LAS float* sl = (LAS float*)(F.lds);
        LAS float* part = (LAS float*)(F.lds + 32768);
        for (int idx = F.tid; idx < 3 * DM; idx += NWAVES * 64) { const int rt = idx / DM, k = idx % DM; const float v = rt < 2 ? F.in(1)[rt * DM + k] : F.in(3)[k]; sl[idx] = silu_f(v); }
        __syncthreads();
        const int layer = F.vcu / 48, cg = F.vcu % 48;
        const float* Wp = F.in(4) + (size_t)layer * DM * 12288 + cg * 256 + F.lane * 4;
        f32x4 a0 = {0.f, 0.f, 0.f, 0.f}, a1 = a0, a2 = a0;
        const int kb = F.wave * 256;
#pragma unroll 8
        for (int k = kb; k < kb + 256; ++k) { const f32x4 w = *(const GAS f32x4*)(Wp + (size_t)k * 12288); a0 += w * sl[k]; a1 += w * sl[DM + k]; a2 += w * sl[2 * DM + k]; }
        *(LAS f32x4*)(part + (F.wave * 3 + 0) * 256 + F.lane * 4) = a0; *(LAS f32x4*)(part + (F.wave * 3 + 1) * 256 + F.lane * 4) = a1; *(LAS f32x4*)(part + (F.wave * 3 + 2) * 256 + F.lane * 4) = a2;
        __syncthreads();
        for (int idx = F.tid; idx < 768; idx += NWAVES * 64) { const int rt = idx >> 8, cl = idx & 255; float s = 0.f;
#pragma unroll
            for (int w = 0; w < 8; ++w) s += part[(w * 3 + rt) * 256 + cl];
            const int n = cg * 256 + cl, chunk = n / DM; float val = s + F.in(5)[layer * 12288 + n]; if (chunk == 1 || chunk == 4) val += 1.0f;
            wsf(F, WS_MOD)[(layer * 3 + rt) * 12288 + n] = val; }
        __syncthreads();
    } else if (F.vcu == 192) {
        for (int idx = F.tid; idx < 256 * 16 + 64 * 16; idx += NWAVES * 64) {
            const int e = idx < 4096 ? idx : idx - 4096, pos = e >> 4, f = e & 15;
            const float inv = 1.0f / powf(10000.0f, (float)f / 16.0f), ang = (float)pos * inv; float sn, cs; sincosf(ang, &sn, &cs);
            f32x2* t = (f32x2*)(F.ws + (idx < 4096 ? WS_ROPER : WS_ROPEC)); t[e] = (f32x2){cs, sn}; }
    }
    LAS float* scr = (LAS float*)(F.lds + RING_OFF + F.wave * 16384);
    const int gw = F.vcu * NWAVES + F.wave, NGW = F.G * NWAVES;
    constexpr int C0 = 32 * 192, C1 = 32 * 64, C2 = 32 * 16, C3 = 32 * 18, C4 = 8 * 96, C5 = 8 * 64, C6 = 8 * 64, C7 = 32 * 64, C8 = 32 * 352, C9 = 88 * 64, C10 = 192;
    constexpr int NITEMS = 2 * (C0 + C1 + C2 + C3 + C4 + C5 + C6 + C7 + C10) + 4 * (C8 + C9);
    for (int it = gw; it < NITEMS; it += NGW) {
        int r = it;
        if (r < 4 * C8) { const int l = r / C8, item = r % C8, n0 = 32 * (item % 352);
            const int m0 = n0 < DFF ? n0 : n0 - DFF, dst = (m0 >> 7) * 256 + (n0 < DFF ? 0 : 128) + (m0 & 127);
            p0_transpose_item(F.in(21) + (size_t)l * DM * 11264, DM, 11264, wsb(F, WS_W + W_FFN_BASE + l * W_FFN_STRIDE + W_UP), dst - n0, scr, item, F.lane); continue; } r -= 4 * C8;
        if (r < 4 * C9) { const int l = r / C9; p0_transpose_item(F.in(24) + (size_t)l * DFF * DM, DFF, DM, wsb(F, WS_W + W_FFN_BASE + l * W_FFN_STRIDE + W_DOWN), 0, scr, r % C9, F.lane, nullptr, true); continue; } r -= 4 * C9;
        if (r < 2 * C0) { const int l = r / C0, item = r % C0, n0 = 32 * (item % 192);
            const int m0 = n0 < 4096 ? n0 - 2048 : n0 - 4096, dst = n0 < 2048 ? n0 : 2048 + (m0 >> 7) * 256 + (n0 < 4096 ? 0 : 128) + (m0 & 127);
            p0_transpose_item(F.in(10) + (size_t)l * DM * 6144, DM, 6144, wsb(F, WS_W + l * W_CONV_STRIDE + W_WIN), dst - n0, scr, item, F.lane); continue; } r -= 2 * C0;
        if (r < 2 * C1) { const int l = r / C1; p0_transpose_item(F.in(12) + (size_t)l * DM * DM, DM, DM, wsb(F, WS_W + l * W_CONV_STRIDE + W_WOUT), 0, scr, r % C1, F.lane); continue; } r -= 2 * C1;
        if (r < 2 * C2) { const int l = r / C2; p0_transpose_item(F.in(13) + (size_t)l * DM * QLR, DM, QLR, wsb(F, WS_W + W_MLA_BASE + l * W_MLA_STRIDE + W_DQKV), 0, scr, r % C2, F.lane); continue; } r -= 2 * C2;
        if (r < 2 * C3) { const int l = r / C3; p0_transpose_item(F.in(16) + (size_t)l * DM * 576, DM, 576, wsb(F, WS_W + W_MLA_BASE + l * W_MLA_STRIDE + W_DQKV), 512, scr, r % C3, F.lane); continue; } r -= 2 * C3;
        if (r < 2 * C4) { const int l = r / C4; p0_transpose_item(F.in(15) + (size_t)l * QLR * 3072, QLR, 3072, wsb(F, WS_W + W_MLA_BASE + l * W_MLA_STRIDE + W_UQ), 0, scr, r % C4, F.lane, F.in(14) + l * QLR); continue; } r -= 2 * C4;
        if (r < 2 * C5) { const int l = r / C5; p0_transpose_item(F.in(18) + (size_t)l * KVLR * 2048, KVLR, 2048, wsb(F, WS_W + W_MLA_BASE + l * W_MLA_STRIDE + W_UKV), 0, scr, r % C5, F.lane, F.in(17) + l * KVLR); continue; } r -= 2 * C5;
        if (r < 2 * C6) { const int l = r / C6; p0_transpose_item(F.in(19) + (size_t)l * KVLR * 2048, KVLR, 2048, wsb(F, WS_W + W_MLA_BASE + l * W_MLA_STRIDE + W_UKV), 2048, scr, r % C6, F.lane, F.in(17) + l * KVLR); continue; } r -= 2 * C6;
        if (r < 2 * C7) { const int l = r / C7; p0_transpose_item(F.in(20) + (size_t)l * DM * DM, DM, DM, wsb(F, WS_W + W_MLA_BASE + l * W_MLA_STRIDE + W_WO), 0, scr, r % C7, F.lane); continue; } r -= 2 * C7;
        { const int l = r / C10, row = 1088 + r % C10; bf16* d = wsb(F, WS_W + W_MLA_BASE + l * W_MLA_STRIDE + W_DQKV) + (size_t)row * DM;
#pragma unroll
          for (int j = 0; j < 4; ++j) *(GAS v4u*)(d + j * 512 + F.lane * 8) = (v4u){0u, 0u, 0u, 0u}; }
    }
}

__device__ __forceinline__ void p1_hx0(Frame& F) {
    const int gw = F.vcu * NWAVES + F.wave, NGW = F.G * NWAVES;
    bf16* HX = wsb(F, WS_ACT); const float* xin = F.in(0); const float* cin = F.in(2);
    constexpr int RPW = 16;
    for (int blk = gw; blk < M_T / RPW; blk += NGW) {
        const int r0 = blk * RPW, rt = r0 < SEQ ? 0 : (r0 < M_X ? 1 : 2);
        const float* mod = wsf(F, WS_MOD) + (size_t)rt * 12288;
        const GAS f32x4* shp = (const GAS f32x4*)mod + F.lane; const GAS f32x4* scp = (const GAS f32x4*)(mod + DM) + F.lane;
        f32x4 A[8], B[8];
#pragma unroll
        for (int j = 0; j < 8; ++j) { A[j] = scp[64 * j]; B[j] = shp[64 * j]; }
        const float* src = r0 < M_X ? xin + (size_t)r0 * DM : cin + (size_t)(r0 - M_X) * DM;
        const GAS f32x4* xr = (const GAS f32x4*)src + F.lane;
        GAS f32x4* xc = (GAS f32x4*)(wsf(F, WS_X32C) + (size_t)(r0 < M_X ? 0 : r0 - M_X) * DM) + F.lane;
        f32x4 va[8], vb[8];
#pragma unroll
        for (int j = 0; j < 8; ++j) va[j] = xr[64 * j];
#define P1_ROW(CUR, NXT, R) do { \
            if ((R) + 1 < RPW) { _Pragma("unroll") for (int j = 0; j < 8; ++j) NXT[j] = xr[(size_t)((R) + 1) * (DM / 4) + 64 * j]; } \
            GAS v2u* o8_ = (GAS v2u*)(HX + (size_t)(r0 + (R)) * DM) + F.lane; \
            _Pragma("unroll") for (int j = 0; j < 8; ++j) { const f32x4 h_ = CUR[j] * A[j] + B[j]; o8_[64 * j] = (v2u){pk2(h_.x, h_.y), pk2(h_.z, h_.w)}; \
                if (r0 >= M_X) xc[(size_t)(R) * (DM / 4) + 64 * j] = CUR[j] * DN_ALPHA; }     \
        } while (0)
        for (int r = 0; r < RPW; r += 2) { P1_ROW(va, vb, r); P1_ROW(vb, va, r + 1); }
#undef P1_ROW
    }
}

__device__ __forceinline__ void ln_phase(Frame& F, int layer, int second, int nrows, int nplanes) {
    const int gw = F.vcu * NWAVES + F.wave, NGW = F.G * NWAVES;
    const float* gam = F.in(second ? 8 : 6) + layer * DM; const float* bet = F.in(second ? 9 : 7) + layer * DM;
    const bool final_out = (second && layer == DEPTH - 1);
    const int modl = second ? (layer + 1 < DEPTH ? layer + 1 : layer) : layer, chunk = second ? 0 : 3;
    bf16* HX = wsb(F, WS_ACT); float* stats = wsf(F, WS_STATS) + (size_t)second * 2 * M_T;
    const GAS f32x4* gp = (const GAS f32x4*)gam + F.lane; const GAS f32x4* bp = (const GAS f32x4*)bet + F.lane;
    constexpr int RPW = 16;
    const _Float16* T16 = (const _Float16*)(F.ws + WS_T16);
    for (int blk = gw; blk < M_X / RPW; blk += NGW) {
        const int r0 = blk * RPW, rt = r0 < SEQ ? 0 : 1;
        f32x4 A[8], B[8];
        { const float* mod = wsf(F, WS_MOD) + (size_t)(modl * 3 + rt) * 12288 + chunk * DM;
          const GAS f32x4* g4 = (const GAS f32x4*)gam + 2 * F.lane; const GAS f32x4* b4 = (const GAS f32x4*)bet + 2 * F.lane;
          const GAS f32x4* shp = (const GAS f32x4*)mod + 2 * F.lane; const GAS f32x4* scp = (const GAS f32x4*)(mod + DM) + 2 * F.lane;
#pragma unroll
          for (int j = 0; j < 4; ++j)
#pragma unroll
              for (int h = 0; h < 2; ++h) { const int q = 128 * j + h; const f32x4 g = g4[q], b = b4[q]; if (final_out) { A[2 * j + h] = g; B[2 * j + h] = b; } else { const f32x4 sc = scp[q], sh = shp[q]; A[2 * j + h] = g * sc; B[2 * j + h] = b * sc + sh; } } }
        const GAS f16x8* xr = (const GAS f16x8*)(T16 + (size_t)r0 * DM) + F.lane;
        f16x8 ta[4], tb[4], tc[4];
#pragma unroll
        for (int j = 0; j < 4; ++j) { ta[j] = xr[64 * j]; tb[j] = xr[(size_t)(DM / 8) + 64 * j]; }
#define LN_ROW(CUR, NXT, R) do { \
            if ((R) + 2 < RPW) { _Pragma("unroll") for (int j = 0; j < 4; ++j) NXT[j] = xr[(size_t)((R) + 2) * (DM / 8) + 64 * j]; } \
            f32x4 v_[8]; float s_ = 0.f; \
            _Pragma("unroll") for (int j = 0; j < 4; ++j) { v_[2 * j] = (f32x4){(float)CUR[j][0], (float)CUR[j][1], (float)CUR[j][2], (float)CUR[j][3]}; v_[2 * j + 1] = (f32x4){(float)CUR[j][4], (float)CUR[j][5], (float)CUR[j][6], (float)CUR[j][7]}; } \
            _Pragma("unroll") for (int j = 0; j < 8; ++j) s_ += (v_[j].x + v_[j].y) + (v_[j].z + v_[j].w); \
            const float mean_ = wave_sum(s_, F.lane) * (1.f / DM); float q_ = 0.f; \
            _Pragma("unroll") for (int j = 0; j < 8; ++j) { v_[j] = v_[j] - mean_; q_ += (v_[j].x * v_[j].x + v_[j].y * v_[j].y) + (v_[j].z * v_[j].z + v_[j].w * v_[j].w); } \
            const float rstd_ = 1.f / sqrtf(wave_sum(q_, F.lane) * (1.f / DM) + LN_EPS); \
            if (final_out) { GAS f32x4* o4_ = (GAS f32x4*)(F.out + (size_t)(r0 + (R)) * DM) + 2 * F.lane; \
                   _Pragma("unroll") for (int j = 0; j < 4; ++j) { o4_[128 * j] = v_[2 * j] * rstd_ * A[2 * j] + B[2 * j]; o4_[128 * j + 1] = v_[2 * j + 1] * rstd_ * A[2 * j + 1] + B[2 * j + 1]; } } \
            else { if (F.lane == 0) *(GAS f32x2*)(stats + 2 * (size_t)(r0 + (R))) = (f32x2){mean_, rstd_}; \
                   GAS v4u* o8_ = (GAS v4u*)(HX + (size_t)(r0 + (R)) * DM) + F.lane; \
                   _Pragma("unroll") for (int j = 0; j < 4; ++j) { const f32x4 h0_ = v_[2 * j] * rstd_ * A[2 * j] + B[2 * j], h1_ = v_[2 * j + 1] * rstd_ * A[2 * j + 1] + B[2 * j + 1]; \
                       o8_[64 * j] = (v4u){pk2(h0_.x, h0_.y), pk2(h0_.z, h0_.w), pk2(h1_.x, h1_.y), pk2(h1_.z, h1_.w)}; } } \
        } while (0)
        for (int r = 0; r < RPW - 1; r += 3) { LN_ROW(ta, tc, r); LN_ROW(tb, ta, r + 1); LN_ROW(tc, tb, r + 2); }
        LN_ROW(ta, tc, RPW - 1);
#undef LN_ROW
    }
    for (int row = M_X + F.wave * F.G + F.vcu; row < nrows; row += NGW) {
        float* xrow = wsf(F, WS_X32C) + (size_t)(row - M_X) * DM;
        GAS f32x4* xr = (GAS f32x4*)xrow + F.lane;
        f32x4 v[8]; float s = 0.f;
#pragma unroll
        for (int j = 0; j < 8; ++j) v[j] = xr[64 * j];
        { const GAS f32x4* pp = (const GAS f32x4*)(wsf(F, WS_BIG + BIG_CPART) + (size_t)(row - M_X) * DM) + F.lane;
          int p = 0;
          for (; p + 4 <= nplanes; p += 4) {
              f32x4 t[4][8];
#pragma unroll
              for (int q = 0; q < 4; ++q)
#pragma unroll
                  for (int j = 0; j < 8; ++j) t[q][j] = pp[(size_t)(p + q) * (M_C * DM / 4) + 64 * j];
#pragma unroll
              for (int j = 0; j < 8; ++j) v[j] += (t[0][j] + t[1][j]) + (t[2][j] + t[3][j]); }
          for (; p < nplanes; ++p) {
#pragma unroll
              for (int j = 0; j < 8; ++j) v[j] += pp[(size_t)p * (M_C * DM / 4) + 64 * j]; } }
#pragma unroll
        for (int j = 0; j < 8; ++j) s += (v[j].x + v[j].y) + (v[j].z + v[j].w);
        const float mean = wave_sum(s, F.lane) * (1.f / DM); float s2 = 0.f;
#pragma unroll
        for (int j = 0; j < 8; ++j) { v[j] = v[j] - mean; s2 += (v[j].x * v[j].x + v[j].y * v[j].y) + (v[j].z * v[j].z + v[j].w * v[j].w); }
        const float rstd = 1.f / sqrtf(wave_sum(s2, F.lane) * (1.f / DM) + LN_EPS);
#pragma unroll
        for (int j = 0; j < 8; ++j) v[j] = v[j] * rstd * gp[64 * j] + bp[64 * j];
        if (F.lane == 0) *(GAS f32x2*)(stats + 2 * (size_t)row) = (f32x2){mean, rstd};
        const float* mod = wsf(F, WS_MOD) + (size_t)(modl * 3 + 2) * 12288 + chunk * DM;
        const GAS f32x4* shp = (const GAS f32x4*)mod + F.lane; const GAS f32x4* scp = (const GAS f32x4*)(mod + DM) + F.lane;
        GAS v2u* o8 = (GAS v2u*)(HX + (size_t)row * DM) + F.lane;
#pragma unroll
        for (int j = 0; j < 8; ++j) { const f32x4 h = v[j] * scp[64 * j] + shp[64 * j]; o8[64 * j] = (v2u){pk2(h.x, h.y), pk2(h.z, h.w)}; xr[64 * j] = v[j] * DN_ALPHA; }
    }
}

__device__ __forceinline__ void ln_cluster(Frame& F, int layer, int second, int nrows, int nplanes, const pg8::ClusterCtxOrder& S, unsigned* rel, unsigned* bar) {
    const int gw = F.vcu * NWAVES + F.wave, NGW = F.G * NWAVES;
    const float* gam = F.in(second ? 8 : 6) + layer * DM; const float* bet = F.in(second ? 9 : 7) + layer * DM;
    const bool final_out = (second && layer == DEPTH - 1);
    const int modl = second ? (layer + 1 < DEPTH ? layer + 1 : layer) : layer, chunk = second ? 0 : 3;
    bf16* HX = wsb(F, WS_ACT); float* stats = wsf(F, WS_STATS) + (size_t)second * 2 * M_T;
    const GAS f32x4* gp = (const GAS f32x4*)gam + F.lane; const GAS f32x4* bp = (const GAS f32x4*)bet + F.lane;
    const _Float16* T16 = (const _Float16*)(F.ws + WS_T16);
    pg8::Unit u0; S.map(S.c, u0);
    bool fast = (S.nxu == 4 * S.G) && S.c < S.nxu;
    if (fast) { for (int i = 1; i < 4; ++i) { pg8::Unit ui; S.map(i * S.G + S.c, ui); fast = fast && ui.pm == u0.pm + 4 * i && ui.pn == u0.pn; }
                const int ra = u0.pm * 256, rb = (u0.pm + 12) * 256 + 255; fast = fast && ((ra < SEQ) == (rb < SEQ)); }
    if (fast) {
        constexpr int RPWF = 16;
        if (F.wave == 0) { unsigned sp = 0u;
            for (int i = 0; i < 4; ++i) { unsigned* fl = rel + S.owner(u0.pm + 4 * i, F.lane & 7);
                while (!__all(__hip_atomic_load(fl, __ATOMIC_RELAXED, __HIP_MEMORY_SCOPE_AGENT) >= 1u)) { __builtin_amdgcn_s_sleep(2);
                    if ((++sp & 255u) == 0u) { if (xb_ld(&bar[XB_TMO])) break; if (sp > XB_SPIN_CAP) { atomicAdd(&bar[XB_TMO], 1u); break; } } } }
            __builtin_amdgcn_fence(__ATOMIC_ACQUIRE, "agent"); asm volatile("s_waitcnt vmcnt(0)" ::: "memory"); }
        __syncthreads();
        const int r0 = u0.pm * 256 + u0.pn * 32 + F.wave * 4, rt = r0 < SEQ ? 0 : 1;
        f32x4 A[8], B[8];
        { const float* mod = wsf(F, WS_MOD) + (size_t)(modl * 3 + rt) * 12288 + chunk * DM;
          const GAS f32x4* g4 = (const GAS f32x4*)gam + 2 * F.lane; const GAS f32x4* b4 = (const GAS f32x4*)bet + 2 * F.lane;
          const GAS f32x4* shp = (const GAS f32x4*)mod + 2 * F.lane; const GAS f32x4* scp = (const GAS f32x4*)(mod + DM) + 2 * F.lane;
#pragma unroll
          for (int j = 0; j < 4; ++j)
#pragma unroll
              for (int h = 0; h < 2; ++h) { const int q = 128 * j + h; const f32x4 g = g4[q], b = b4[q]; if (final_out) { A[2 * j + h] = g; B[2 * j + h] = b; } else { const f32x4 sc = scp[q], sh = shp[q]; A[2 * j + h] = g * sc; B[2 * j + h] = b * sc + sh; } } }
        #define ROWI(R) (r0 + ((R) >> 2) * 1024 + ((R) & 3))
#define XRP(R) ((const GAS f16x8*)(T16 + (size_t)ROWI(R) * DM) + F.lane)
        f16x8 ta[4], tb[4], tc[4];
#pragma unroll
        for (int j = 0; j < 4; ++j) { ta[j] = XRP(0)[64 * j]; tb[j] = XRP(1)[64 * j]; }
#define LN_ROW(CUR, NXT, R) do { \
            if ((R) + 2 < RPWF) { _Pragma("unroll") for (int j = 0; j < 4; ++j) NXT[j] = XRP((R) + 2)[64 * j]; } \
            f32x4 v_[8]; float s_ = 0.f; \
            _Pragma("unroll") for (int j = 0; j < 4; ++j) { v_[2 * j] = (f32x4){(float)CUR[j][0], (float)CUR[j][1], (float)CUR[j][2], (float)CUR[j][3]}; v_[2 * j + 1] = (f32x4){(float)CUR[j][4], (float)CUR[j][5], (float)CUR[j][6], (float)CUR[j][7]}; } \
            _Pragma("unroll") for (int j = 0; j < 8; ++j) s_ += (v_[j].x + v_[j].y) + (v_[j].z + v_[j].w); \
            const float mean_ = wave_sum(s_, F.lane) * (1.f / DM); float q_ = 0.f; \
            _Pragma("unroll") for (int j = 0; j < 8; ++j) { v_[j] = v_[j] - mean_; q_ += (v_[j].x * v_[j].x + v_[j].y * v_[j].y) + (v_[j].z * v_[j].z + v_[j].w * v_[j].w); } \
            const float rstd_ = 1.f / sqrtf(wave_sum(q_, F.lane) * (1.f / DM) + LN_EPS); \
            if (final_out) { GAS f32x4* o4_ = (GAS f32x4*)(F.out + (size_t)ROWI(R) * DM) + 2 * F.lane; \
                   _Pragma("unroll") for (int j = 0; j < 4; ++j) { o4_[128 * j] = v_[2 * j] * rstd_ * A[2 * j] + B[2 * j]; o4_[128 * j + 1] = v_[2 * j + 1] * rstd_ * A[2 * j + 1] + B[2 * j + 1]; } } \
            else { if (F.lane == 0) *(GAS f32x2*)(stats + 2 * (size_t)ROWI(R)) = (f32x2){mean_, rstd_}; \
                   GAS v4u* o8_ = (GAS v4u*)(HX + (size_t)ROWI(R) * DM) + F.lane; \
                   _Pragma("unroll") for (int j = 0; j < 4; ++j) { const f32x4 h0_ = v_[2 * j] * rstd_ * A[2 * j] + B[2 * j], h1_ = v_[2 * j + 1] * rstd_ * A[2 * j + 1] + B[2 * j + 1]; \
                       o8_[64 * j] = (v4u){pk2(h0_.x, h0_.y), pk2(h0_.z, h0_.w), pk2(h1_.x, h1_.y), pk2(h1_.z, h1_.w)}; } } \
        } while (0)
        for (int r = 0; r < RPWF - 1; r += 3) { LN_ROW(ta, tc, r); LN_ROW(tb, ta, r + 1); LN_ROW(tc, tb, r + 2); }
        LN_ROW(ta, tc, RPWF - 1);
#undef LN_ROW
#undef XRP
#undef ROWI
    } else {
    constexpr int RPW = 4;
    for (int i = 0;; ++i) {
        const long L = (long)i * S.G + S.c; if (L >= S.nxu) break;
        pg8::Unit u; S.map((int)L, u);
        if (F.wave == 0) { unsigned* fl = rel + S.owner(u.pm, F.lane & 7); unsigned sp = 0u;
            while (!__all(__hip_atomic_load(fl, __ATOMIC_RELAXED, __HIP_MEMORY_SCOPE_AGENT) >= 1u)) { __builtin_amdgcn_s_sleep(2);
                if ((++sp & 255u) == 0u) { if (xb_ld(&bar[XB_TMO])) break; if (sp > XB_SPIN_CAP) { atomicAdd(&bar[XB_TMO], 1u); break; } } }
            __builtin_amdgcn_fence(__ATOMIC_ACQUIRE, "agent"); asm volatile("s_waitcnt vmcnt(0)" ::: "memory"); }
        __syncthreads();
        const int r0 = u.pm * 256 + u.pn * 32 + F.wave * RPW, rt = r0 < SEQ ? 0 : 1;
        f32x4 A[8], B[8];
        { const float* mod = wsf(F, WS_MOD) + (size_t)(modl * 3 + rt) * 12288 + chunk * DM;
          const GAS f32x4* g4 = (const GAS f32x4*)gam + 2 * F.lane; const GAS f32x4* b4 = (const GAS f32x4*)bet + 2 * F.lane;
          const GAS f32x4* shp = (const GAS f32x4*)mod + 2 * F.lane; const GAS f32x4* scp = (const GAS f32x4*)(mod + DM) + 2 * F.lane;
#pragma unroll
          for (int j = 0; j < 4; ++j)
#pragma unroll
              for (int h = 0; h < 2; ++h) { const int q = 128 * j + h; const f32x4 g = g4[q], b = b4[q]; if (final_out) { A[2 * j + h] = g; B[2 * j + h] = b; } else { const f32x4 sc = scp[q], sh = shp[q]; A[2 * j + h] = g * sc; B[2 * j + h] = b * sc + sh; } } }
        const GAS f16x8* xr = (const GAS f16x8*)(T16 + (size_t)r0 * DM) + F.lane;
        f16x8 ta[4], tb[4], tc[4];
#pragma unroll
        for (int j = 0; j < 4; ++j) { ta[j] = xr[64 * j]; tb[j] = xr[(size_t)(DM / 8) + 64 * j]; }
#define LN_ROW(CUR, NXT, R) do { \
            if ((R) + 2 < RPW) { _Pragma("unroll") for (int j = 0; j < 4; ++j) NXT[j] = xr[(size_t)((R) + 2) * (DM / 8) + 64 * j]; } \
            f32x4 v_[8]; float s_ = 0.f; \
            _Pragma("unroll") for (int j = 0; j < 4; ++j) { v_[2 * j] = (f32x4){(float)CUR[j][0], (float)CUR[j][1], (float)CUR[j][2], (float)CUR[j][3]}; v_[2 * j + 1] = (f32x4){(float)CUR[j][4], (float)CUR[j][5], (float)CUR[j][6], (float)CUR[j][7]}; } \
            _Pragma("unroll") for (int j = 0; j < 8; ++j) s_ += (v_[j].x + v_[j].y) + (v_[j].z + v_[j].w); \
            const float mean_ = wave_sum(s_, F.lane) * (1.f / DM); float q_ = 0.f; \
            _Pragma("unroll") for (int j = 0; j < 8; ++j) { v_[j] = v_[j] - mean_; q_ += (v_[j].x * v_[j].x + v_[j].y * v_[j].y) + (v_[j].z * v_[j].z + v_[j].w * v_[j].w); } \
            const float rstd_ = 1.f / sqrtf(wave_sum(q_, F.lane) * (1.f / DM) + LN_EPS); \
            if (final_out) { GAS f32x4* o4_ = (GAS f32x4*)(F.out + (size_t)(r0 + (R)) * DM) + 2 * F.lane; \
                   _Pragma("unroll") for (int j = 0; j < 4; ++j) { o4_[128 * j] = v_[2 * j] * rstd_ * A[2 * j] + B[2 * j]; o4_[128 * j + 1] = v_[2 * j + 1] * rstd_ * A[2 * j + 1] + B[2 * j + 1]; } } \
            else { if (F.lane == 0) *(GAS f32x2*)(stats + 2 * (size_t)(r0 + (R))) = (f32x2){mean_, rstd_}; \
                   GAS v4u* o8_ = (GAS v4u*)(HX + (size_t)(r0 + (R)) * DM) + F.lane; \
                   _Pragma("unroll") for (int j = 0; j < 4; ++j) { const f32x4 h0_ = v_[2 * j] * rstd_ * A[2 * j] + B[2 * j], h1_ = v_[2 * j + 1] * rstd_ * A[2 * j + 1] + B[2 * j + 1]; \
                       o8_[64 * j] = (v4u){pk2(h0_.x, h0_.y), pk2(h0_.z, h0_.w), pk2(h1_.x, h1_.y), pk2(h1_.z, h1_.w)}; } } \
        } while (0)
        for (int r = 0; r < RPW - 1; r += 3) { LN_ROW(ta, tc, r); LN_ROW(tb, ta, r + 1); LN_ROW(tc, tb, r + 2); }
        LN_ROW(ta, tc, RPW - 1);
#undef LN_ROW
    }
    }
    if (nrows > M_X) {
        if (F.wave == 0) { unsigned sp = 0u;
            while ((unsigned)__builtin_amdgcn_readfirstlane((int)xb_ld(rel + 256)) < (unsigned)F.G) { __builtin_amdgcn_s_sleep(2);
                if ((++sp & 255u) == 0u) { if (xb_ld(&bar[XB_TMO])) break; if (sp > XB_SPIN_CAP) { atomicAdd(&bar[XB_TMO], 1u); break; } } }
            __builtin_amdgcn_fence(__ATOMIC_ACQUIRE, "agent"); asm volatile("s_waitcnt vmcnt(0)" ::: "memory"); }
        __syncthreads();
    }
    for (int row = M_X + F.wave * F.G + F.vcu; row < nrows; row += NGW) {
        float* xrow = wsf(F, WS_X32C) + (size_t)(row - M_X) * DM;
        GAS f32x4* xr = (GAS f32x4*)xrow + F.lane;
        f32x4 v[8]; float s = 0.f;
#pragma unroll
        for (int j = 0; j < 8; ++j) v[j] = xr[64 * j];
        { const GAS f32x4* pp = (const GAS f32x4*)(wsf(F, WS_BIG + BIG_CPART) + (size_t)(row - M_X) * DM) + F.lane;
          int p = 0;
          for (; p + 4 <= nplanes; p += 4) {
              f32x4 t[4][8];
#pragma unroll
              for (int q = 0; q < 4; ++q)
#pragma unroll
                  for (int j = 0; j < 8; ++j) t[q][j] = pp[(size_t)(p + q) * (M_C * DM / 4) + 64 * j];
#pragma unroll
              for (int j = 0; j < 8; ++j) v[j] += (t[0][j] + t[1][j]) + (t[2][j] + t[3][j]); }
          for (; p < nplanes; ++p) {
#pragma unroll
              for (int j = 0; j < 8; ++j) v[j] += pp[(size_t)p * (M_C * DM / 4) + 64 * j]; } }
#pragma unroll
        for (int j = 0; j < 8; ++j) s += (v[j].x + v[j].y) + (v[j].z + v[j].w);
        const float mean = wave_sum(s, F.lane) * (1.f / DM); float s2 = 0.f;
#pragma unroll
        for (int j = 0; j < 8; ++j) { v[j] = v[j] - mean; s2 += (v[j].x * v[j].x + v[j].y * v[j].y) + (v[j].z * v[j].z + v[j].w * v[j].w); }
        const float rstd = 1.f / sqrtf(wave_sum(s2, F.lane) * (1.f / DM) + LN_EPS);
#pragma unroll
        for (int j = 0; j < 8; ++j) v[j] = v[j] * rstd * gp[64 * j] + bp[64 * j];
        if (F.lane == 0) *(GAS f32x2*)(stats + 2 * (size_t)row) = (f32x2){mean, rstd};
        const float* mod = wsf(F, WS_MOD) + (size_t)(modl * 3 + 2) * 12288 + chunk * DM;
        const GAS f32x4* shp = (const GAS f32x4*)mod + F.lane; const GAS f32x4* scp = (const GAS f32x4*)(mod + DM) + F.lane;
        GAS v2u* o8 = (GAS v2u*)(HX + (size_t)row * DM) + F.lane;
#pragma unroll
        for (int j = 0; j < 8; ++j) { const f32x4 h = v[j] * scp[64 * j] + shp[64 * j]; o8[64 * j] = (v2u){pk2(h.x, h.y), pk2(h.z, h.w)}; xr[64 * j] = v[j] * DN_ALPHA; }
    }
}

__device__ __forceinline__ bool seq_start(int r) { return r >= M_T ? true : (r < M_X ? ((r & (SEQ - 1)) == 0) : (((r - M_X) & (CTXL - 1)) == 0)); }
__device__ __forceinline__ void unpack8(const v4u w, float (&f)[8]) { f[0] = bflo(w.x); f[1] = bfhi(w.x); f[2] = bflo(w.y); f[3] = bfhi(w.y); f[4] = bflo(w.z); f[5] = bfhi(w.z); f[6] = bflo(w.w); f[7] = bfhi(w.w); }

__device__ __forceinline__ void load8f(const float* p, float (&f)[8]) { const f32x4 a = *(const GAS f32x4*)p, b = *(const GAS f32x4*)(p + 4); f[0] = a.x; f[1] = a.y; f[2] = a.z; f[3] = a.w; f[4] = b.x; f[5] = b.y; f[6] = b.z; f[7] = b.w; }
__device__ __forceinline__ void convfix_phase(Frame& F, int j) {
    const int gw = F.vcu * NWAVES + F.wave, NGW = F.G * NWAVES;
    const float* HALO = wsf(F, WS_BIG + BIG_HALOC); const bf16* Bb = wsb(F, WS_BIG + BIG_BB); bf16* OUT = wsb(F, WS_BIG + BIG_GATED);
    const float* cw = F.in(11) + (size_t)j * 3 * DM;
    constexpr int NCG = DM / 512, NSEG = M_T / 64;
    for (int item = gw; item < NSEG * 2 * NCG; item += NGW) {
        const int cg = item % NCG, sw = item / NCG, seg = sw >> 1, bot = sw & 1, f0 = cg * 512 + F.lane * 8;
        const int row = 64 * seg + (bot ? 63 : 0);
        const bool missing = bot ? seq_start(row + 1) : seq_start(row);
        const float* P = HALO + ((size_t)seg * 512 + (f0 >> 2)) * 16 + (bot ? 12 : 4);
        const f32x4 p0 = *(const GAS f32x4*)P, p1 = *(const GAS f32x4*)(P + 16);
        float z[8] = {p0.x, p0.y, p0.z, p0.w, p1.x, p1.y, p1.z, p1.w};
        if (!missing) {
            const float* R = HALO + ((size_t)(bot ? seg + 1 : seg - 1) * 512 + (f0 >> 2)) * 16 + (bot ? 0 : 8);
            const f32x4 r0 = *(const GAS f32x4*)R, r1 = *(const GAS f32x4*)(R + 16); const float rr[8] = {r0.x, r0.y, r0.z, r0.w, r1.x, r1.y, r1.z, r1.w};
            float w[8]; load8f(cw + (bot ? 2 : 0) * DM + f0, w);
#pragma unroll
            for (int e = 0; e < 8; ++e) z[e] += w[e] * rr[e];
        }
        float bb[8]; unpack8(*(const GAS v4u*)(Bb + (size_t)row * DM + f0), bb);
        *(GAS v4u*)(OUT + (size_t)row * DM + f0) = (v4u){pk2(bb[0] * z[0], bb[1] * z[1]), pk2(bb[2] * z[2], bb[3] * z[3]), pk2(bb[4] * z[4], bb[5] * z[5]), pk2(bb[6] * z[6], bb[7] * z[7])};
    }
}

__device__ __forceinline__ void ffnfix_phase(Frame& F, int layer, int nrows) {
    const int gw = F.vcu * NWAVES + F.wave, NGW = F.G * NWAVES;
    const float* HALO = wsf(F, WS_BIG + BIG_HALO); bf16* ACT = wsb(F, WS_BIG + BIG_ACT);
    const float* cw = F.in(22) + (size_t)layer * 3 * 11264;
    constexpr int NCG = DFF / 512;
    const int nseg = nrows / 64;
    for (int item = gw; item < nseg * 2 * NCG; item += NGW) {
        const int cg = item % NCG, sw = item / NCG, seg = sw >> 1, bot = sw & 1, f0 = cg * 512 + F.lane * 8;
        const int row = 64 * seg + (bot ? 63 : 0);
        const bool missing = bot ? seq_start(row + 1) : seq_start(row);
        const float* P = HALO + ((size_t)seg * 2816 + (f0 >> 2)) * 16 + (bot ? 12 : 4);
        float pg[8], pu[8];
        { const f32x4 a = *(const GAS f32x4*)P, b = *(const GAS f32x4*)(P + 16), c = *(const GAS f32x4*)(P + 1408 * 16), d = *(const GAS f32x4*)(P + 1408 * 16 + 16);
          pg[0] = a.x; pg[1] = a.y; pg[2] = a.z; pg[3] = a.w; pg[4] = b.x; pg[5] = b.y; pg[6] = b.z; pg[7] = b.w; pu[0] = c.x; pu[1] = c.y; pu[2] = c.z; pu[3] = c.w; pu[4] = d.x; pu[5] = d.y; pu[6] = d.z; pu[7] = d.w; }
        if (!missing) {
            const float* R = HALO + ((size_t)(bot ? seg + 1 : seg - 1) * 2816 + (f0 >> 2)) * 16 + (bot ? 0 : 8); const float* W = cw + (bot ? 2 : 0) * 11264 + f0;
            float rg[8], ru[8], wg[8], wu[8]; load8f(W, wg); load8f(W + DFF, wu);
            { const f32x4 a = *(const GAS f32x4*)R, b = *(const GAS f32x4*)(R + 16), c = *(const GAS f32x4*)(R + 1408 * 16), d = *(const GAS f32x4*)(R + 1408 * 16 + 16);
              rg[0] = a.x; rg[1] = a.y; rg[2] = a.z; rg[3] = a.w; rg[4] = b.x; rg[5] = b.y; rg[6] = b.z; rg[7] = b.w; ru[0] = c.x; ru[1] = c.y; ru[2] = c.z; ru[3] = c.w; ru[4] = d.x; ru[5] = d.y; ru[6] = d.z; ru[7] = d.w; }
#pragma unroll
            for (int e = 0; e < 8; ++e) { pg[e] += wg[e] * rg[e]; pu[e] += wu[e] * ru[e]; }
        }
        float o[8];
#pragma unroll
        for (int e = 0; e < 8; ++e) o[e] = pg[e] * __builtin_amdgcn_rcpf(1.0f + __builtin_amdgcn_exp2f(-1.4426950408889634f * pg[e])) * pu[e];
        *(GAS v4u*)(ACT + ((size_t)((row >> 8) * 88 + (f0 >> 6)) * 256 + (row & 255)) * 64 + (f0 & 63)) = (v4u){pk2(o[0], o[1]), pk2(o[2], o[3]), pk2(o[4], o[5]), pk2(o[6], o[7])};
    }
}

__device__ __forceinline__ void krope_phase(Frame& F) {
    const int gw = F.vcu * NWAVES + F.wave, NGW = F.G * NWAVES;
    const float* KRRAW = wsf(F, WS_BIG + BIG_KRRAW); bf16* KR = wsb(F, WS_BIG + BIG_KR);
    const f32x2* ropeR = (const f32x2*)(F.ws + WS_ROPER); const f32x2* ropeC = (const f32x2*)(F.ws + WS_ROPEC);
    for (int row = gw; row < M_T; row += NGW) {
        float kr = KRRAW[(size_t)row * ROPE_D + F.lane];
        const float partner = lane_xor(kr, F.lane, 16);
        if (row < M_X) { const int pos = row & (SEQ - 1), f = F.lane & 15; const f32x2 cs = F.lane < 32 ? ropeR[(pos >> 6) * 16 + f] : ropeC[(pos & 63) * 16 + f];
            kr = kr * cs.x + ((F.lane & 16) ? partner : -partner) * cs.y; }
        KR[(size_t)row * ROPE_D + F.lane] = (bf16)f2bf(kr);
    }
}

__device__ __forceinline__ void attn_phase(Frame& F, bool last, int i_lo = 0, int i_hi = 1 << 30) {
    const bf16* Q = wsb(F, WS_BIG + BIG_Q); const bf16* K = wsb(F, WS_BIG + BIG_K); const bf16* V = wsb(F, WS_BIG + BIG_V); const bf16* KR = wsb(F, WS_BIG + BIG_KR); bf16* O = wsb(F, WS_BIG + BIG_O);
    const att::f32x2* ropeR = (const att::f32x2*)(F.ws + WS_ROPER); const att::f32x2* ropeC = (const att::f32x2*)(F.ws + WS_ROPEC);
    ATT_LAS char* lds = (ATT_LAS char*)(F.lds + RING_OFF);
    constexpr int NQB = SEQ / 256, NUNIT = BATCH * NH * NQB, NCU = BATCH * NH;
    const int ntot = last ? NUNIT : NUNIT + NCU;
    for (int i = i_lo; i < i_hi; ++i) {
        const int L = i * F.G + F.vcu; if (L >= ntot) break;
        const bool isx = L < NUNIT;
        const int p = isx ? L / NQB : L - NUNIT, qb = isx ? L % NQB : 0, b = p / NH, h = p % NH;
        const size_t qrow = isx ? (size_t)b * SEQ + (size_t)qb * 256 : (size_t)M_X + (size_t)b * CTXL;
        att::attn_unit(Q + qrow * 3072 + h * 192, K + (size_t)h * M_T * 128, V + (size_t)h * M_T * 128, KR, O + qrow * 2048 + h * 128,

                       b * SEQ, isx ? SEQ / 64 : 0, M_X + b * CTXL, isx ? SEQ / 64 + CTXL / 64 : CTXL / 64, isx ? 1 : 0, qb * 256, ropeR, ropeC, lds, F.wave0);
    }
}

#ifndef MK_ONE_LAUNCH
#define MK_ONE_LAUNCH 1
#endif
constexpr bool ONE_LAUNCH = (MK_ONE_LAUNCH != 0);
constexpr int N_PHASE_IDS = 2 + 10 * DEPTH;
struct Args { const float* in[25]; float* out; unsigned char* ws; int ph_lo, ph_hi; };
__global__ void __launch_bounds__(NWAVES * 64, 2) mk_fwd(Args args) {
    extern __shared__ __attribute__((aligned(16))) unsigned char lds[];
    LAS unsigned char* const L0 = (LAS unsigned char*)lds;
    for (int u = threadIdx.x; u < (LDS_BYTES - LDSCTL_OFF) / 4; u += NWAVES * 64) ((LAS unsigned*)(L0 + LDSCTL_OFF))[u] = 0u;
    __syncthreads();
    if (threadIdx.x < 27) { const unsigned long long v = threadIdx.x < 25 ? (unsigned long long)args.in[threadIdx.x] : (threadIdx.x == 25 ? (unsigned long long)args.out : (unsigned long long)args.ws);
        ((LAS unsigned long long*)(L0 + PTAB_OFF))[threadIdx.x] = v; }
    __syncthreads();
    const int lo = args.ph_lo, hi = args.ph_hi;
    const int wave0 = __builtin_amdgcn_readfirstlane((int)threadIdx.x >> 6);
    if (ONE_LAUNCH) { Frame F; make_frame(F, L0, wave0); (void)xcd_barrier_post((unsigned*)((gu32*)(F.ws + WS_CTL) + CW_BAR), (volatile LAS unsigned*)(L0 + MISC_OFF) + 8, F.tid == 0); }
#ifndef MK_SLOT_MASK
#define MK_SLOT_MASK 0xFFFFFFFFu
#endif
#define IN(k) (lo <= (k) && (k) < hi)
#define INS(sl, cv) ((((MK_SLOT_MASK) >> ((sl) + ((cv) ? 16 : 0))) & 1u) && IN(pb + (sl)))
#ifndef PROBE_WAIT
#define PROBE_WAIT 0
#endif
#ifndef PROBE_WAIT_MASK
#define PROBE_WAIT_MASK 0xFFFFFFFFFFFFFFFFull
#endif
#ifndef PROBE_SPAN
#define PROBE_SPAN 0
#endif
#ifndef PROBE_WAIT_AMP
#define PROBE_WAIT_AMP 4
#endif
#define SEAM() do { if (ONE_LAUNCH) { XcdBarrier b_; b_.bar = (unsigned*)((gu32*)(F.ws + WS_CTL) + CW_BAR); b_.x = xb_xcc_id(); b_.st = (volatile LAS unsigned*)(L0 + MISC_OFF) + 8; const bool lead_ = tid_from_wave(wave0) == 0; \
    unsigned long long tw0_ = 0; if (PROBE_WAIT) { __syncthreads(); tw0_ = __builtin_amdgcn_s_memrealtime(); } \
    for (int rb_ = 0; rb_ <= REP_BAR; ++rb_) xcd_barrier(b_, lead_); \
    if (PROBE_WAIT) { const unsigned long long tw1_ = __builtin_amdgcn_s_memrealtime(); if (lead_) { volatile LAS unsigned* pw_ = (volatile LAS unsigned*)(L0 + MISC_OFF + 64); const unsigned idx_ = pw_[2]; pw_[2] = idx_ + 1u; \
        const unsigned prev_ = pw_[4]; pw_[4] = (unsigned)tw1_;     \
        if (((unsigned long long)(PROBE_WAIT_MASK) >> idx_) & 1ull) pw_[0] += PROBE_SPAN ? ((unsigned)tw1_ - prev_) : (unsigned)(tw1_ - tw0_); } } } } while (0)
#ifndef REP_ATTN
#define REP_ATTN 0
#endif
#ifndef REP_UP
#define REP_UP 0
#endif
#ifndef REP_WIN
#define REP_WIN 0
#endif
#ifndef REP_MLAG
#define REP_MLAG 0
#endif
#ifndef REP_ELT
#define REP_ELT 0
#endif
#ifndef REP_RESID
#define REP_RESID 0
#endif
#ifndef REP_BAR
#define REP_BAR 0
#endif
#ifndef REP_LN
#define REP_LN 0
#endif
#ifndef PROBE_ATTN_SPLIT
#define PROBE_ATTN_SPLIT 0
#endif
#ifndef PROBE_UP_TAIL
#define PROBE_UP_TAIL 0
#endif
#ifndef REP_P0
#define REP_P0 0
#endif
#define FRAME() Frame F; make_frame(F, L0, wave0); LAS unsigned char* ring = F.lds + RING_OFF; (void)ring; \
    bf16* HX = wsb(F, WS_ACT); bf16* ACT = wsb(F, WS_BIG + BIG_ACT); bf16* GU = wsb(F, WS_BIG); float* X32C = wsf(F, WS_X32C); const float* MOD = wsf(F, WS_MOD); (void)HX; (void)ACT; (void)GU; (void)X32C; (void)MOD

    if (((MK_SLOT_MASK >> 30) & 1u) && IN(0)) { FRAME(); for (int rep_ = 0; rep_ <= REP_P0; ++rep_) { p0_prologue(F); __syncthreads(); } SEAM(); }
    if (((MK_SLOT_MASK >> 31) & 1u) && IN(1)) { FRAME(); p1_hx0(F); SEAM(); }

    for (int L = 0; L < DEPTH; ++L) {
        const int pb = 2 + 10 * L, j = L >> 1; const bool last = (L == DEPTH - 1); const int Mrows = last ? M_X : M_T;
        const bool is_conv = (L & 1) == 0;
        if (is_conv) {
            if (INS(1, 1)) { FRAME();
                unsigned* cvf = (unsigned*)((gu32*)(F.ws + WS_CTL) + CW_CVF + j * 1024);
                pg8::Gemm g{HX, wsb(F, WS_W + j * W_CONV_STRIDE + W_WIN), M_T, 3 * DM, DM}; pg8::ConvMergedOrder S; S.init(M_T, DM, 2 * DM, F.G, F.bx, cvf);
                pg8::EpiConvBoth E{{wsb(F, WS_BIG + BIG_BB), DM, nullptr, 0, 0, 1.f},
                                   {wsb(F, WS_BIG + BIG_GATED), wsf(F, WS_BIG + BIG_HALOC), wsb(F, WS_BIG + BIG_BB), F.in(11) + (size_t)j * 3 * DM, (unsigned)((M_T / 64) * 512 * 64)},
                                   S.sb, cvf, (unsigned*)((gu32*)(F.ws + WS_CTL) + CW_BAR) + XB_TMO, F.G};
                pg8::gemm_phase<pg8::EpiConvBoth, pg8::ConvMergedOrder, true, true>(ring, g, S, E, F.wave0); SEAM(); }
            if (INS(2, 1)) { FRAME(); convfix_phase(F, j); SEAM(); }
        } else {
            if (INS(0, 0)) { FRAME();
                pg8::Gemm g{HX, wsb(F, WS_W + W_MLA_BASE + j * W_MLA_STRIDE + W_DQKV), M_T, NDQKV, DM}; pg8::StaticOrder S; S.init(M_T, NDQKV, F.G, F.bx);
                pg8::EpiDqkv E{wsb(F, WS_BIG + BIG_CQ), wsb(F, WS_BIG + BIG_CKV), wsf(F, WS_BIG + BIG_KRRAW), wsf(F, WS_BIG + BIG_SSQ), (unsigned)(M_T * 64)};
                for (int rep_ = 0; rep_ <= REP_MLAG; ++rep_) pg8::gemm_phase<pg8::EpiDqkv, pg8::StaticOrder, true, true>(ring, g, S, E, F.wave0); SEAM(); }
            if (INS(2, 0)) { FRAME();
                krope_phase(F);
                for (int rep_ = 0; rep_ <= REP_MLAG; ++rep_) {
                { pg8::Gemm g{wsb(F, WS_BIG + BIG_CQ), wsb(F, WS_W + W_MLA_BASE + j * W_MLA_STRIDE + W_UQ), Mrows, 3072, QLR}; pg8::StaticOrder S; S.init(Mrows, 3072, F.G, F.bx);
                  pg8::EpiBf16Row E{wsb(F, WS_BIG + BIG_Q), 3072, 0, 0, wsf(F, WS_BIG + BIG_SSQ), RMS_EPS, 0};
                  pg8::gemm_phase<pg8::EpiBf16Row, pg8::StaticOrder, true, true>(ring, g, S, E, F.wave0); }
                { pg8::Gemm g{wsb(F, WS_BIG + BIG_CKV), wsb(F, WS_W + W_MLA_BASE + j * W_MLA_STRIDE + W_UKV), M_T, 4096, KVLR}; pg8::StaticOrder S; S.init(M_T, 4096, F.G, (F.bx + F.G / 2) % F.G);
                  pg8::EpiBf16Row E{wsb(F, WS_BIG + BIG_K), 2048, 2048, (BIG_V - BIG_K) / 2, wsf(F, WS_BIG + BIG_SSQ) + 8, RMS_EPS, M_T};
                  pg8::gemm_phase<pg8::EpiBf16Row, pg8::StaticOrder, true, true>(ring, g, S, E, F.wave0); }
                }
                SEAM(); }
            if (INS(3, 0)) { FRAME(); if (PROBE_ATTN_SPLIT) { attn_phase(F, last, 0, 4); SEAM(); attn_phase(F, last, 4); } else { for (int rep_ = 0; rep_ <= REP_ATTN; ++rep_) attn_phase(F, last); } SEAM(); }
        }
        if (INS(4, 0)) { FRAME();
            const bf16* A = is_conv ? wsb(F, WS_BIG + BIG_GATED) : wsb(F, WS_BIG + BIG_O);
            const bf16* Bt = is_conv ? wsb(F, WS_W + j * W_CONV_STRIDE + W_WOUT) : wsb(F, WS_W + W_MLA_BASE + j * W_MLA_STRIDE + W_WO);
            pg8::Gemm g{A, Bt, Mrows, DM, DM}; pg8::ClusterCtxOrder S; S.init(M_X, Mrows - M_X, DM, DM, 4, F.G, F.bx);
            pg8::EpiResid E{L == 0 ? F.in(0) : nullptr, (const _Float16*)(F.ws + WS_T16), (_Float16*)(F.ws + WS_T16), wsf(F, WS_BIG + BIG_CPART), MOD + (size_t)L * 3 * 12288 + 2 * DM, DN_ALPHA,
                             L == 0 ? nullptr : wsf(F, WS_STATS) + 2 * M_T, F.in(8) + (L == 0 ? 0 : L - 1) * DM, F.in(9) + (L == 0 ? 0 : L - 1) * DM};
            if (REP_RESID) { pg8::EpiResid E2 = E; E2.dstT = (_Float16*)HX; pg8::SplitCtxOrder S2; S2.init(M_X, 0, DM, DM, 4, F.G, F.bx); pg8::gemm_phase<pg8::EpiResid, pg8::SplitCtxOrder, true, true>(ring, g, S2, E2, F.wave0); }
            pg8::gemm_phase<pg8::EpiResid, pg8::ClusterCtxOrder, true, true>(ring, g, S, E, F.wave0);
            { Frame F2; make_frame(F2, L0, wave0); unsigned* rel = (unsigned*)((gu32*)(F2.ws + WS_CTL) + CW_RLF + (2 * L + 0) * RLF_STRIDE); unsigned* bar2 = (unsigned*)((gu32*)(F2.ws + WS_CTL) + CW_BAR);
              if (F2.tid == 0) { __builtin_amdgcn_fence(__ATOMIC_RELEASE, "agent"); asm volatile("s_waitcnt vmcnt(0)" ::: "memory"); __hip_atomic_store(rel + F2.bx, 1u, __ATOMIC_RELAXED, __HIP_MEMORY_SCOPE_AGENT); (void)xb_add(rel + 256, 1u); }
              pg8::ClusterCtxOrder S2; S2.init(M_X, Mrows - M_X, DM, DM, 4, F2.G, F2.bx);
              ln_cluster(F2, L, 0, Mrows, 4, S2, rel, bar2);
              if (F2.G == 256) {
                  asm volatile("s_waitcnt vmcnt(0)" ::: "memory"); __syncthreads();
                  if (F2.tid == 0) { __builtin_amdgcn_fence(__ATOMIC_RELEASE, "agent"); asm volatile("s_waitcnt vmcnt(0)" ::: "memory"); __hip_atomic_store(rel + 512 + F2.bx, 1u, __ATOMIC_RELAXED, __HIP_MEMORY_SCOPE_AGENT); (void)xb_add(rel + 257, 1u); } } }
            if (F.G != 256) SEAM(); }
        if (INS(6, 0)) { FRAME();
            pg8::Gemm g{HX, wsb(F, WS_W + W_FFN_BASE + L * W_FFN_STRIDE + W_UP), Mrows, 11264, DM};
            pg8::EpiConvAct E{ACT, wsf(F, WS_BIG + BIG_HALO), F.in(22) + (size_t)L * 3 * 11264, F.in(23) + (size_t)L * 11264, (unsigned)((M_T / 64) * 2816 * 64)};
            if (F.G == 256) {
                unsigned* rel = (unsigned*)((gu32*)(F.ws + WS_CTL) + CW_RLF + (2 * L + 0) * RLF_STRIDE);
                if (F.wave == 0) { unsigned* bar2 = (unsigned*)((gu32*)(F.ws + WS_CTL) + CW_BAR); unsigned* fl = rel + 512 + (8 * (8 * (F.bx >> 6) + (F.lane & 7)) + (F.bx & 7)); unsigned sp = 0u;
                    while (!__all(__hip_atomic_load(fl, __ATOMIC_RELAXED, __HIP_MEMORY_SCOPE_AGENT) >= 1u)) { __builtin_amdgcn_s_sleep(2);
                        if ((++sp & 255u) == 0u) { if (xb_ld(&bar2[XB_TMO])) break; if (sp > XB_SPIN_CAP) { atomicAdd(&bar2[XB_TMO], 1u); break; } } }
                    __builtin_amdgcn_fence(__ATOMIC_ACQUIRE, "agent"); asm volatile("s_waitcnt vmcnt(0)" ::: "memory"); }
                __syncthreads();
                pg8::ClusterUpOrder S; S.init(11264, Mrows - M_X, F.G, F.bx, rel + 257);
                pg8::gemm_phase<pg8::EpiConvAct, pg8::ClusterUpOrder, true, true>(ring, g, S, E, F.wave0);
            } else {
                pg8::StaticOrder S; S.init(Mrows, 11264, F.G, F.bx);
                pg8::gemm_phase<pg8::EpiConvAct, pg8::StaticOrder, true, true>(ring, g, S, E, F.wave0);
            }
            SEAM(); }
        if (INS(7, 0)) { FRAME(); for (int rep_ = 0; rep_ <= REP_ELT; ++rep_) ffnfix_phase(F, L, Mrows); SEAM(); }
        if (INS(8, 0)) { FRAME();
            pg8::Gemm g{ACT, wsb(F, WS_W + W_FFN_BASE + L * W_FFN_STRIDE + W_DOWN), Mrows, DM, DFF, 1, 1}; pg8::ClusterCtxOrder S; S.init(M_X, Mrows - M_X, DM, DFF, 11, F.G, F.bx);
            pg8::EpiResid E{nullptr, (const _Float16*)(F.ws + WS_T16), (_Float16*)(F.ws + WS_T16), wsf(F, WS_BIG + BIG_CPART), MOD + (size_t)L * 3 * 12288 + 5 * DM, DN_ALPHA, wsf(F, WS_STATS), F.in(6) + L * DM, F.in(7) + L * DM};
            if (REP_RESID) { pg8::EpiResid E2 = E; E2.dstT = (_Float16*)HX; pg8::SplitCtxOrder S2; S2.init(M_X, 0, DM, DFF, 11, F.G, F.bx); pg8::gemm_phase<pg8::EpiResid, pg8::SplitCtxOrder, true, true>(ring, g, S2, E2, F.wave0); }
            pg8::gemm_phase<pg8::EpiResid, pg8::ClusterCtxOrder, true, true>(ring, g, S, E, F.wave0);
            { Frame F2; make_frame(F2, L0, wave0); unsigned* rel = (unsigned*)((gu32*)(F2.ws + WS_CTL) + CW_RLF + (2 * L + 1) * RLF_STRIDE); unsigned* bar2 = (unsigned*)((gu32*)(F2.ws + WS_CTL) + CW_BAR);
              if (F2.tid == 0) { __builtin_amdgcn_fence(__ATOMIC_RELEASE, "agent"); asm volatile("s_waitcnt vmcnt(0)" ::: "memory"); __hip_atomic_store(rel + F2.bx, 1u, __ATOMIC_RELAXED, __HIP_MEMORY_SCOPE_AGENT); (void)xb_add(rel + 256, 1u); }
              pg8::ClusterCtxOrder S2; S2.init(M_X, Mrows - M_X, DM, DFF, 11, F2.G, F2.bx);
              ln_cluster(F2, L, 1, Mrows, 11, S2, rel, bar2); }
            if (!last) SEAM(); }
    }
#if PROBE_WAIT
    { FRAME(); const bool pl_ = F.tid == 0; unsigned* acc_ = (unsigned*)((gu32*)(F.ws + WS_CTL) + 64);
      if (pl_) (void)xb_add(acc_, *(volatile LAS unsigned*)(L0 + MISC_OFF + 64));
      SEAM();
      if (F.bx == 0 && pl_) { const unsigned sum_ = xb_ld(acc_); const unsigned long long tgt_ = (unsigned long long)(sum_ / (unsigned)F.G) * PROBE_WAIT_AMP; const unsigned long long t0_ = __builtin_amdgcn_s_memrealtime();
          while (__builtin_amdgcn_s_memrealtime() - t0_ < tgt_) __builtin_amdgcn_s_sleep(16); } }
#endif
#undef IN
#undef SEAM
}

extern "C" void kernel_launch(void* const* d_in, const int* in_sizes, int n_in, void* d_out, int out_size, void* d_ws, size_t ws_size, hipStream_t stream) {
    static int grid = 0;
    if (grid == 0) {
        if (n_in != 25 || in_sizes[0] != M_X * DM || out_size != M_X * DM || ws_size < WS_END) {
            fprintf(stderr, "kernel_launch: shape/workspace mismatch: n_in %d in0 %d out %d ws %zu (need %zu); nothing launched\n", n_in, n_in > 0 ? in_sizes[0] : -1, out_size, ws_size, (size_t)WS_END); grid = -1; return; }
        int dev = 0, cus = 0, per_cu = 0;
        if (hipGetDevice(&dev) != hipSuccess || hipDeviceGetAttribute(&cus, hipDeviceAttributeMultiprocessorCount, dev) != hipSuccess) { grid = -1; return; }
        if (hipFuncSetAttribute((const void*)mk_fwd, hipFuncAttributeMaxDynamicSharedMemorySize, LDS_BYTES) != hipSuccess) { fprintf(stderr, "kernel_launch: hipFuncSetAttribute failed\n"); grid = -1; return; }
        if (hipOccupancyMaxActiveBlocksPerMultiprocessor(&per_cu, (const void*)mk_fwd, NWAVES * 64, LDS_BYTES) != hipSuccess || per_cu < 1)
            fprintf(stderr, "kernel_launch: note: occupancy query reports %d workgroups per CU\n", per_cu);
        (void)hipGetLastError();
        grid = cus;
    }
    if (grid < 0) return;
    if (hipMemsetAsync((char*)d_ws + WS_CTL, 0, CTL_ZERO_BYTES, stream) != hipSuccess) return;
    Args a{};
    for (int i = 0; i < 25; ++i) a.in[i] = (const float*)d_in[i];
    a.out = (float*)d_out; a.ws = (unsigned char*)d_ws;
    if (ONE_LAUNCH) {
        a.ph_lo = 0; a.ph_hi = N_PHASE_IDS;
        hipLaunchKernelGGL(mk_fwd, dim3(grid), dim3(NWAVES * 64), LDS_BYTES, stream, a);
    } else {
        for (int p = 0; p < N_PHASE_IDS; ++p) {
            if (p >= 2) { const int L = (p - 2) / 10, s = (p - 2) % 10; if (((L & 1) == 0 && s == 3) || ((L & 1) == 1 && s == 1)) continue; }
            a.ph_lo = p; a.ph_hi = p + 1;
            hipLaunchKernelGGL(mk_fwd, dim3(grid), dim3(NWAVES * 64), LDS_BYTES, stream, a);
        }
    }
    const hipError_t le = hipPeekAtLastError();
    if (le != hipSuccess) fprintf(stderr, "kernel_launch: launch failed: %s\n", hipGetErrorName(le));
}
```
